# Optimizing an MI355X kernel written in HIP

```python
import math
import jax
import jax.numpy as jnp
from jax import lax
import numpy as np

D_MODEL = 1024
BATCH = 2
SEQ = 8192
DEPTH = 2

GRID_W = 64
CTX_LEN = 256
CHUNK = 128
CONV_W = 5
RMS_EPS = 1e-6
LN_EPS = 1e-5
ROPE_BASE = 10000.0

SSD_HEADS = 16
SSD_HEAD_DIM = 64
SSD_INNER = SSD_HEADS * SSD_HEAD_DIM
SSD_GROUPS = 4
SSD_STATE = 128
SSD_CONV_DIM = SSD_INNER + 2 * SSD_GROUPS * SSD_STATE

RET_HEADS = 4
RET_QK_DIM = 128
RET_V_DIM = 256
RET_QK = RET_HEADS * RET_QK_DIM
RET_V = RET_HEADS * RET_V_DIM

AB_IN_SIZES = (SSD_INNER, SSD_CONV_DIM, SSD_HEADS, RET_QK, RET_QK, RET_V, RET_V)
AB_IN = sum(AB_IN_SIZES)
AB_SPLITS = tuple(sum(AB_IN_SIZES[:i + 1]) for i in range(len(AB_IN_SIZES) - 1))
AB_OUT = SSD_INNER + RET_V

MLSTM_HEADS = 4
MLSTM_INNER = 2 * D_MODEL
MLSTM_HEAD_DIM = MLSTM_INNER // MLSTM_HEADS
QKV_BLOCK = 4
N_QKV_BLOCKS = MLSTM_INNER // QKV_BLOCK
N_GATES = 4 * MLSTM_HEADS

FFN_HIDDEN = -(-(8 * D_MODEL) // (3 * 256)) * 256
N_EVEN = (DEPTH + 1) // 2
N_ODD = DEPTH // 2

kernel_name = 'hybrid_ssd_retention_mlstm_dit'


def rmsnorm(x, w):
    xf = x.astype(jnp.float32)
    y = xf * lax.rsqrt(jnp.mean(xf * xf, axis=-1, keepdims=True) + RMS_EPS)
    return (y * w).astype(x.dtype)


def head_layernorm(y):
    yf = y.astype(jnp.float32)
    mu = jnp.mean(yf, axis=-1, keepdims=True)
    d = yf - mu
    return d * lax.rsqrt(jnp.mean(d * d, axis=-1, keepdims=True) + LN_EPS)


def modulation(cvec, w, b):
    return jax.nn.silu(cvec) @ w + b


def modulate(hn, shift, scale):
    return hn * (1.0 + scale) + shift


def swiglu(h, w1, w3, w2):
    return (jax.nn.silu(h @ w1) * (h @ w3)) @ w2


def dwconv(x, w, b):
    ch = x.shape[-1]
    y = lax.conv_general_dilated(x, w[:, None, :].astype(x.dtype), window_strides=(1,),
                                 padding=[(CONV_W // 2, CONV_W // 2)],
                                 dimension_numbers=('NWC', 'WIO', 'NWC'), feature_group_count=ch)
    return y + b


def flip(a):
    return jnp.flip(a, axis=1)


def axial_rope(rows):
    r = jnp.repeat(jnp.arange(rows, dtype=jnp.float32), GRID_W)
    col = jnp.tile(jnp.arange(GRID_W, dtype=jnp.float32), rows)
    nf = RET_QK_DIM // 4
    inv = ROPE_BASE ** (-jnp.arange(nf, dtype=jnp.float32) / nf)
    ang = jnp.concatenate([r[:, None] * inv, col[:, None] * inv], axis=-1)
    return jnp.cos(ang), jnp.sin(ang)


def apply_rope(x, cos, sin):
    x1, x2 = jnp.split(x, 2, axis=-1)
    cc, ss = cos[None, :, None, :], sin[None, :, None, :]
    return jnp.concatenate([x1 * cc - x2 * ss, x1 * ss + x2 * cc], axis=-1).astype(x.dtype)


def to_chunks(a):
    b, n = a.shape[:2]
    return jnp.moveaxis(a.reshape(b, n // CHUNK, CHUNK, *a.shape[2:]), 1, 0)


def from_chunks(a):
    nc, b, l = a.shape[:3]
    return jnp.moveaxis(a, 0, 1).reshape(b, nc * l, *a.shape[3:])


def decay_scan(q, k, v, log_a, s0):
    tril = jnp.tril(jnp.ones((CHUNK, CHUNK), bool))[None, :, :, None]

    def body(s, inp):
        qc, kc, vc, ac = inp
        cs = jnp.cumsum(ac, axis=1)
        decay = jnp.exp(jnp.where(tril, cs[:, :, None, :] - cs[:, None, :, :], -jnp.inf))
        scores = jnp.einsum('bihd,bjhd->bijh', qc, kc) * decay
        y = (jnp.einsum('bijh,bjhe->bihe', scores, vc)
             + jnp.einsum('bihd,bhde->bihe', qc * jnp.exp(cs)[..., None], s))
        w_end = jnp.exp(cs[:, -1:, :] - cs)[..., None]
        s_new = (jnp.exp(cs[:, -1, :])[..., None, None] * s
                 + jnp.einsum('bjhd,bjhe->bhde', kc * w_end, vc))
        return s_new, y

    s_fin, ys = lax.scan(body, s0, (to_chunks(q), to_chunks(k), to_chunks(v), to_chunks(log_a)))
    return from_chunks(ys), s_fin


def bidir_decay_scan(q, k, v_f, v_b, la_f, la_b, s_f, s_b):
    y_f, s_f = decay_scan(q, k, v_f, la_f, s_f)
    y_b, s_b = decay_scan(flip(q), flip(k), flip(v_b), flip(la_b), s_b)
    return y_f + flip(y_b), s_f, s_b


def mlstm_scan(q, k, v, i_pre, log_f, state):
    tril = jnp.tril(jnp.ones((CHUNK, CHUNK), bool))[None, :, :, None]

    def body(carry, inp):
        c_mat, n_vec, m = carry
        qc, kc, vc, ic, fc = inp
        bcum = jnp.cumsum(fc, axis=1)
        d = jnp.where(tril, bcum[:, :, None, :] - bcum[:, None, :, :] + ic[:, None, :, :], -jnp.inf)
        prev = bcum + m[:, None, :]
        m_out = jnp.maximum(prev, jnp.max(d, axis=2))
        s = jnp.einsum('bihd,bjhd->bijh', qc, kc) * jnp.exp(d - m_out[:, :, None, :])
        w_prev = jnp.exp(prev - m_out)
        num = (jnp.einsum('bijh,bjhe->bihe', s, vc)
               + w_prev[..., None] * jnp.einsum('bihd,bhde->bihe', qc, c_mat))
        den = jnp.sum(s, axis=2) + w_prev * jnp.einsum('bihd,bhd->bih', qc, n_vec)
        hc = num / jnp.maximum(jnp.abs(den), jnp.exp(-m_out))[..., None]
        b_end = bcum[:, -1, :]
        d_end = b_end[:, None, :] - bcum + ic
        m_new = jnp.maximum(b_end + m, jnp.max(d_end, axis=1))
        w_k = jnp.exp(d_end - m_new[:, None, :])[..., None] * kc
        w_c = jnp.exp(b_end + m - m_new)
        c_new = w_c[..., None, None] * c_mat + jnp.einsum('bjhd,bjhe->bhde', w_k, vc)
        n_new = w_c[..., None] * n_vec + jnp.sum(w_k, axis=1)
        return (c_new, n_new, m_new), hc

    carry, hs = lax.scan(body, state, tuple(map(to_chunks, (q, k, v, i_pre, log_f))))
    return from_chunks(hs), carry


def ab_zero_states(b):
    s_ssd = jnp.zeros((b, SSD_HEADS, SSD_STATE, SSD_HEAD_DIM), jnp.float32)
    s_ret = jnp.zeros((b, RET_HEADS, RET_QK_DIM, RET_V_DIM), jnp.float32)
    return (s_ssd, s_ssd, s_ret, s_ret)


def mlstm_zero_states(b):
    st = (jnp.zeros((b, MLSTM_HEADS, MLSTM_HEAD_DIM, MLSTM_HEAD_DIM), jnp.float32),
          jnp.zeros((b, MLSTM_HEADS, MLSTM_HEAD_DIM), jnp.float32),
          jnp.zeros((b, MLSTM_HEADS), jnp.float32))
    return (st, st)


def ssd_retention_mixer(h, rope, states, in_w, conv_w, conv_b, dt_bias_f, dt_bias_b, a_log_f, a_log_b,
                        d_skip, ssd_norm_w, ret_logit_f, ret_logit_b, out_w):
    b, n, _ = h.shape
    z, xbc, dt_raw, q, k, v, g = jnp.split(h @ in_w, AB_SPLITS, axis=-1)
    xbc = jax.nn.silu(dwconv(xbc, conv_w, conv_b))
    xs, bm, cm = jnp.split(xbc, [SSD_INNER, SSD_INNER + SSD_GROUPS * SSD_STATE], axis=-1)
    xs = xs.reshape(b, n, SSD_HEADS, SSD_HEAD_DIM)
    rep = SSD_HEADS // SSD_GROUPS
    bm = jnp.repeat(bm.reshape(b, n, SSD_GROUPS, SSD_STATE), rep, axis=2)
    cm = jnp.repeat(cm.reshape(b, n, SSD_GROUPS, SSD_STATE), rep, axis=2)
    dt_raw = dt_raw.astype(jnp.float32)
    dt_f = jax.nn.softplus(dt_raw + dt_bias_f)
    dt_b = jax.nn.softplus(dt_raw + dt_bias_b)
    la_f = -dt_f * jnp.exp(a_log_f.astype(jnp.float32))
    la_b = -dt_b * jnp.exp(a_log_b.astype(jnp.float32))
    y_ssd, sf, sb = bidir_decay_scan(cm, bm, xs * dt_f[..., None], xs * dt_b[..., None],
                                     la_f, la_b, states[0], states[1])
    y_ssd = (y_ssd + d_skip[:, None] * xs).reshape(b, n, SSD_INNER) * jax.nn.silu(z)
    y_ssd = rmsnorm(y_ssd.reshape(b, n, SSD_GROUPS, SSD_INNER // SSD_GROUPS),
                    ssd_norm_w.reshape(SSD_GROUPS, SSD_INNER // SSD_GROUPS)).reshape(b, n, SSD_INNER)
    q = q.reshape(b, n, RET_HEADS, RET_QK_DIM)
    k = k.reshape(b, n, RET_HEADS, RET_QK_DIM) * RET_QK_DIM ** -0.5
    if rope is not None:
        q = apply_rope(q, *rope)
        k = apply_rope(k, *rope)
    v = v.reshape(b, n, RET_HEADS, RET_V_DIM)
    lg_f = jnp.broadcast_to(jax.nn.log_sigmoid(ret_logit_f.astype(jnp.float32)), (b, n, RET_HEADS))
    lg_b = jnp.broadcast_to(jax.nn.log_sigmoid(ret_logit_b.astype(jnp.float32)), (b, n, RET_HEADS))
    y_ret, rf, rb = bidir_decay_scan(q, k, v, v, lg_f, lg_b, states[2], states[3])
    y_ret = head_layernorm(y_ret).reshape(b, n, RET_V) * jax.nn.silu(g)
    out = jnp.concatenate([y_ssd, y_ret], axis=-1).astype(h.dtype) @ out_w
    return out, (sf, sb, rf, rb)


def mlstm_mixer(h, states, up_w, conv_w, conv_b, wq, wk, wv, gate_w, gate_b, norm_w, skip, down_w):
    b, n, _ = h.shape
    xm, z = jnp.split(h @ up_w, 2, axis=-1)
    xc = jax.nn.silu(dwconv(xm, conv_w, conv_b))

    def blockwise(a, w):
        return jnp.einsum('bnkd,kde->bnke', a.reshape(b, n, N_QKV_BLOCKS, QKV_BLOCK), w).reshape(b, n, MLSTM_INNER)

    q, k, v = blockwise(xc, wq), blockwise(xc, wk), blockwise(xm, wv)
    gates = (jnp.concatenate([q, k, v], axis=-1) @ gate_w + gate_b).astype(jnp.float32)
    i_f, f_f, i_b, f_b = jnp.split(gates, 4, axis=-1)

    def heads(a):
        return a.reshape(b, n, MLSTM_HEADS, MLSTM_HEAD_DIM)

    qh, kh, vh = heads(q), heads(k) * MLSTM_HEAD_DIM ** -0.5, heads(v)
    h_f, st_f = mlstm_scan(qh, kh, vh, i_f, jax.nn.log_sigmoid(f_f), states[0])
    h_b, st_b = mlstm_scan(flip(qh), flip(kh), flip(vh), flip(i_b), flip(jax.nn.log_sigmoid(f_b)), states[1])
    hn = head_layernorm(h_f + flip(h_b)).reshape(b, n, MLSTM_INNER) * norm_w
    y = (hn + skip * xc) * jax.nn.silu(z)
    return y.astype(h.dtype) @ down_w, (st_f, st_b)


def block_update(x, y, mod, ffn_norm_w, w1, w3, w2):
    x = x + (mod[2] * y).astype(x.dtype)
    hf = modulate(rmsnorm(x, ffn_norm_w), mod[3], mod[4])
    return x + (mod[5] * swiglu(hf, w1, w3, w2)).astype(x.dtype)


def setup_inputs(seed: int = 0) -> dict:
    key = jax.random.key(seed)
    ks = iter(jax.random.split(key, 64))

    def nrm(shape, scale):
        return scale * jax.random.normal(next(ks), shape, jnp.float32)

    def gain(shape):
        return 1.0 + nrm(shape, 0.02)

    def dt_bias():
        dt = jnp.exp(jax.random.uniform(next(ks), (N_EVEN, SSD_HEADS), jnp.float32,
                                        math.log(1e-3), math.log(1e-1)))
        return dt + jnp.log(-jnp.expm1(-dt))

    def a_log():
        return jnp.log(jax.random.uniform(next(ks), (N_EVEN, SSD_HEADS), jnp.float32, 1.0, 16.0))

    gamma0 = 1.0 - 2.0 ** (-5.0 - jnp.arange(RET_HEADS, dtype=jnp.float32))
    logit0 = jnp.log(gamma0) - jnp.log1p(-gamma0)
    f_bias0 = jnp.linspace(3.0, 6.0, MLSTM_HEADS, dtype=jnp.float32)
    D = D_MODEL
    return {
        'x': nrm((BATCH, SEQ, D), 1.0),
        'c': nrm((BATCH, D), 1.0),
        'ctx': nrm((BATCH, CTX_LEN, D), 1.0),
        'c_ctx': nrm((D,), 1.0),
        'ada_w': nrm((DEPTH, D, 6 * D), D ** -0.5),
        'ada_b': nrm((DEPTH, 6 * D), 0.02),
        'norm_mix_w': gain((DEPTH, D)),
        'norm_ffn_w': gain((DEPTH, D)),
        'ffn_w1': nrm((DEPTH, D, FFN_HIDDEN), D ** -0.5),
        'ffn_w3': nrm((DEPTH, D, FFN_HIDDEN), D ** -0.5),
        'ffn_w2': nrm((DEPTH, FFN_HIDDEN, D), FFN_HIDDEN ** -0.5),
        'ab_in_w': nrm((N_EVEN, D, AB_IN), D ** -0.5),
        'ab_conv_w': nrm((N_EVEN, CONV_W, SSD_CONV_DIM), CONV_W ** -0.5),
        'ab_conv_b': nrm((N_EVEN, SSD_CONV_DIM), 0.02),
        'ssd_dt_bias_f': dt_bias(),
        'ssd_dt_bias_b': dt_bias(),
        'ssd_a_log_f': a_log(),
        'ssd_a_log_b': a_log(),
        'ssd_d': 1.0 + nrm((N_EVEN, SSD_HEADS), 0.1),
        'ssd_norm_w': gain((N_EVEN, SSD_INNER)),
        'ret_logit_f': logit0 + nrm((N_EVEN, RET_HEADS), 0.1),
        'ret_logit_b': logit0 + nrm((N_EVEN, RET_HEADS), 0.1),
        'ab_out_w': nrm((N_EVEN, AB_OUT, D), AB_OUT ** -0.5),
        'ml_up_w': nrm((N_ODD, D, 2 * MLSTM_INNER), D ** -0.5),
        'ml_conv_w': nrm((N_ODD, CONV_W, MLSTM_INNER), CONV_W ** -0.5),
        'ml_conv_b': nrm((N_ODD, MLSTM_INNER), 0.02),
        'ml_wq': nrm((N_ODD, N_QKV_BLOCKS, QKV_BLOCK, QKV_BLOCK), QKV_BLOCK ** -0.5),
        'ml_wk': nrm((N_ODD, N_QKV_BLOCKS, QKV_BLOCK, QKV_BLOCK), QKV_BLOCK ** -0.5),
        'ml_wv': nrm((N_ODD, N_QKV_BLOCKS, QKV_BLOCK, QKV_BLOCK), QKV_BLOCK ** -0.5),
        'ml_gate_w': nrm((N_ODD, 3 * MLSTM_INNER, N_GATES), 0.1 * (3 * MLSTM_INNER) ** -0.5),
        'ml_gate_b': jnp.concatenate([nrm((N_ODD, MLSTM_HEADS), 0.1),
                                      f_bias0 + nrm((N_ODD, MLSTM_HEADS), 0.1),
                                      nrm((N_ODD, MLSTM_HEADS), 0.1),
                                      f_bias0 + nrm((N_ODD, MLSTM_HEADS), 0.1)], axis=-1),
        'ml_norm_w': gain((N_ODD, MLSTM_INNER)),
        'ml_skip': gain((N_ODD, MLSTM_INNER)),
        'ml_down_w': nrm((N_ODD, MLSTM_INNER, D), MLSTM_INNER ** -0.5),
        'final_norm_w': gain((D,)),
    }


def reference(x, c, ctx, c_ctx, ada_w, ada_b, norm_mix_w, norm_ffn_w, ffn_w1, ffn_w3, ffn_w2,
              ab_in_w, ab_conv_w, ab_conv_b, ssd_dt_bias_f, ssd_dt_bias_b, ssd_a_log_f, ssd_a_log_b,
              ssd_d, ssd_norm_w, ret_logit_f, ret_logit_b, ab_out_w,
              ml_up_w, ml_conv_w, ml_conv_b, ml_wq, ml_wk, ml_wv, ml_gate_w, ml_gate_b,
              ml_norm_w, ml_skip, ml_down_w, final_norm_w):
    b = x.shape[0]
    rows = x.shape[1] // GRID_W
    rope = axial_rope(rows)
    lat, cx = x, ctx
    for layer in range(DEPTH):
        mod_l = jnp.split(modulation(c, ada_w[layer], ada_b[layer])[:, None, :], 6, axis=-1)
        mod_c = jnp.split(modulation(c_ctx[None, :], ada_w[layer], ada_b[layer])[:, None, :], 6, axis=-1)
        h_l = modulate(rmsnorm(lat, norm_mix_w[layer]), mod_l[0], mod_l[1])
        h_c = modulate(rmsnorm(cx, norm_mix_w[layer]), mod_c[0], mod_c[1])
        j = layer // 2
        if layer % 2 == 0:
            p = (ab_in_w[j], ab_conv_w[j], ab_conv_b[j], ssd_dt_bias_f[j], ssd_dt_bias_b[j],
                 ssd_a_log_f[j], ssd_a_log_b[j], ssd_d[j], ssd_norm_w[j], ret_logit_f[j],
                 ret_logit_b[j], ab_out_w[j])
            y_c, st = ssd_retention_mixer(h_c, None, ab_zero_states(b), *p)
            y_l, _ = ssd_retention_mixer(h_l, rope, st, *p)
        else:
            p = (ml_up_w[j], ml_conv_w[j], ml_conv_b[j], ml_wq[j], ml_wk[j], ml_wv[j],
                 ml_gate_w[j], ml_gate_b[j], ml_norm_w[j], ml_skip[j], ml_down_w[j])
            y_c, st = mlstm_mixer(h_c, mlstm_zero_states(b), *p)
            y_l, _ = mlstm_mixer(h_l, st, *p)
        lat = block_update(lat, y_l, mod_l, norm_ffn_w[layer], ffn_w1[layer], ffn_w3[layer], ffn_w2[layer])
        if layer < DEPTH - 1:
            cx = block_update(cx, y_c, mod_c, norm_ffn_w[layer], ffn_w1[layer], ffn_w3[layer], ffn_w2[layer])
    return rmsnorm(lat, final_norm_w)
```

```cpp
#include <hip/hip_runtime.h>
#include <cstdio>
#include <cstdint>
namespace pg8 {
#define PG8_LAS __attribute__((address_space(3)))
typedef unsigned short bf16_t;
typedef short bf16x8 __attribute__((ext_vector_type(8)));
typedef float f32x4 __attribute__((ext_vector_type(4)));
typedef unsigned u32x4 __attribute__((ext_vector_type(4)));
constexpr int BM = 256, BK = 64, HALF = 128, HTB = HALF * BK * 2  , STAGE_BYTES = 8 * HTB, NXCD = 8, WGM = 8;

__host__ __device__ __forceinline__ int lds_byte(int r, int c) { const int st = (r >> 4) * 2 + (c >> 5), rr = r & 15, cc = c & 31, ob = rr * 64 + cc * 2; return st * 1024 + (ob ^ (((ob >> 9) & 1) << 5)); }
__host__ __device__ __forceinline__ void stage_rc(int b, int& R, int& C) { const int st = b / 1024, sb = b % 1024, swz = sb ^ (((sb >> 9) & 1) << 5); R = (st >> 1) * 16 + swz / 64; C = (st & 1) * 32 + (swz % 64) / 2; }
__host__ __device__ __forceinline__ int perm32(int rho) { const int n = rho >> 4, i = rho & 15; return 8 * (i >> 2) + 4 * n + (i & 3); }

struct Unit { int pm, pn; };
struct Gemm { const bf16_t* A; const bf16_t* Bt; int M, N, K; };

struct StaticOrder {
    int nM, nN, nwg, G, c;
    __host__ __device__ void init(int M, int N, int G_, int c_) { nM = M / BM; nN = N / BM; nwg = nM * nN; G = G_; c = c_; }
    __host__ __device__ bool next(int i, Unit& u) const {
        const long L = (long)i * G + c; if (L >= nwg) return false;
        int wgid = (int)L; { const int q = nwg / NXCD, r = nwg % NXCD, xcd = wgid % NXCD, off = wgid / NXCD; wgid = (xcd < r ? xcd * (q + 1) : r * (q + 1) + (xcd - r) * q) + off; }
        const int nig = WGM * nN, gid = wgid / nig, fm = gid * WGM, gsz = (nM - fm) < WGM ? (nM - fm) : WGM;
        u.pm = fm + ((wgid % nig) % gsz); u.pn = (wgid % nig) / gsz; return true;
    }
    __device__ __forceinline__ void a_ready(const Unit&) const {}
    __device__ __forceinline__ void done(const Unit&) const {}
};

__device__ __forceinline__ unsigned cvt_pk_bf16(float lo, float hi) { unsigned r; asm volatile("v_cvt_pk_bf16_f32 %0, %1, %2" : "=v"(r) : "v"(lo), "v"(hi)); return r; }
__device__ __forceinline__ float fast_silu(float a) { return a * __builtin_amdgcn_rcpf(1.0f + __expf(-a)); }

struct EpiInProj {
    static constexpr bool PERM = true, AFTER_DRAIN = false;
    bf16_t *ZG, *XBC, *QK, *V, *HALO;
    __device__ __forceinline__ void operator()(const f32x4 (&acc)[2][2][4][2], const Unit& u, int wr, int wc, int fr, int fq) const {
        const int pn = u.pn; bf16_t* base; int ld, c0; bool halo = false;
        if (pn < 4) { base = ZG; ld = 2048; c0 = 256 * pn; }
        else if (pn < 12) { base = XBC; ld = 2048; c0 = 256 * (pn - 4); halo = true; }
        else if (pn < 16) { base = QK; ld = 1024; c0 = 256 * (pn - 12); }
        else if (pn < 20) { base = V; ld = 1024; c0 = 256 * (pn - 16); }
        else { base = ZG; ld = 2048; c0 = 1024 + 256 * (pn - 20); }
        const int row0 = u.pm * BM + wr * 64 + fr, col = c0 + wc * 32 + 8 * fq;
#pragma unroll
        for (int ai = 0; ai < 2; ++ai)
#pragma unroll
            for (int m = 0; m < 4; ++m) { const int r = row0 + ai * HALF + m * 16; bf16_t* rowp = base + (size_t)r * ld + col;
                const int rr = r & 31; const bool hrow = halo && (rr < 2 || rr >= 30);
#pragma unroll
                for (int bj = 0; bj < 2; ++bj) { const f32x4 v0 = acc[ai][bj][m][0], v1 = acc[ai][bj][m][1];
                    u32x4 w; w.x = cvt_pk_bf16(v0[0], v0[1]); w.y = cvt_pk_bf16(v0[2], v0[3]); w.z = cvt_pk_bf16(v1[0], v1[1]); w.w = cvt_pk_bf16(v1[2], v1[3]);
                    *(u32x4*)(rowp + bj * HALF) = w;
                    if (hrow) { const int slot = rr < 2 ? rr : rr - 28; *(u32x4*)(HALO + ((size_t)(r >> 5) * 4 + slot) * 2048 + col + bj * HALF) = w; } } }
    }
};
struct EpiSplit2 {
    static constexpr bool PERM = true, AFTER_DRAIN = false;
    bf16_t *O0, *O1; int ld, split_tiles;
    __device__ __forceinline__ void operator()(const f32x4 (&acc)[2][2][4][2], const Unit& u, int wr, int wc, int fr, int fq) const {
        bf16_t* base = u.pn < split_tiles ? O0 : O1; const int c0 = 256 * (u.pn < split_tiles ? u.pn : u.pn - split_tiles);
        const int row0 = u.pm * BM + wr * 64 + fr, col = c0 + wc * 32 + 8 * fq;
#pragma unroll
        for (int ai = 0; ai < 2; ++ai)
#pragma unroll
            for (int m = 0; m < 4; ++m) { bf16_t* rowp = base + (size_t)(row0 + ai * HALF + m * 16) * ld + col;
#pragma unroll
                for (int bj = 0; bj < 2; ++bj) { const f32x4 v0 = acc[ai][bj][m][0], v1 = acc[ai][bj][m][1];
                    u32x4 w; w.x = cvt_pk_bf16(v0[0], v0[1]); w.y = cvt_pk_bf16(v0[2], v0[3]); w.z = cvt_pk_bf16(v1[0], v1[1]); w.w = cvt_pk_bf16(v1[2], v1[3]);
                    *(u32x4*)(rowp + bj * HALF) = w; } }
    }
};
struct EpiSwiglu {
    static constexpr bool PERM = true, AFTER_DRAIN = false;
    bf16_t* O; int ld;
    __device__ __forceinline__ void operator()(const f32x4 (&acc)[2][2][4][2], const Unit& u, int wr, int wc, int fr, int fq) const {
        const int row0 = u.pm * BM + wr * 64 + fr, col = u.pn * HALF + wc * 32 + 8 * fq;
#pragma unroll
        for (int ai = 0; ai < 2; ++ai)
#pragma unroll
            for (int m = 0; m < 4; ++m) { bf16_t* rowp = O + (size_t)(row0 + ai * HALF + m * 16) * ld + col;
                float h[8];
#pragma unroll
                for (int n = 0; n < 2; ++n)
#pragma unroll
                    for (int j = 0; j < 4; ++j) h[4 * n + j] = fast_silu(acc[ai][0][m][n][j]) * acc[ai][1][m][n][j];
                u32x4 w; w.x = cvt_pk_bf16(h[0], h[1]); w.y = cvt_pk_bf16(h[2], h[3]); w.z = cvt_pk_bf16(h[4], h[5]); w.w = cvt_pk_bf16(h[6], h[7]);
                *(u32x4*)rowp = w; }
    }
};
struct EpiResid {
    static constexpr bool PERM = false, AFTER_DRAIN = false;
    const float *resC, *resL; float *outC, *outL; const float* gate; int row_off;
    __device__ __forceinline__ void operator()(const f32x4 (&acc)[2][2][4][2], const Unit& u, int wr, int wc, int fr, int fq) const {
        const int t0 = u.pm * BM + row_off; const float* res; float* out; const float* g; int rbase;
        if (t0 < 512) { res = resC; out = outC; g = gate; rbase = t0; }
        else { res = resL; out = outL; rbase = t0 - 512; g = gate + (size_t)(1 + (rbase >> 13)) * 6144; }
        const int row0 = rbase + wr * 64 + fr, col0 = u.pn * BM + wc * 32 + 4 * fq;
        f32x4 gv[2][2];
#pragma unroll
        for (int bj = 0; bj < 2; ++bj)
#pragma unroll
            for (int n = 0; n < 2; ++n) gv[bj][n] = *(const f32x4*)(g + col0 + bj * HALF + n * 16);
#pragma unroll
        for (int ai = 0; ai < 2; ++ai)
#pragma unroll
            for (int m = 0; m < 4; ++m) { const size_t off = (size_t)(row0 + ai * HALF + m * 16) * 1024 + col0;
#pragma unroll
                for (int bj = 0; bj < 2; ++bj)
#pragma unroll
                    for (int n = 0; n < 2; ++n) { const f32x4 bs = *(const f32x4*)(res + off + bj * HALF + n * 16);
                        *(f32x4*)(out + off + bj * HALF + n * 16) = bs + gv[bj][n] * acc[ai][bj][m][n]; }
                if (m & 1) asm volatile("" ::: "memory"); }
    }
};


template <class Epi, class Sched, bool ALIGN_EPI = false, bool SP2 = false>
__device__ __forceinline__ void gemm_phase(PG8_LAS unsigned char* lds, const Gemm g, const Sched& S, const Epi& E) {
    const int tid = threadIdx.x, wid = __builtin_amdgcn_readfirstlane(tid >> 6), lane = tid & 63, wr = wid >> 2, wc = wid & 3, fr = lane & 15, fq = lane >> 4;
    const int K = g.K, nt = K / BK;
    unsigned voffA[2], voffB[2];
#pragma unroll
    for (int i = 0; i < 2; ++i) { int R, C; stage_rc(tid * 16 + i * 8192, R, C); const int Rb = Epi::PERM ? ((R & ~31) + perm32(R & 31)) : R;
        voffA[i] = (unsigned)(R * K + C) * 2u; voffB[i] = (unsigned)(Rb * K + C) * 2u; }
    const size_t kstep = (size_t)(BK * 2);
    const size_t hstep = (size_t)HALF * K * 2;
    const size_t tstep = 2 * hstep;
    const unsigned ldsw = (unsigned)wid * 1024u;
    const int aoff = lds_byte(wr * 64 + fr, fq * 8), boff = lds_byte(wc * 32 + fr, fq * 8);
#define PG8_SA(b, h) (((b) * 2 + (h)) * HTB)
#define PG8_SB(b, h) ((4 + (b) * 2 + (h)) * HTB)
#define PG8_STAGE(bufoff, gbase, voff) do { _Pragma("unroll") for (int _i = 0; _i < 2; ++_i) \
        __builtin_amdgcn_global_load_lds((const unsigned*)((const char*)(gbase) + (voff)[_i]), (PG8_LAS unsigned*)(lds + (bufoff) + ldsw + _i * 8192), 16, 0, 0); } while (0)
#define PG8_LDA(dst, b, h) do { _Pragma("unroll") for (int m = 0; m < 4; ++m) _Pragma("unroll") for (int k = 0; k < 2; ++k) dst[m][k] = *(const PG8_LAS bf16x8*)(lds + PG8_SA(b, h) + aoff + m * 2048 + k * 1024); } while (0)
#define PG8_LDB(dst, b, h) do { _Pragma("unroll") for (int n = 0; n < 2; ++n) _Pragma("unroll") for (int k = 0; k < 2; ++k) dst[n][k] = *(const PG8_LAS bf16x8*)(lds + PG8_SB(b, h) + boff + n * 2048 + k * 1024); } while (0)
#define PG8_MMA(ai, bj, At, Bt) do { __builtin_amdgcn_s_setprio(1); _Pragma("unroll") for (int m = 0; m < 4; ++m) _Pragma("unroll") for (int n = 0; n < 2; ++n) _Pragma("unroll") for (int k = 0; k < 2; ++k) \
        acc[ai][bj][m][n] = __builtin_amdgcn_mfma_f32_16x16x32_bf16(Bt[n][k], At[m][k], acc[ai][bj][m][n], 0, 0, 0); __builtin_amdgcn_s_setprio(0); } while (0)
#define PG8_WAIT_V(n) asm volatile("s_waitcnt vmcnt(" #n ")" ::: "memory")
#define PG8_WAIT_L(n) asm volatile("s_waitcnt lgkmcnt(" #n ")" ::: "memory")
#define PG8_BAR __builtin_amdgcn_s_barrier()
#define PG8_SCHED __builtin_amdgcn_sched_barrier(0)
    Unit cur, nxt; int ui = 0;
    if (!S.next(0, cur)) return;
    f32x4 acc[2][2][4][2];
#pragma unroll
    for (int a = 0; a < 2; ++a)
#pragma unroll
        for (int b = 0; b < 2; ++b)
#pragma unroll
            for (int m = 0; m < 4; ++m)
#pragma unroll
                for (int n = 0; n < 2; ++n) acc[a][b][m][n] = (f32x4){0.f, 0.f, 0.f, 0.f};
    bf16x8 At[4][2], B0[2][2], B1[2][2];
    const char* cA = (const char*)g.A + (size_t)cur.pm * tstep; const char* cB = (const char*)g.Bt + (size_t)cur.pn * tstep;
    S.a_ready(cur);
    if constexpr (SP2) {
        PG8_STAGE(PG8_SB(0, 0), cB, voffB); PG8_STAGE(PG8_SB(0, 1), cB + hstep, voffB); PG8_STAGE(PG8_SA(0, 0), cA, voffA); PG8_STAGE(PG8_SA(0, 1), cA + hstep, voffA);
        if (wr == 1) PG8_BAR;
        PG8_WAIT_V(2); PG8_BAR;
        PG8_STAGE(PG8_SB(1, 0), cB + kstep, voffB); PG8_STAGE(PG8_SA(1, 0), cA + kstep, voffA); PG8_STAGE(PG8_SB(1, 1), cB + hstep + kstep, voffB);
        PG8_WAIT_V(6); PG8_BAR;
    } else {
        PG8_STAGE(PG8_SB(0, 0), cB, voffB); PG8_STAGE(PG8_SA(0, 0), cA, voffA); PG8_STAGE(PG8_SB(0, 1), cB + hstep, voffB); PG8_STAGE(PG8_SA(0, 1), cA + hstep, voffA);
        if (wr == 1) PG8_BAR;
        PG8_WAIT_V(4); PG8_BAR;
        PG8_STAGE(PG8_SB(1, 0), cB + kstep, voffB); PG8_STAGE(PG8_SA(1, 0), cA + kstep, voffA); PG8_STAGE(PG8_SB(1, 1), cB + hstep + kstep, voffB);
        PG8_WAIT_V(6); PG8_BAR;
    }
    for (;;) {
        const bool has_next = S.next(ui + 1, nxt);
        const char* nA = has_next ? (const char*)g.A + (size_t)nxt.pm * tstep : cA; const char* nB = has_next ? (const char*)g.Bt + (size_t)nxt.pn * tstep : cB;
        for (int t = 0; t < nt; t += 2) {
            const bool last = (t == nt - 2);
            const char* a1 = cA + (size_t)(t + 1) * kstep;
            const char* a2 = last ? nA : cA + (size_t)(t + 2) * kstep; const char* b2 = last ? nB : cB + (size_t)(t + 2) * kstep;
            const char* a3 = a2 + kstep; const char* b3 = b2 + kstep;
            if (last && has_next) S.a_ready(nxt);
            if constexpr (SP2) {
            PG8_LDB(B0, 0, 0); PG8_LDB(B1, 0, 1); PG8_SCHED; PG8_LDA(At, 0, 0); PG8_STAGE(PG8_SA(1, 1), a1 + hstep, voffA);
            PG8_WAIT_V(8); PG8_WAIT_L(0); PG8_BAR; PG8_MMA(0, 0, At, B0); PG8_MMA(0, 1, At, B1); PG8_BAR; PG8_SCHED;
            PG8_LDA(At, 0, 1); PG8_STAGE(PG8_SB(0, 0), b2, voffB); PG8_STAGE(PG8_SB(0, 1), b2 + hstep, voffB); PG8_STAGE(PG8_SA(0, 0), a2, voffA);
            PG8_WAIT_V(8); PG8_WAIT_L(0); PG8_BAR; PG8_MMA(1, 0, At, B0); PG8_MMA(1, 1, At, B1); PG8_BAR; PG8_SCHED;
            PG8_LDB(B0, 1, 0); PG8_LDB(B1, 1, 1); PG8_SCHED; PG8_LDA(At, 1, 0); PG8_STAGE(PG8_SA(0, 1), a2 + hstep, voffA);
            PG8_WAIT_V(8); PG8_WAIT_L(0); PG8_BAR; PG8_MMA(0, 0, At, B0); PG8_MMA(0, 1, At, B1); PG8_BAR; PG8_SCHED;
            PG8_LDA(At, 1, 1); PG8_STAGE(PG8_SB(1, 0), b3, voffB); PG8_STAGE(PG8_SB(1, 1), b3 + hstep, voffB); PG8_STAGE(PG8_SA(1, 0), a3, voffA);
            PG8_WAIT_V(8); PG8_WAIT_L(0); PG8_BAR; PG8_MMA(1, 0, At, B0); PG8_MMA(1, 1, At, B1); PG8_BAR; PG8_SCHED;
            } else {
            PG8_LDB(B0, 0, 0); PG8_SCHED; PG8_LDA(At, 0, 0); PG8_STAGE(PG8_SA(1, 1), a1 + hstep, voffA);
            PG8_WAIT_L(8); PG8_BAR; PG8_WAIT_L(0); PG8_MMA(0, 0, At, B0); PG8_BAR; PG8_SCHED;
            PG8_LDB(B1, 0, 1); PG8_STAGE(PG8_SB(0, 0), b2, voffB);
            PG8_BAR; PG8_WAIT_L(0); PG8_MMA(0, 1, At, B1); PG8_BAR;
            PG8_LDA(At, 0, 1); PG8_STAGE(PG8_SA(0, 0), a2, voffA);
            PG8_BAR; PG8_WAIT_L(0); PG8_MMA(1, 0, At, B0); PG8_BAR; PG8_SCHED;
            PG8_STAGE(PG8_SB(0, 1), b2 + hstep, voffB);
            PG8_WAIT_V(6); PG8_BAR; PG8_MMA(1, 1, At, B1); PG8_BAR;
            PG8_LDB(B0, 1, 0); PG8_SCHED; PG8_LDA(At, 1, 0); PG8_STAGE(PG8_SA(0, 1), a2 + hstep, voffA);
            PG8_WAIT_L(8); PG8_BAR; PG8_WAIT_L(0); PG8_MMA(0, 0, At, B0); PG8_BAR; PG8_SCHED;
            PG8_LDB(B1, 1, 1); PG8_STAGE(PG8_SB(1, 0), b3, voffB);
            PG8_BAR; PG8_WAIT_L(0); PG8_MMA(0, 1, At, B1); PG8_BAR;
            PG8_LDA(At, 1, 1); PG8_STAGE(PG8_SA(1, 0), a3, voffA);
            PG8_BAR; PG8_WAIT_L(0); PG8_MMA(1, 0, At, B0); PG8_BAR; PG8_SCHED;
            PG8_STAGE(PG8_SB(1, 1), b3 + hstep, voffB);
            PG8_WAIT_V(6); PG8_BAR; PG8_MMA(1, 1, At, B1); PG8_BAR;
            }
        }
        if constexpr (ALIGN_EPI) { if (wr == 0) PG8_BAR; }
        if constexpr (!Epi::AFTER_DRAIN) { E(acc, cur, wr, wc, fr, fq); S.done(cur); }
        if (!has_next) break;
#pragma unroll
        for (int a = 0; a < 2; ++a)
#pragma unroll
            for (int b = 0; b < 2; ++b)
#pragma unroll
                for (int m = 0; m < 4; ++m)
#pragma unroll
                    for (int n = 0; n < 2; ++n) acc[a][b][m][n] = (f32x4){0.f, 0.f, 0.f, 0.f};
        cur = nxt; cA = nA; cB = nB; ++ui;
        if constexpr (ALIGN_EPI) { if (wr == 1) PG8_BAR; }
    }
    PG8_WAIT_V(0);
    if constexpr (!ALIGN_EPI) { if (wr == 0) PG8_BAR; }
    PG8_BAR;
    if constexpr (Epi::AFTER_DRAIN) { E.fused(acc, cur, wr, wc, fr, fq, lds, wid, lane); S.done(cur); }
#undef PG8_SA
#undef PG8_SB
#undef PG8_STAGE
#undef PG8_LDA
#undef PG8_LDB
#undef PG8_MMA
#undef PG8_WAIT_V
#undef PG8_WAIT_L
#undef PG8_BAR
#undef PG8_SCHED
}
}


constexpr int NWAVES = 8;
constexpr int DM = 1024, SEQ = 8192, CTXL = 256, NB = 2;
constexpr int R = NB * (SEQ + CTXL);
constexpr int RL0 = NB * CTXL;
constexpr int MLAT = NB * SEQ;
constexpr int FFH = 2816;
constexpr int ABIN = 6160;
constexpr float RMS_EPS = 1e-6f, LN_EPS = 1e-5f;

constexpr size_t MiB = 1u << 20;
constexpr size_t WS_CTL = 0, CTL_ZERO_BYTES = 1 * MiB;
constexpr size_t CTL_MOD = 256 * 1024;
constexpr size_t WS_XCTX = 1 * MiB;
constexpr size_t WS_DTRAW = 3 * MiB, WS_DTF = WS_DTRAW + 1280 * 1024, WS_DTB = WS_DTF + 1280 * 1024, WS_CSF = WS_DTB + 1280 * 1024, WS_RB = WS_CSF + 1280 * 1024;
constexpr size_t WS_WQK = 9 * MiB + 256 * 1024;
constexpr size_t WS_HALO = 9 * MiB + 512 * 1024;
constexpr size_t WS_W_IN = 18 * MiB, WS_W_OUT = 30 * MiB, WS_W_F1 = 34 * MiB, WS_W_F2 = 45 * MiB;
constexpr size_t WS_ZG = 51 * MiB, WS_XBC = 117 * MiB, WS_QK = 183 * MiB, WS_V = 216 * MiB;
constexpr size_t WS_HF0 = WS_V, WS_HH0 = WS_XBC;
constexpr size_t WS_GATE = 3 * MiB, WS_BC = WS_GATE + 1280 * 1024, WS_AJ = WS_BC + 768 * 1024, WS_CM = WS_AJ + 768 * 1024, WS_CH = WS_CM + 768 * 1024, WS_NV = WS_CH + 256 * 1024;
constexpr size_t WS_W_UP = 10 * MiB, WS_H1 = 18 * MiB, WS_XC = 18 * MiB, WS_XM = 51 * MiB, WS_Z = 117 * MiB, WS_ST1 = 183 * MiB;
constexpr size_t WS_W_DN = 53 * MiB, WS_W_F1B = 57 * MiB, WS_W_F2B = 68 * MiB;
constexpr size_t WS_HF1 = WS_Z, WS_HH1 = 150 * MiB;
constexpr size_t WS_END = 256 * MiB;
constexpr size_t DO_H = 0, DO_ST_SSD = 0, DO_ST_RET = 16 * MiB;
constexpr int CW_TMO = 0, CW_CODE = 1, CW_BAR = 4096;

constexpr int RING_BYTES = 131072;
constexpr int SCR_BYTES = 143360;
constexpr int LDSCTL_OFF = SCR_BYTES, MISC_OFF = LDSCTL_OFF + 320;
constexpr int LDS_BYTES = 147456;

#define GAS __attribute__((address_space(1)))
#define LAS __attribute__((address_space(3)))
typedef unsigned short bf16;
typedef unsigned v4u __attribute__((ext_vector_type(4)));
typedef unsigned v2u __attribute__((ext_vector_type(2)));
typedef float f32x4 __attribute__((ext_vector_type(4)));
typedef short bf16x8 __attribute__((ext_vector_type(8)));
typedef short s16x4 __attribute__((ext_vector_type(4)));
typedef GAS unsigned gu32;
#define RLX_AGENT __ATOMIC_RELAXED, __HIP_MEMORY_SCOPE_AGENT
#define LDS_WAIT() asm volatile("s_waitcnt lgkmcnt(0)" ::: "memory")
#define VM_WAIT() asm volatile("s_waitcnt vmcnt(0)" ::: "memory")
__device__ __forceinline__ unsigned f2bf(float f) { unsigned u = __builtin_bit_cast(unsigned, f); return (u + 0x7fffu + ((u >> 16) & 1u)) >> 16; }
__device__ __forceinline__ unsigned pk2(float lo, float hi) { return f2bf(lo) | (f2bf(hi) << 16); }
__device__ __forceinline__ float bf2f(unsigned short h) { return __builtin_bit_cast(float, (unsigned)h << 16); }
__device__ __forceinline__ float bflo(unsigned w) { return __builtin_bit_cast(float, w << 16); }
__device__ __forceinline__ float bfhi(unsigned w) { return __builtin_bit_cast(float, w & 0xffff0000u); }
__device__ __forceinline__ float silu_f(float a) { return a / (1.0f + __expf(-a)); }
__device__ __forceinline__ float softplus_f(float x) { return x > 20.f ? x : log1pf(__expf(x)); }
__device__ __forceinline__ float logsig_f(float x) { return x >= 0.f ? -log1pf(__expf(-x)) : x - log1pf(__expf(x)); }
__device__ __forceinline__ float wave_sum(float v) {
#pragma unroll
    for (int o = 1; o < 64; o <<= 1) v += __shfl_xor(v, o);
    return v;
}
__device__ __forceinline__ float wave_max(float v) {
#pragma unroll
    for (int o = 1; o < 64; o <<= 1) v = fmaxf(v, __shfl_xor(v, o));
    return v;
}

#define XB_TMO      128
#define XB_XCNT(j)  (256  + 64 * (j))
#define XB_XSUB(j)  (1280 + 64 * (j))
#define XB_XGEN(j)  (2304 + 64 * (j))
#define XB_TOP      3328
#define XB_TOPGEN   3392
#define XCD_BAR_WORDS 3456
#define XB_SPIN_CAP (1u << 18)

__device__ __forceinline__ unsigned xb_ld(unsigned* p)              { return __hip_atomic_load(p, __ATOMIC_RELAXED, __HIP_MEMORY_SCOPE_AGENT); }
__device__ __forceinline__ unsigned xb_add(unsigned* p, unsigned v) { return __hip_atomic_fetch_add(p, v, __ATOMIC_RELAXED, __HIP_MEMORY_SCOPE_AGENT); }
__device__ __forceinline__ unsigned xb_xcc_id() { return (unsigned)__builtin_amdgcn_s_getreg((3 << 11) | 20) & 0xFu; }
#define XB_SPIN(cond, bar) do { unsigned _sp = 0; while (cond) { __builtin_amdgcn_s_sleep(1); \
    if ((++_sp & 255u) == 0u) { if (xb_ld(&(bar)[XB_TMO])) break; if (_sp > XB_SPIN_CAP) { atomicAdd(&(bar)[XB_TMO], 1u); break; } } } } while (0)

struct XcdBarrier {
    unsigned* bar; unsigned x;
    volatile LAS unsigned* st;
};

__device__ __forceinline__ XcdBarrier xcd_barrier_post(unsigned* bar, volatile LAS unsigned* st) {
    XcdBarrier b; b.bar = bar; b.x = xb_xcc_id(); b.st = st;
    if (threadIdx.x == 0) (void)xb_add(&bar[XB_XCNT(b.x)], 1u);
    return b;
}
__device__ __forceinline__ void xcd_barrier_complete(unsigned* bar, unsigned x, unsigned& nloc, unsigned& nx) {
    const unsigned G = gridDim.x * gridDim.y * gridDim.z;
    unsigned sum, cnt, mine, sp = 0u;
    for (;;) {
        sum = 0u; cnt = 0u; mine = 0u;
#pragma unroll
        for (unsigned j = 0; j < 16; ++j) { const unsigned c = xb_ld(&bar[XB_XCNT(j)]); sum += c; cnt += (c > 0u) ? 1u : 0u; mine = (j == x) ? c : mine; }
        if (sum == G) break;
        __builtin_amdgcn_s_sleep(1);
        if ((++sp & 255u) == 0u) { if (xb_ld(&bar[XB_TMO])) break; if (sp > XB_SPIN_CAP) { atomicAdd(&bar[XB_TMO], 1u); break; } }
    }
    nloc = mine > 0u ? mine : 1u; nx = cnt > 0u ? cnt : 1u;
}

__device__ __forceinline__ void xcd_barrier(const XcdBarrier& b) {
    asm volatile("s_waitcnt vmcnt(0)" ::: "memory");
    __syncthreads();
    if (threadIdx.x == 0) {
        unsigned* bar = b.bar;
        __builtin_amdgcn_s_waitcnt(0);
        unsigned nloc = b.st[0], nx = b.st[1];
        if (nloc == 0u) { xcd_barrier_complete(bar, b.x, nloc, nx); b.st[0] = nloc; b.st[1] = nx; }
        const unsigned old = xb_add(&bar[XB_XSUB(b.x)], 1u);
        const unsigned gen = old / nloc;
        if (old + 1u == (gen + 1u) * nloc) {
            __builtin_amdgcn_fence(__ATOMIC_RELEASE, "agent");
            asm volatile("s_waitcnt vmcnt(0)" ::: "memory");
            const unsigned og = xb_add(&bar[XB_TOP], 1u);
            const unsigned tg = og / nx;
            if (og + 1u == (tg + 1u) * nx) xb_add(&bar[XB_TOPGEN], 1u);
            else XB_SPIN(xb_ld(&bar[XB_TOPGEN]) == tg, bar);
            __builtin_amdgcn_fence(__ATOMIC_ACQUIRE, "agent");
            xb_add(&bar[XB_XGEN(b.x)], 1u);
            asm volatile("s_waitcnt vmcnt(0)" ::: "memory");
        } else {
            XB_SPIN(xb_ld(&bar[XB_XGEN(b.x)]) == gen, bar);
            __builtin_amdgcn_fence(__ATOMIC_ACQUIRE, "agent");
            asm volatile("s_waitcnt vmcnt(0)" ::: "memory");
        }
    }
    __syncthreads();
}


struct Args { const float* in[35]; float* out; unsigned char* ws; int ph_lo, ph_hi; };
enum { I_X = 0, I_C, I_CTX, I_CCTX, I_ADAW, I_ADAB, I_NMIX, I_NFFN, I_W1, I_W3, I_W2, I_ABIN, I_ABCW, I_ABCB, I_DTBF, I_DTBB, I_ALF, I_ALB, I_SSDD, I_SSDNW,
       I_RLF, I_RLB, I_ABOUT, I_MLUP, I_MLCW, I_MLCB, I_MLWQ, I_MLWK, I_MLWV, I_MLGW, I_MLGB, I_MLNW, I_MLSKIP, I_MLDOWN, I_FNW };

__device__ __forceinline__ void transpose_item(const float* W, int ldw, int K, bf16* WT, int kb, int src_n0, int dst_n0, LAS float* scr, int lane) {
    const int k0 = 64 * kb;
#pragma unroll 8
    for (int i = 0; i < 32; ++i) { const int kk = 2 * i + (lane >> 5); scr[kk * 33 + (lane & 31)] = W[(size_t)(k0 + kk) * ldw + src_n0 + (lane & 31)]; }
    LDS_WAIT(); asm volatile("" ::: "memory");
    const int c = lane & 7;
#pragma unroll
    for (int j = 0; j < 4; ++j) { const int n = (lane >> 3) + 8 * j; const LAS float* s = scr + (8 * c) * 33 + n;
        v4u o; o.x = pk2(s[0 * 33], s[1 * 33]); o.y = pk2(s[2 * 33], s[3 * 33]); o.z = pk2(s[4 * 33], s[5 * 33]); o.w = pk2(s[6 * 33], s[7 * 33]);
        *(GAS v4u*)(WT + (size_t)(dst_n0 + n) * K + k0 + 8 * c) = o; }
    LDS_WAIT(); asm volatile("" ::: "memory");
}
__device__ __forceinline__ void conv_plain(const float* W, int K, int N, bf16* WT, LAS float* scr, int gw, int NGW, int lane) {
    const int nblk = N / 32, nit = (K / 64) * nblk;
    for (int it = gw; it < nit; it += NGW) { const int kb = it / nblk, nb = it % nblk; transpose_item(W, N, K, WT, kb, 32 * nb, 32 * nb, scr, lane); }
}
__device__ __forceinline__ void conv_ffn1(const float* w1, const float* w3, bf16* WT, LAS float* scr, int gw, int NGW, int lane) {
    const int nblk = 5632 / 32, nit = (1024 / 64) * nblk;
    for (int it = gw; it < nit; it += NGW) { const int kb = it / nblk, nb = it % nblk; const int n0 = 32 * nb, pn = n0 >> 8, within = n0 & 255;
        const float* W = within < 128 ? w1 : w3; const int sc = 128 * pn + (within & 127);
        transpose_item(W, FFH, 1024, WT, kb, sc, n0, scr, lane); }
}
__device__ __forceinline__ void conv_abin(const float* W, bf16* WT, LAS float* scr, int gw, int NGW, int lane) {
    const int nblk = 6144 / 32, nit = (1024 / 64) * nblk;
    for (int it = gw; it < nit; it += NGW) { const int kb = it / nblk, nb = it % nblk; const int n0 = 32 * nb;
        transpose_item(W, ABIN, 1024, WT, kb, n0 + (n0 >= 3072 ? 16 : 0), n0, scr, lane); }
}

template <bool WITH_DT>
__device__ __forceinline__ void norm_rows(const float* srcC, const float* srcL, const float* w, const float* mod, int si, bf16* dst, int dst_off, int row_lo, int row_hi,
                                          int gw, int NGW, int lane, const LAS float* wdt, float* dtraw) {
    for (int m = row_lo + gw; m < row_hi; m += NGW) {
        const float* src = m < RL0 ? srcC + (size_t)m * DM : srcL + (size_t)(m - RL0) * DM;
        const float* mv = mod + (size_t)(m < RL0 ? 0 : 1 + ((m - RL0) >> 13)) * 6144 + si * 1024;
        f32x4 v[4]; float ss = 0.f;
#pragma unroll
        for (int j = 0; j < 4; ++j) { v[j] = *(const f32x4*)(src + 4 * lane + 256 * j); ss += (v[j].x * v[j].x + v[j].y * v[j].y) + (v[j].z * v[j].z + v[j].w * v[j].w); }
        const float rstd = 1.0f / sqrtf(wave_sum(ss) * (1.f / DM) + RMS_EPS);
#pragma unroll
        for (int j = 0; j < 4; ++j) { const int c = 4 * lane + 256 * j; const f32x4 wv = *(const f32x4*)(w + c), sh = *(const f32x4*)(mv + c), sc = *(const f32x4*)(mv + 1024 + c);
            v[j] = (v[j] * rstd * wv) * (sc + 1.0f) + sh;
            v2u o; o.x = pk2(v[j].x, v[j].y); o.y = pk2(v[j].z, v[j].w);
            *(v2u*)(dst + (size_t)(m - dst_off) * DM + c) = o; }
        if constexpr (WITH_DT) {
            float d[16];
#pragma unroll
            for (int c = 0; c < 16; ++c) d[c] = 0.f;
#pragma unroll
            for (int j = 0; j < 4; ++j) {
#pragma unroll
                for (int e = 0; e < 4; ++e) { const int k = 4 * lane + 256 * j + e; const float hv = v[j][e]; const LAS f32x4* wp = (const LAS f32x4*)(wdt + k * 16);
                    const f32x4 w0 = wp[0], w1 = wp[1], w2 = wp[2], w3 = wp[3];
                    d[0] += hv * w0.x; d[1] += hv * w0.y; d[2] += hv * w0.z; d[3] += hv * w0.w; d[4] += hv * w1.x; d[5] += hv * w1.y; d[6] += hv * w1.z; d[7] += hv * w1.w;
                    d[8] += hv * w2.x; d[9] += hv * w2.y; d[10] += hv * w2.z; d[11] += hv * w2.w; d[12] += hv * w3.x; d[13] += hv * w3.y; d[14] += hv * w3.z; d[15] += hv * w3.w; }
                asm volatile("" ::: "memory");
            }
            float mine = 0.f;
#pragma unroll
            for (int c = 0; c < 16; ++c) { const float s = wave_sum(d[c]); if (lane == c) mine = s; }
            if (lane < 16) dtraw[(size_t)m * 16 + lane] = mine;
        }
    }
}


#define MFMA16(a, b, c) __builtin_amdgcn_mfma_f32_16x16x32_bf16(a, b, c, 0, 0, 0)
__device__ __forceinline__ bf16x8 frag_nat(const LAS unsigned char* base, int pitch, int r0, int k0, int lane) {
    return *(const LAS bf16x8*)(base + (r0 + (lane & 15)) * pitch + (k0 + 8 * (lane >> 4)) * 2);
}
__device__ __forceinline__ bf16x8 frag_tr(const LAS unsigned char* base, int pitch, int k0, int i0, int lane) {
    const int g = lane >> 4, q = (lane & 15) >> 2, p = lane & 3;
    const LAS unsigned char* a = base + (k0 + 8 * g + q) * pitch + (i0 + 4 * p) * 2;
    const s16x4 lo = __builtin_bit_cast(s16x4, __builtin_amdgcn_ds_read_tr16_b64_v4i16((LAS s16x4*)a));
    const s16x4 hi = __builtin_bit_cast(s16x4, __builtin_amdgcn_ds_read_tr16_b64_v4i16((LAS s16x4*)(a + 4 * pitch)));
    bf16x8 r; r[0] = lo[0]; r[1] = lo[1]; r[2] = lo[2]; r[3] = lo[3]; r[4] = hi[0]; r[5] = hi[1]; r[6] = hi[2]; r[7] = hi[3]; return r;
}
__device__ __forceinline__ v2u pack4(f32x4 v) { v2u o; o.x = pk2(v.x, v.y); o.y = pk2(v.z, v.w); return o; }
__device__ __forceinline__ f32x4 unpack4(v2u w) { f32x4 r; r.x = bflo(w.x); r.y = bfhi(w.x); r.z = bflo(w.y); r.w = bfhi(w.y); return r; }
__device__ __forceinline__ v4u scale8(v4u x, float s) { v4u o; o.x = pk2(bflo(x.x) * s, bfhi(x.x) * s); o.y = pk2(bflo(x.y) * s, bfhi(x.y) * s); o.z = pk2(bflo(x.z) * s, bfhi(x.z) * s); o.w = pk2(bflo(x.w) * s, bfhi(x.w) * s); return o; }

__device__ __forceinline__ void chunk_rows(int ci, int& base, int& L) { if (ci < 2) { base = 256 * ci; L = 256; } else { base = RL0 + 512 * (ci - 2); L = 512; } }

__device__ __forceinline__ void conv8(const v4u (&x)[5], const float (&cw)[5][8], const float (&cb)[8], v4u& out) {
    float o[8];
#pragma unroll
    for (int c = 0; c < 8; ++c) o[c] = cb[c];
#pragma unroll
    for (int k = 0; k < 5; ++k) { const v4u v = x[k];
        o[0] += cw[k][0] * bflo(v.x); o[1] += cw[k][1] * bfhi(v.x); o[2] += cw[k][2] * bflo(v.y); o[3] += cw[k][3] * bfhi(v.y);
        o[4] += cw[k][4] * bflo(v.z); o[5] += cw[k][5] * bfhi(v.z); o[6] += cw[k][6] * bflo(v.w); o[7] += cw[k][7] * bfhi(v.w); }
#pragma unroll
    for (int c = 0; c < 8; ++c) o[c] = silu_f(o[c]);
    out.x = pk2(o[0], o[1]); out.y = pk2(o[2], o[3]); out.z = pk2(o[4], o[5]); out.w = pk2(o[6], o[7]);
}
__device__ __forceinline__ void phase_l0_prep(const Args& args, unsigned char* ws, LAS unsigned char* lds, int tid, int lane, int wave, int bx, int G, int gw, int NGW) {
    bf16* XBC = (bf16*)(ws + WS_XBC); const bf16* HALO = (const bf16*)(ws + WS_HALO);
    {
        const int cg = tid & 255, c0 = 8 * cg;
        float cw[5][8], cb[8];
#pragma unroll
        for (int k = 0; k < 5; ++k)
#pragma unroll
            for (int c = 0; c < 8; ++c) cw[k][c] = args.in[I_ABCW][k * 2048 + c0 + c];
#pragma unroll
        for (int c = 0; c < 8; ++c) cb[c] = args.in[I_ABCB][c0 + c];
        for (int u = bx; u < 264; u += G) {
            const int blk = 2 * u + (tid >> 8), r0 = 32 * blk;
            int slo, shi; if (r0 < RL0) { slo = r0 & ~255; shi = slo + 256; } else { slo = RL0 + ((r0 - RL0) & ~8191); shi = slo + 8192; }
            const v4u zero = (v4u){0u, 0u, 0u, 0u};
            v4u raw[20];
            raw[0] = r0 > slo ? *(const v4u*)(HALO + ((size_t)(blk - 1) * 4 + 2) * 2048 + c0) : zero;
            raw[1] = r0 > slo ? *(const v4u*)(HALO + ((size_t)(blk - 1) * 4 + 3) * 2048 + c0) : zero;
#pragma unroll
            for (int t = 0; t < 18; ++t) raw[2 + t] = *(const v4u*)(XBC + (size_t)(r0 + t) * 2048 + c0);
#pragma unroll
            for (int t = 0; t < 16; ++t) { v4u x5[5] = {raw[t], raw[t + 1], raw[t + 2], raw[t + 3], raw[t + 4]}; v4u o; conv8(x5, cw, cb, o); *(v4u*)(XBC + (size_t)(r0 + t) * 2048 + c0) = o; }
            raw[0] = raw[16]; raw[1] = raw[17]; raw[2] = raw[18]; raw[3] = raw[19];
#pragma unroll
            for (int t = 0; t < 14; ++t) raw[4 + t] = *(const v4u*)(XBC + (size_t)(r0 + 18 + t) * 2048 + c0);
            raw[18] = r0 + 32 < shi ? *(const v4u*)(HALO + ((size_t)(blk + 1) * 4 + 0) * 2048 + c0) : zero;
            raw[19] = r0 + 32 < shi ? *(const v4u*)(HALO + ((size_t)(blk + 1) * 4 + 1) * 2048 + c0) : zero;
#pragma unroll
            for (int t = 0; t < 16; ++t) { v4u x5[5] = {raw[t], raw[t + 1], raw[t + 2], raw[t + 3], raw[t + 4]}; v4u o; conv8(x5, cw, cb, o); *(v4u*)(XBC + (size_t)(r0 + 16 + t) * 2048 + c0) = o; }
        }
    }
    {
        bf16* QK = (bf16*)(ws + WS_QK);
        const float inv = exp2f(-(float)(lane & 31) * (13.287712379549449f / 32.0f));
        for (int m = gw; m < R; m += NGW) {
            bf16* row = QK + (size_t)m * 1024;
            float cs = 1.f, sn = 0.f;
            if (m >= RL0) { const int t = (m - RL0) & 8191; const float ang = (float)(lane < 32 ? (t >> 6) : (t & 63)) * inv; sincosf(ang, &sn, &cs); }
#pragma unroll
            for (int hh = 0; hh < 8; ++hh) { const float x1 = bf2f(row[128 * hh + lane]), x2 = bf2f(row[128 * hh + 64 + lane]); const float sc = hh >= 4 ? 0.08838834764831845f : 1.0f;
                row[128 * hh + lane] = (bf16)f2bf((x1 * cs - x2 * sn) * sc); row[128 * hh + 64 + lane] = (bf16)f2bf((x1 * sn + x2 * cs) * sc); }
        }
    }
    {
        const float* dtraw = (const float*)(ws + WS_DTRAW); float* DTF = (float*)(ws + WS_DTF); float* DTB = (float*)(ws + WS_DTB); float* CSF = (float*)(ws + WS_CSF); float* RBA = (float*)(ws + WS_RB);
        for (int wu = gw; wu < 34 * 16; wu += NGW) {
            const int ci = wu >> 4, h = wu & 15; int base, L; chunk_rows(ci, base, L);
            const float bf_ = args.in[I_DTBF][h], bb_ = args.in[I_DTBB][h], af = __expf(args.in[I_ALF][h]), ab = __expf(args.in[I_ALB][h]);
            const int per = L >> 6, t0 = lane * per;
            float dtf[8], dtb[8], laf[8], lab[8]; float sf = 0.f, sb = 0.f;
#pragma unroll
            for (int t = 0; t < 8; ++t) if (t < per) { const float rawv = dtraw[(size_t)(base + t0 + t) * 16 + h]; dtf[t] = softplus_f(rawv + bf_); dtb[t] = softplus_f(rawv + bb_); laf[t] = -dtf[t] * af; lab[t] = -dtb[t] * ab; sf += laf[t]; sb += lab[t]; }
            float pf = sf, pb = sb;
#pragma unroll
            for (int o = 1; o < 64; o <<= 1) { const float a = __shfl_up(pf, o), c = __shfl_down(pb, o); if (lane >= o) pf += a; if (lane + o < 64) pb += c; }
            float runf = pf - sf;
#pragma unroll
            for (int t = 0; t < 8; ++t) if (t < per) { runf += laf[t]; const size_t o = (size_t)(base + t0 + t) * 16 + h; CSF[o] = runf; DTF[o] = dtf[t]; DTB[o] = dtb[t]; }
            float runb = pb - sb;
#pragma unroll
            for (int t = 7; t >= 0; --t) if (t < per) { runb += lab[t]; RBA[(size_t)(base + t0 + t) * 16 + h] = runb; }
        }
    }
}

constexpr int SCAN_PITCH = 144;
__device__ __forceinline__ void phase_l0_scan(const Args& args, unsigned char* ws, unsigned char* dob, LAS unsigned char* lds, int tid, int lane, int wave, int bx, int G) {
    LAS unsigned char* Kt = lds; LAS unsigned char* Vt = lds + 128 * SCAN_PITCH;
    const float* DTF = (const float*)(ws + WS_DTF); const float* DTB = (const float*)(ws + WS_DTB); const float* CSF = (const float*)(ws + WS_CSF); const float* RBA = (const float*)(ws + WS_RB);
    for (int u = bx; u < 256; u += G) {
        const bool ssd = u < 128; int b, dir, h; const bf16* Ksrc; const bf16* Vsrc; int ld; bf16* Sout; int stS; float lg = 0.f;
        if (ssd) { const int s = u >> 1, nt = u & 1; b = s >> 5; dir = (s >> 4) & 1; h = s & 15; ld = 2048;
            Ksrc = (const bf16*)(ws + WS_XBC) + 1024 + 128 * (h >> 2) + 64 * nt; Vsrc = (const bf16*)(ws + WS_XBC) + 64 * h;
            Sout = (bf16*)(dob + DO_ST_SSD) + (size_t)s * 16 * 8192 + 64 * nt; stS = 128; }
        else { const int v = u - 128, s = v >> 3, t = v & 7, et = t >> 1, dt = t & 1; b = s >> 3; dir = (s >> 2) & 1; h = s & 3; ld = 1024;
            Ksrc = (const bf16*)(ws + WS_QK) + 512 + 128 * h + 64 * dt; Vsrc = (const bf16*)(ws + WS_V) + 256 * h + 64 * et;
            Sout = (bf16*)(dob + DO_ST_RET) + (size_t)s * 16 * 32768 + (size_t)(64 * et) * 128 + 64 * dt; stS = 128;
            lg = logsig_f(args.in[dir ? I_RLB : I_RLF][h]); }
        const size_t kstride = ssd ? 8192 : 32768;
        const int wd = wave & 3, we = wave >> 2;
        f32x4 acc[2] = {(f32x4){0.f, 0.f, 0.f, 0.f}, (f32x4){0.f, 0.f, 0.f, 0.f}};
        const int srow = tid >> 2, sc16 = tid & 3;
        for (int step = 0; step < 17; ++step) {
            int base, L, k = -1;
            if (step == 0) { base = 256 * b; L = 256; } else { k = dir ? 16 - step : step - 1; base = RL0 + 8192 * b + 512 * k; L = 512; }
            if (k >= 0) {
#pragma unroll
                for (int t2 = 0; t2 < 2; ++t2) { const int e = 32 * we + 16 * t2 + (lane & 15), d = 16 * wd + 4 * (lane >> 4);
                    *(v2u*)(Sout + (size_t)k * kstride + (size_t)e * stS + d) = pack4(acc[t2]); }
                if (step == 16) break;
            }
            float A, wref;
            if (ssd) { wref = dir ? RBA[(size_t)base * 16 + h] : CSF[(size_t)(base + L - 1) * 16 + h]; A = __expf(wref); }
            else { A = __expf((float)L * lg); wref = 0.f; }
            acc[0] = acc[0] * A; acc[1] = acc[1] * A;
            for (int t0 = 0; t0 < L; t0 += 128) {
                const int r = base + t0 + srow, jl = t0 + srow;
                float w;
                if (ssd) w = dir ? __expf(wref - RBA[(size_t)r * 16 + h]) * DTB[(size_t)r * 16 + h] : __expf(wref - CSF[(size_t)r * 16 + h]) * DTF[(size_t)r * 16 + h];
                else w = dir ? __expf((float)jl * lg) : __expf((float)(L - 1 - jl) * lg);
                const v4u k0 = *(const v4u*)(Ksrc + (size_t)r * ld + 16 * sc16), k1 = *(const v4u*)(Ksrc + (size_t)r * ld + 16 * sc16 + 8);
                const v4u v0 = *(const v4u*)(Vsrc + (size_t)r * ld + 16 * sc16), v1 = *(const v4u*)(Vsrc + (size_t)r * ld + 16 * sc16 + 8);
                __syncthreads();
                *(LAS v4u*)(Kt + srow * SCAN_PITCH + 32 * sc16) = scale8(k0, w); *(LAS v4u*)(Kt + srow * SCAN_PITCH + 32 * sc16 + 16) = scale8(k1, w);
                *(LAS v4u*)(Vt + srow * SCAN_PITCH + 32 * sc16) = v0; *(LAS v4u*)(Vt + srow * SCAN_PITCH + 32 * sc16 + 16) = v1;
                __syncthreads();
#pragma unroll
                for (int kk = 0; kk < 4; ++kk) { const bf16x8 a = frag_tr(Kt, SCAN_PITCH, 32 * kk, 16 * wd, lane);
#pragma unroll
                    for (int t2 = 0; t2 < 2; ++t2) { const bf16x8 bb = frag_tr(Vt, SCAN_PITCH, 32 * kk, 32 * we + 16 * t2, lane); acc[t2] = MFMA16(a, bb, acc[t2]); } }
            }
        }
        __syncthreads();
    }
}


constexpr int Y_KT = 0, Y_VT = 17408, Y_MT = 51200, Y_SC = 69632, Y_ST = 73728;
constexpr int P272 = 272, P528 = 528, P144 = 144;
__device__ __forceinline__ void phase_l0_y(const Args& args, unsigned char* ws, unsigned char* dob, LAS unsigned char* lds, int tid, int lane, int wave, int bx, int G) {
    LAS unsigned char* Kt = lds + Y_KT; LAS unsigned char* Vt = lds + Y_VT; LAS unsigned char* Mt = lds + Y_MT; LAS float* SC = (LAS float*)(lds + Y_SC); LAS unsigned char* St = lds + Y_ST;
    bf16* ZG = (bf16*)(ws + WS_ZG); const bf16* XBC = (const bf16*)(ws + WS_XBC); const bf16* QK = (const bf16*)(ws + WS_QK); const bf16* VV = (const bf16*)(ws + WS_V);
    const float* DTF = (const float*)(ws + WS_DTF); const float* DTB = (const float*)(ws + WS_DTB); const float* CSF = (const float*)(ws + WS_CSF); const float* RBA = (const float*)(ws + WS_RB);
    const int fr = lane & 15, fq = lane >> 4;
    for (int u = bx; u < 1056; u += G) {
        const bool ssd = u < 528; const int idx = ssd ? u : u - 528; const int grp = idx & 3, br = idx >> 2, b = br / 66, rbk = br % 66;
        int cb0, L, i0, kchunk = -1;
        if (rbk < 2) { cb0 = 256 * b; L = 256; i0 = 128 * rbk; } else { const int lk = rbk - 2; kchunk = lk >> 2; cb0 = RL0 + 8192 * b + 512 * kchunk; L = 512; i0 = 128 * (lk & 3); }
        const int il = i0 + 16 * wave + fr;
        const int row = cb0 + il;
        const int nkb = L >> 6;
        if (ssd) {
            const int g = grp;
            bf16x8 cf[4];
#pragma unroll
            for (int kk = 0; kk < 4; ++kk) cf[kk] = *(const bf16x8*)(XBC + (size_t)row * 2048 + 1536 + 128 * g + 32 * kk + 8 * fq);
            float csi[4], rbi[4];
#pragma unroll
            for (int hh = 0; hh < 4; ++hh) { csi[hh] = CSF[(size_t)row * 16 + 4 * g + hh]; rbi[hh] = RBA[(size_t)row * 16 + 4 * g + hh]; }
            f32x4 acc[4][4];
#pragma unroll
            for (int hh = 0; hh < 4; ++hh)
#pragma unroll
                for (int pt = 0; pt < 4; ++pt) acc[hh][pt] = (f32x4){0.f, 0.f, 0.f, 0.f};
            for (int kb = 0; kb < nkb; ++kb) {
                __syncthreads();
                const int krow0 = cb0 + 64 * kb;
#pragma unroll
                for (int c = 0; c < 2; ++c) { const int ch = tid + 512 * c, r = ch >> 4, cc = ch & 15; *(LAS v4u*)(Kt + r * P272 + 16 * cc) = *(const v4u*)(XBC + (size_t)(krow0 + r) * 2048 + 1024 + 128 * g + 8 * cc); }
#pragma unroll
                for (int c = 0; c < 4; ++c) { const int ch = tid + 512 * c, r = ch >> 5, cc = ch & 31; *(LAS v4u*)(Vt + r * P528 + 16 * cc) = *(const v4u*)(XBC + (size_t)(krow0 + r) * 2048 + 256 * g + 8 * cc); }
                if (tid < 256) { const int r = tid >> 2, hh = tid & 3; const size_t o = (size_t)(krow0 + r) * 16 + 4 * g + hh;
                    SC[0 * 256 + r * 4 + hh] = CSF[o]; SC[1 * 256 + r * 4 + hh] = RBA[o]; SC[2 * 256 + r * 4 + hh] = DTF[o]; SC[3 * 256 + r * 4 + hh] = DTB[o]; }
                __syncthreads();
                f32x4 Gt[4];
#pragma unroll
                for (int t = 0; t < 4; ++t) { Gt[t] = (f32x4){0.f, 0.f, 0.f, 0.f};
#pragma unroll
                    for (int kk = 0; kk < 4; ++kk) Gt[t] = MFMA16(frag_nat(Kt, P272, 16 * t, 32 * kk, lane), cf[kk], Gt[t]); }
#pragma unroll
                for (int hh = 0; hh < 4; ++hh) {
#pragma unroll
                    for (int t = 0; t < 4; ++t) { f32x4 m;
#pragma unroll
                        for (int r = 0; r < 4; ++r) { const int jk = 16 * t + 4 * fq + r, j = 64 * kb + jk;
                            const float csj = SC[0 * 256 + jk * 4 + hh], rbj = SC[1 * 256 + jk * 4 + hh], dtfj = SC[2 * 256 + jk * 4 + hh], dtbj = SC[3 * 256 + jk * 4 + hh];
                            const float x = j < il ? csi[hh] - csj : (j > il ? rbi[hh] - rbj : 0.f);
                            const float s = j < il ? dtfj : (j > il ? dtbj : dtfj + dtbj);
                            m[r] = Gt[t][r] * __expf(x) * s; }
                        *(LAS v2u*)(Mt + (16 * wave + fr) * P144 + (16 * t + 4 * fq) * 2) = pack4(m); }
                    LDS_WAIT();
#pragma unroll
                    for (int kk2 = 0; kk2 < 2; ++kk2) { const bf16x8 mb = frag_nat(Mt, P144, 16 * wave, 32 * kk2, lane);
#pragma unroll
                        for (int pt = 0; pt < 4; ++pt) acc[hh][pt] = MFMA16(frag_tr(Vt, P528, 32 * kk2, 64 * hh + 16 * pt, lane), mb, acc[hh][pt]); }
                }
            }
            if (kchunk >= 0) {
#pragma unroll 1
                for (int hh = 0; hh < 4; ++hh) {
                    const int h = 4 * g + hh;
                    __syncthreads();
#pragma unroll
                    for (int dir = 0; dir < 2; ++dir) { const bf16* S = (const bf16*)(dob + DO_ST_SSD) + ((size_t)(b * 32 + dir * 16 + h) * 16 + kchunk) * 8192;
#pragma unroll
                        for (int c = 0; c < 2; ++c) { const int ch = tid + 512 * c, r = ch >> 4, cc = ch & 15; *(LAS v4u*)(St + dir * 17408 + r * P272 + 16 * cc) = *(const v4u*)(S + r * 128 + 8 * cc); } }
                    __syncthreads();
                    float Ei[2] = {__expf(csi[0]), __expf(rbi[0])};
                    if (hh == 1) { Ei[0] = __expf(csi[1]); Ei[1] = __expf(rbi[1]); } else if (hh == 2) { Ei[0] = __expf(csi[2]); Ei[1] = __expf(rbi[2]); } else if (hh == 3) { Ei[0] = __expf(csi[3]); Ei[1] = __expf(rbi[3]); }
#pragma unroll
                    for (int dir = 0; dir < 2; ++dir)
#pragma unroll
                        for (int pt = 0; pt < 4; ++pt) { f32x4 T = (f32x4){0.f, 0.f, 0.f, 0.f};
#pragma unroll
                            for (int kk = 0; kk < 4; ++kk) T = MFMA16(frag_nat(St + dir * 17408, P272, 16 * pt, 32 * kk, lane), cf[kk], T);
                            const f32x4 add = T * Ei[dir];
                            if (hh == 0) acc[0][pt] += add; else if (hh == 1) acc[1][pt] += add; else if (hh == 2) acc[2][pt] += add; else acc[3][pt] += add; }
                }
            }
            float ssq = 0.f;
#pragma unroll
            for (int hh = 0; hh < 4; ++hh) { const float dsk = args.in[I_SSDD][4 * g + hh];
#pragma unroll
                for (int pt = 0; pt < 4; ++pt) { const int ch = 256 * g + 64 * hh + 16 * pt + 4 * fq;
                    const f32x4 xs = unpack4(*(const v2u*)(XBC + (size_t)row * 2048 + ch)), zz = unpack4(*(const v2u*)(ZG + (size_t)row * 2048 + ch));
                    f32x4 y = acc[hh][pt] + xs * dsk;
                    y.x *= silu_f(zz.x); y.y *= silu_f(zz.y); y.z *= silu_f(zz.z); y.w *= silu_f(zz.w);
                    acc[hh][pt] = y; ssq += (y.x * y.x + y.y * y.y) + (y.z * y.z + y.w * y.w); } }
            ssq += __shfl_xor(ssq, 16); ssq += __shfl_xor(ssq, 32);
            const float rstd = 1.0f / sqrtf(ssq * (1.f / 256.f) + RMS_EPS);
#pragma unroll
            for (int hh = 0; hh < 4; ++hh)
#pragma unroll
                for (int pt = 0; pt < 4; ++pt) { const int ch = 256 * g + 64 * hh + 16 * pt + 4 * fq; const f32x4 nw = *(const f32x4*)(args.in[I_SSDNW] + ch);
                    *(v2u*)(ZG + (size_t)row * 2048 + ch) = pack4(acc[hh][pt] * rstd * nw); }
        } else {
            const int h = grp;
            const float lgf = logsig_f(args.in[I_RLF][h]), lgb = logsig_f(args.in[I_RLB][h]);
            bf16x8 qf[4];
#pragma unroll
            for (int kk = 0; kk < 4; ++kk) qf[kk] = *(const bf16x8*)(QK + (size_t)row * 1024 + 128 * h + 32 * kk + 8 * fq);
            f32x4 acc[16];
#pragma unroll
            for (int et = 0; et < 16; ++et) acc[et] = (f32x4){0.f, 0.f, 0.f, 0.f};
            for (int kb = 0; kb < nkb; ++kb) {
                __syncthreads();
                const int krow0 = cb0 + 64 * kb;
#pragma unroll
                for (int c = 0; c < 2; ++c) { const int ch = tid + 512 * c, r = ch >> 4, cc = ch & 15; *(LAS v4u*)(Kt + r * P272 + 16 * cc) = *(const v4u*)(QK + (size_t)(krow0 + r) * 1024 + 512 + 128 * h + 8 * cc); }
#pragma unroll
                for (int c = 0; c < 4; ++c) { const int ch = tid + 512 * c, r = ch >> 5, cc = ch & 31; *(LAS v4u*)(Vt + r * P528 + 16 * cc) = *(const v4u*)(VV + (size_t)(krow0 + r) * 1024 + 256 * h + 8 * cc); }
                __syncthreads();
#pragma unroll
                for (int t = 0; t < 4; ++t) { f32x4 Gt = (f32x4){0.f, 0.f, 0.f, 0.f};
#pragma unroll
                    for (int kk = 0; kk < 4; ++kk) Gt = MFMA16(frag_nat(Kt, P272, 16 * t, 32 * kk, lane), qf[kk], Gt);
                    f32x4 m;
#pragma unroll
                    for (int r = 0; r < 4; ++r) { const int j = 64 * kb + 16 * t + 4 * fq + r; const float f = j < il ? __expf((float)(il - j) * lgf) : (j > il ? __expf((float)(j - il) * lgb) : 2.0f); m[r] = Gt[r] * f; }
                    *(LAS v2u*)(Mt + (16 * wave + fr) * P144 + (16 * t + 4 * fq) * 2) = pack4(m); }
                LDS_WAIT();
#pragma unroll
                for (int kk2 = 0; kk2 < 2; ++kk2) { const bf16x8 mb = frag_nat(Mt, P144, 16 * wave, 32 * kk2, lane);
#pragma unroll
                    for (int et = 0; et < 16; ++et) acc[et] = MFMA16(frag_tr(Vt, P528, 32 * kk2, 16 * et, lane), mb, acc[et]); }
            }
            if (kchunk >= 0) {
#pragma unroll 1
                for (int dir = 0; dir < 2; ++dir) {
                    const bf16* S = (const bf16*)(dob + DO_ST_RET) + ((size_t)(b * 8 + dir * 4 + h) * 16 + kchunk) * 32768;
                    __syncthreads();
#pragma unroll
                    for (int c = 0; c < 8; ++c) { const int ch = tid + 512 * c, r = ch >> 4, cc = ch & 15; *(LAS v4u*)(St + r * P272 + 16 * cc) = *(const v4u*)(S + r * 128 + 8 * cc); }
                    __syncthreads();
                    const float Ei = dir ? __expf((float)(L - il) * lgb) : __expf((float)(il + 1) * lgf);
#pragma unroll
                    for (int et = 0; et < 16; ++et) { f32x4 T = (f32x4){0.f, 0.f, 0.f, 0.f};
#pragma unroll
                        for (int kk = 0; kk < 4; ++kk) T = MFMA16(frag_nat(St, P272, 16 * et, 32 * kk, lane), qf[kk], T);
                        acc[et] += T * Ei; }
                }
            }
            float sm = 0.f;
#pragma unroll
            for (int et = 0; et < 16; ++et) sm += (acc[et].x + acc[et].y) + (acc[et].z + acc[et].w);
            sm += __shfl_xor(sm, 16); sm += __shfl_xor(sm, 32);
            const float mean = sm * (1.f / 256.f); float sq = 0.f;
#pragma unroll
            for (int et = 0; et < 16; ++et) { acc[et] = acc[et] - mean; sq += (acc[et].x * acc[et].x + acc[et].y * acc[et].y) + (acc[et].z * acc[et].z + acc[et].w * acc[et].w); }
            sq += __shfl_xor(sq, 16); sq += __shfl_xor(sq, 32);
            const float rstd = 1.0f / sqrtf(sq * (1.f / 256.f) + LN_EPS);
#pragma unroll
            for (int et = 0; et < 16; ++et) { const int ch = 1024 + 256 * h + 16 * et + 4 * fq; const f32x4 gg = unpack4(*(const v2u*)(ZG + (size_t)row * 2048 + ch));
                f32x4 y = acc[et] * rstd; y.x *= silu_f(gg.x); y.y *= silu_f(gg.y); y.z *= silu_f(gg.z); y.w *= silu_f(gg.w);
                *(v2u*)(ZG + (size_t)row * 2048 + ch) = pack4(y); }
        }
        __syncthreads();
    }
}


constexpr size_t WS_GWT = 7 * MiB;
__device__ __forceinline__ int xc_row(int r, int b) { return r < RL0 ? r - 256 * b : 256 + (r - RL0 - 8192 * b); }
__device__ __forceinline__ void bw8(const float (&x)[8], const float* w  , float (&o)[8]) {
#pragma unroll
    for (int bl = 0; bl < 2; ++bl)
#pragma unroll
        for (int e = 0; e < 4; ++e) o[4 * bl + e] = x[4 * bl] * w[16 * bl + e] + x[4 * bl + 1] * w[16 * bl + 4 + e] + x[4 * bl + 2] * w[16 * bl + 8 + e] + x[4 * bl + 3] * w[16 * bl + 12 + e];
}
__device__ __forceinline__ void unpack8(v4u v, float (&o)[8]) { o[0] = bflo(v.x); o[1] = bfhi(v.x); o[2] = bflo(v.y); o[3] = bfhi(v.y); o[4] = bflo(v.z); o[5] = bfhi(v.z); o[6] = bflo(v.w); o[7] = bfhi(v.w); }
__device__ __forceinline__ v4u pack8(const float (&o)[8]) { v4u r; r.x = pk2(o[0], o[1]); r.y = pk2(o[2], o[3]); r.z = pk2(o[4], o[5]); r.w = pk2(o[6], o[7]); return r; }

__device__ __forceinline__ void phase_l1_prep(const Args& args, unsigned char* ws, LAS unsigned char* lds, int tid, int lane, int wave, int bx, int G, int b) {
    const bf16* XM = (const bf16*)(ws + WS_XM); bf16* XC = (bf16*)(ws + WS_XC); const bf16* GWT = (const bf16*)(ws + WS_GWT); float* GATE = (float*)(ws + WS_GATE);
    const float* cwp = args.in[I_MLCW]; const float* cbp = args.in[I_MLCB];
    LAS float* GL = (LAS float*)lds;
    const int st = wave >> 2, kq = wave & 3, fr = lane & 15, fq = lane >> 4;
    for (int u = bx; u < 264; u += G) {
        const int tb = u < 8 ? 256 * b + 32 * u : RL0 + 8192 * b + 32 * (u - 8);
        const int slo = u < 8 ? 256 * b : RL0 + 8192 * b, shi = u < 8 ? slo + 256 : slo + 8192;
        const int r = tb + 16 * st + fr, xr = xc_row(r, b);
        f32x4 gacc = (f32x4){0.f, 0.f, 0.f, 0.f};
#pragma unroll 1
        for (int c32 = 0; c32 < 16; ++c32) {
            const int cb = 512 * kq + 32 * c32 + 8 * fq;
            float xw[5][8];
#pragma unroll
            for (int k = 0; k < 5; ++k) { const int rr = r + k - 2; v4u v = (v4u){0u, 0u, 0u, 0u}; if (rr >= slo && rr < shi) v = *(const v4u*)(XM + (size_t)rr * 2048 + cb); unpack8(v, xw[k]); }
            float xc[8];
#pragma unroll
            for (int c = 0; c < 8; ++c) { float a = cbp[cb + c];
#pragma unroll
                for (int k = 0; k < 5; ++k) a += cwp[k * 2048 + cb + c] * xw[k][c];
                xc[c] = silu_f(a); }
            const v4u xcp = pack8(xc);
            *(v4u*)(XC + (size_t)xr * 2048 + cb) = xcp;
            unpack8(xcp, xc);
            float q8[8], k8[8], v8[8];
            bw8(xc, args.in[I_MLWQ] + (cb >> 2) * 16, q8); bw8(xc, args.in[I_MLWK] + (cb >> 2) * 16, k8); bw8(xw[2], args.in[I_MLWV] + (cb >> 2) * 16, v8);
            const bf16x8 qf = __builtin_bit_cast(bf16x8, pack8(q8)), kf = __builtin_bit_cast(bf16x8, pack8(k8)), vf = __builtin_bit_cast(bf16x8, pack8(v8));
            const bf16x8 gq = *(const bf16x8*)(GWT + (size_t)fr * 6144 + cb), gk = *(const bf16x8*)(GWT + (size_t)fr * 6144 + 2048 + cb), gv = *(const bf16x8*)(GWT + (size_t)fr * 6144 + 4096 + cb);
            gacc = MFMA16(gq, qf, gacc); gacc = MFMA16(gk, kf, gacc); gacc = MFMA16(gv, vf, gacc);
        }
        __syncthreads();
#pragma unroll
        for (int rr = 0; rr < 4; ++rr) GL[((st * 4 + kq) * 16 + 4 * fq + rr) * 16 + fr] = gacc[rr];
        __syncthreads();
        { const int s2 = tid >> 8, gt = (tid >> 4) & 15, tk = tid & 15;
            float s = args.in[I_MLGB][gt];
#pragma unroll
            for (int q = 0; q < 4; ++q) s += GL[((s2 * 4 + q) * 16 + gt) * 16 + tk];
            GATE[(size_t)(tb + 16 * s2 + tk) * 16 + gt] = s; }
        __syncthreads();
    }
}

__device__ __forceinline__ void phase_l1_gatescan(const Args& args, unsigned char* ws, LAS unsigned char* lds, int tid, int lane, int wave, int bx, int G, int gw, int NGW, int b) {
    const float* GATE = (const float*)(ws + WS_GATE); float* BC = (float*)(ws + WS_BC); float* AJ = (float*)(ws + WS_AJ); float* CM = (float*)(ws + WS_CM); float* CH = (float*)(ws + WS_CH);
    for (int wu = gw; wu < 8 * 17; wu += NGW) {
        const int sl = wu / 17, c17 = wu % 17, dir = sl >> 2, h = sl & 3;
        const int base = c17 == 0 ? 256 * b : RL0 + 8192 * b + 512 * (c17 - 1), L = c17 == 0 ? 256 : 512, per = L >> 6, t0 = lane * per;
        float fc[8], ic[8]; float s = 0.f;
#pragma unroll
        for (int t = 0; t < 8; ++t) if (t < per) { const size_t o = (size_t)(base + t0 + t) * 16; fc[t] = logsig_f(GATE[o + (dir ? 12 : 4) + h]); ic[t] = GATE[o + (dir ? 8 : 0) + h]; s += fc[t]; }
        float p = s;
#pragma unroll
        for (int o = 1; o < 64; o <<= 1) { const float up = __shfl_up(p, o), dn = __shfl_down(p, o); if (!dir) { if (lane >= o) p += up; } else { if (lane + o < 64) p += dn; } }
        const float total = dir ? __shfl(p, 0) : __shfl(p, 63);
        float run = p - s, a[8], bcv[8]; float mx = -3.0e38f;
        if (!dir) {
#pragma unroll
            for (int t = 0; t < 8; ++t) if (t < per) { run += fc[t]; bcv[t] = run; a[t] = ic[t] - run; mx = fmaxf(mx, a[t]); }
        } else {
#pragma unroll
            for (int t = 7; t >= 0; --t) if (t < per) { run += fc[t]; bcv[t] = run; a[t] = ic[t] - run; mx = fmaxf(mx, a[t]); }
        }
        float pm = mx;
#pragma unroll
        for (int o = 1; o < 64; o <<= 1) { const float up = __shfl_up(pm, o), dn = __shfl_down(pm, o); if (!dir) { if (lane >= o) pm = fmaxf(pm, up); } else { if (lane + o < 64) pm = fmaxf(pm, dn); } }
        const float cmax = dir ? __shfl(pm, 0) : __shfl(pm, 63);
        float excl = !dir ? __shfl_up(pm, 1) : __shfl_down(pm, 1);
        if ((!dir && lane == 0) || (dir && lane == 63)) excl = -3.0e38f;
        float rm = excl;
        if (!dir) {
#pragma unroll
            for (int t = 0; t < 8; ++t) if (t < per) { rm = fmaxf(rm, a[t]); const size_t o = (size_t)(base + t0 + t) * 8 + sl; BC[o] = bcv[t]; AJ[o] = a[t]; CM[o] = rm; }
        } else {
#pragma unroll
            for (int t = 7; t >= 0; --t) if (t < per) { rm = fmaxf(rm, a[t]); const size_t o = (size_t)(base + t0 + t) * 8 + sl; BC[o] = bcv[t]; AJ[o] = a[t]; CM[o] = rm; }
        }
        if (lane == 0) { CH[((b * 8 + sl) * 17 + c17) * 2] = total; CH[((b * 8 + sl) * 17 + c17) * 2 + 1] = cmax; }
    }
}

__device__ __forceinline__ void m_chain(const float* CH, int b, int sl, LAS float* m_in, LAS float* mul) {
    const int dir = sl >> 2; float m = 0.f;
    for (int step = 0; step < 17; ++step) { const int c17 = step == 0 ? 0 : (dir ? 17 - step : step); const float be = CH[((b * 8 + sl) * 17 + c17) * 2], cx = CH[((b * 8 + sl) * 17 + c17) * 2 + 1];
        const float mu = fmaxf(m, cx); m_in[step] = m; mul[step] = mu; m = be + mu; }
}

__device__ __forceinline__ void phase_l1_scan(const Args& args, unsigned char* ws, LAS unsigned char* lds, int tid, int lane, int wave, int bx, int G, int b) {
    const bf16* XM = (const bf16*)(ws + WS_XM); const bf16* XC = (const bf16*)(ws + WS_XC); const float* AJ = (const float*)(ws + WS_AJ); const float* CH = (const float*)(ws + WS_CH);
    bf16* ST = (bf16*)(ws + WS_ST1); float* NV = (float*)(ws + WS_NV);
    LAS unsigned char* Kt = lds; LAS unsigned char* Vt = lds + 128 * P144; LAS float* MS = (LAS float*)(lds + 128 * P144 + 128 * P272);
    const int fr = lane & 15, fq = lane >> 4, wd = wave & 3, we = wave >> 2;
    const bf16x8 ones = (bf16x8){(short)0x3F80, (short)0x3F80, (short)0x3F80, (short)0x3F80, (short)0x3F80, (short)0x3F80, (short)0x3F80, (short)0x3F80};
    for (int u = bx; u < 256; u += G) {
        const int sl = u >> 5, t = u & 31, et = t >> 3, dt = t & 7, dir = sl >> 2, h = sl & 3;
        __syncthreads();
        if (tid == 0) m_chain(CH, b, sl, MS, MS + 32);
        __syncthreads();
        f32x4 acc[4]; f32x4 nacc = (f32x4){0.f, 0.f, 0.f, 0.f};
#pragma unroll
        for (int i = 0; i < 4; ++i) acc[i] = (f32x4){0.f, 0.f, 0.f, 0.f};
        const int srow = tid >> 2, q4 = tid & 3;
        for (int step = 0; step < 17; ++step) {
            int base, L, k = -1, xb;
            if (step == 0) { base = 256 * b; L = 256; xb = 0; } else { k = dir ? 16 - step : step - 1; base = RL0 + 8192 * b + 512 * k; L = 512; xb = 256 + 512 * k; }
            if (k >= 0) {
                bf16* So = ST + ((size_t)(sl * 16 + k) * 512) * 512;
#pragma unroll
                for (int t4 = 0; t4 < 4; ++t4) { const int e = 128 * et + 64 * we + 16 * t4 + fr, d = 64 * dt + 16 * wd + 4 * fq; *(v2u*)(So + (size_t)e * 512 + d) = pack4(acc[t4]); }
                if (et == 0 && we == 0 && fr == 0) *(f32x4*)(NV + (size_t)(sl * 16 + k) * 512 + 64 * dt + 16 * wd + 4 * fq) = nacc;
                if (step == 16) break;
            }
            const float mu = MS[32 + step], wc = __expf(MS[step] - mu);
#pragma unroll
            for (int i = 0; i < 4; ++i) acc[i] = acc[i] * wc;
            nacc = nacc * wc;
            for (int t0 = 0; t0 < L; t0 += 128) {
                const int r = base + t0 + srow, xr = xb + t0 + srow;
                const float w = __expf(AJ[(size_t)r * 8 + sl] - mu);
                const v4u k0 = *(const v4u*)(XC + (size_t)xr * 2048 + 512 * h + 64 * dt + 16 * q4), k1 = *(const v4u*)(XC + (size_t)xr * 2048 + 512 * h + 64 * dt + 16 * q4 + 8);
                v4u vv[4];
#pragma unroll
                for (int c = 0; c < 4; ++c) vv[c] = *(const v4u*)(XM + (size_t)r * 2048 + 512 * h + 128 * et + 32 * q4 + 8 * c);
                __syncthreads();
                *(LAS v4u*)(Kt + srow * P144 + 32 * q4) = scale8(k0, w); *(LAS v4u*)(Kt + srow * P144 + 32 * q4 + 16) = scale8(k1, w);
#pragma unroll
                for (int c = 0; c < 4; ++c) *(LAS v4u*)(Vt + srow * P272 + 64 * q4 + 16 * c) = vv[c];
                __syncthreads();
#pragma unroll
                for (int kk = 0; kk < 4; ++kk) { const bf16x8 a = frag_tr(Kt, P144, 32 * kk, 16 * wd, lane);
#pragma unroll
                    for (int t4 = 0; t4 < 4; ++t4) acc[t4] = MFMA16(a, frag_tr(Vt, P272, 32 * kk, 64 * we + 16 * t4, lane), acc[t4]);
                    nacc = MFMA16(a, ones, nacc); }
            }
        }
    }
    __syncthreads();
}


constexpr int P1040 = 1040;
constexpr int LY_AJ = 139264;
constexpr int LY_MT = 66560;
__device__ __forceinline__ void qprime8(const bf16* xcrow, const float* WQK, int cb, float (&o)[8]) {
    float x[8]; unpack8(*(const v4u*)(xcrow + cb), x);
    bw8(x, WQK + (cb >> 2) * 16, o);
}
__device__ __forceinline__ void phase_l1_y(const Args& args, unsigned char* ws, LAS unsigned char* lds, int tid0, int lane0, int wave, int bx, int G, int b) {
    const bf16* XM = (const bf16*)(ws + WS_XM); const bf16* XC = (const bf16*)(ws + WS_XC); bf16* Z = (bf16*)(ws + WS_Z);
    const float* AJ = (const float*)(ws + WS_AJ); const float* BC = (const float*)(ws + WS_BC); const float* CM = (const float*)(ws + WS_CM); const float* CH = (const float*)(ws + WS_CH);
    const bf16* ST = (const bf16*)(ws + WS_ST1); const float* NV = (const float*)(ws + WS_NV); const float* WQK = (const float*)(ws + WS_WQK);
    LAS float* AJL = (LAS float*)(lds + LY_AJ);
    LAS unsigned char* Mf = lds;
    LAS unsigned char* Tt = lds + 66560;
    const int wr = wave >> 1, we = wave & 1;
    for (int u = bx; u < 512; u += G) {
        int tid = tid0, lane = lane0; asm volatile("" : "+v"(tid), "+v"(lane));
        const int fr = lane & 15, fq = lane >> 4;
        const int h = u >> 7, k = (u >> 3) & 15, rb = u & 7;
        const int base = RL0 + 8192 * b + 512 * k, xb = 256 + 512 * k, i0 = 64 * rb;
        const int il = i0 + 16 * wr + fr, row = base + il; const bf16* xcrow = XC + (size_t)(xb + il) * 2048;
        const int Rw = 4 * rb + wr;
        __syncthreads();
        float m_in_f = 0.f, m_in_b = 0.f;
        { float m = 0.f;
          for (int step = 0; step <= k; ++step) { const float be = CH[((b * 8 + h) * 17 + step) * 2], cx = CH[((b * 8 + h) * 17 + step) * 2 + 1]; m = be + fmaxf(m, cx); }
          m_in_f = m; m = 0.f;
          for (int step = 0; step <= 15 - k; ++step) { const int c17 = step == 0 ? 0 : 17 - step; const float be = CH[((b * 8 + 4 + h) * 17 + c17) * 2], cx = CH[((b * 8 + 4 + h) * 17 + c17) * 2 + 1]; m = be + fmaxf(m, cx); }
          m_in_b = m; }
        const float mu_f = fmaxf(m_in_f, CM[(size_t)row * 8 + h]), mu_b = fmaxf(m_in_b, CM[(size_t)row * 8 + 4 + h]);
        const float bc_f = BC[(size_t)row * 8 + h], bc_b = BC[(size_t)row * 8 + 4 + h];
        for (int i = tid; i < 1024; i += 512) { const int d = i >> 9, j = i & 511; AJL[i] = AJ[(size_t)(base + j) * 8 + 4 * d + h]; }
        f32x4 Gt[4][4];
#pragma unroll
        for (int kb = 0; kb < 4; ++kb)
#pragma unroll
            for (int t = 0; t < 4; ++t) Gt[kb][t] = (f32x4){0.f, 0.f, 0.f, 0.f};
        float qn_f = 0.f, qn_b = 0.f;
        const float* nf = NV + (size_t)(h * 16 + k) * 512; const float* nb = NV + (size_t)((4 + h) * 16 + k) * 512;
#pragma unroll 1
        for (int ds = 0; ds < 4; ++ds) {
            __syncthreads();
#pragma unroll 4
            for (int c = 0; c < 16; ++c) { const int ch = tid + 512 * c, r = ch >> 4, cc = ch & 15; *(LAS v4u*)(lds + r * P272 + 16 * cc) = *(const v4u*)(XC + (size_t)(xb + r) * 2048 + 512 * h + 128 * ds + 8 * cc); }
            bf16x8 qf[4];
#pragma unroll
            for (int kk = 0; kk < 4; ++kk) { const int dl = 128 * ds + 32 * kk + 8 * fq; float q8[8]; qprime8(xcrow, WQK, 512 * h + dl, q8);
#pragma unroll
                for (int e = 0; e < 8; ++e) { qn_f += q8[e] * nf[dl + e]; qn_b += q8[e] * nb[dl + e]; }
                qf[kk] = __builtin_bit_cast(bf16x8, pack8(q8)); asm volatile("" ::: "memory"); }
            __syncthreads();
#pragma unroll
            for (int kb = 0; kb < 4; ++kb) {
#pragma unroll
                for (int t = 0; t < 4; ++t) {
#pragma unroll
                    for (int kk = 0; kk < 4; ++kk) Gt[kb][t] = MFMA16(frag_nat(lds, P272, 64 * (4 * we + kb) + 16 * t, 32 * kk, lane), qf[kk], Gt[kb][t]);
                    asm volatile("" ::: "memory"); } }
        }
        qn_f += __shfl_xor(qn_f, 16); qn_f += __shfl_xor(qn_f, 32); qn_b += __shfl_xor(qn_b, 16); qn_b += __shfl_xor(qn_b, 32);
        float rsf = 0.f, rsb = 0.f;
#pragma unroll
        for (int kb = 0; kb < 4; ++kb)
#pragma unroll
            for (int t = 0; t < 4; ++t) { const int T = 4 * (4 * we + kb) + t, j0 = 16 * T + 4 * fq; const f32x4 g = Gt[kb][t];
                if (T < Rw) { rsf += g.x * __expf(AJL[j0] - mu_f) + g.y * __expf(AJL[j0 + 1] - mu_f) + g.z * __expf(AJL[j0 + 2] - mu_f) + g.w * __expf(AJL[j0 + 3] - mu_f); }
                else if (T > Rw) { rsb += g.x * __expf(AJL[512 + j0] - mu_b) + g.y * __expf(AJL[512 + j0 + 1] - mu_b) + g.z * __expf(AJL[512 + j0 + 2] - mu_b) + g.w * __expf(AJL[512 + j0 + 3] - mu_b); }
                else {
#pragma unroll
                    for (int r = 0; r < 4; ++r) { const int jj = 4 * fq + r; const float ef = __expf(AJL[j0 + r] - mu_f), eb = __expf(AJL[512 + j0 + r] - mu_b);
                        rsf += jj <= fr ? g[r] * ef : 0.f; rsb += jj >= fr ? g[r] * eb : 0.f; } }
                asm volatile("" ::: "memory"); }
        rsf += __shfl_xor(rsf, 16); rsf += __shfl_xor(rsf, 32); rsb += __shfl_xor(rsb, 16); rsb += __shfl_xor(rsb, 32);
        __syncthreads();
        { LAS float* RS = (LAS float*)lds; if (fq == 0) { RS[(wave * 16 + fr) * 2] = rsf; RS[(wave * 16 + fr) * 2 + 1] = rsb; }
          __syncthreads();
          rsf += RS[((wave ^ 1) * 16 + fr) * 2]; rsb += RS[((wave ^ 1) * 16 + fr) * 2 + 1]; }
        const float wp_f = __expf(m_in_f - mu_f), wp_b = __expf(m_in_b - mu_b);
        const float dn_f = fmaxf(fabsf(rsf + wp_f * qn_f), __expf(-bc_f - mu_f)), dn_b = fmaxf(fabsf(rsb + wp_b * qn_b), __expf(-bc_b - mu_b));
        const float inv_f = 1.0f / dn_f, inv_b = 1.0f / dn_b, s_f = wp_f * inv_f, s_b = wp_b * inv_b;
        __syncthreads();
#pragma unroll
        for (int kb = 0; kb < 4; ++kb)
#pragma unroll
            for (int t = 0; t < 4; ++t) { const int T = 4 * (4 * we + kb) + t, j0 = 16 * T + 4 * fq; const f32x4 g = Gt[kb][t]; f32x4 m;
                if (T < Rw) { m.x = g.x * __expf(AJL[j0] - mu_f) * inv_f; m.y = g.y * __expf(AJL[j0 + 1] - mu_f) * inv_f; m.z = g.z * __expf(AJL[j0 + 2] - mu_f) * inv_f; m.w = g.w * __expf(AJL[j0 + 3] - mu_f) * inv_f; }
                else if (T > Rw) { m.x = g.x * __expf(AJL[512 + j0] - mu_b) * inv_b; m.y = g.y * __expf(AJL[512 + j0 + 1] - mu_b) * inv_b; m.z = g.z * __expf(AJL[512 + j0 + 2] - mu_b) * inv_b; m.w = g.w * __expf(AJL[512 + j0 + 3] - mu_b) * inv_b; }
                else {
#pragma unroll
                    for (int r = 0; r < 4; ++r) { const int jj = 4 * fq + r; const float ef = __expf(AJL[j0 + r] - mu_f) * inv_f, eb = __expf(AJL[512 + j0 + r] - mu_b) * inv_b;
                        m[r] = g[r] * ((jj <= fr ? ef : 0.f) + (jj >= fr ? eb : 0.f)); } }
                *(LAS v2u*)(Mf + (16 * wr + fr) * P1040 + j0 * 2) = pack4(m); asm volatile("" ::: "memory"); }
        f32x4 acc[16];
#pragma unroll
        for (int et = 0; et < 16; ++et) acc[et] = (f32x4){0.f, 0.f, 0.f, 0.f};
        v4u pre[8];
#pragma unroll
        for (int c = 0; c < 8; ++c) { const int ch = tid + 512 * c, r = ch >> 6, cc = ch & 63; pre[c] = *(const v4u*)(XM + (size_t)(base + r) * 2048 + 512 * h + 8 * cc); }
#pragma unroll 1
        for (int kb = 0; kb < 8; ++kb) {
            __syncthreads();
#pragma unroll
            for (int c = 0; c < 8; ++c) { const int ch = tid + 512 * c, r = ch >> 6, cc = ch & 63; *(LAS v4u*)(Tt + r * P1040 + 16 * cc) = pre[c]; }
            __syncthreads();
            if (kb < 7) {
#pragma unroll
                for (int c = 0; c < 8; ++c) { const int ch = tid + 512 * c, r = ch >> 6, cc = ch & 63; pre[c] = *(const v4u*)(XM + (size_t)(base + 64 * (kb + 1) + r) * 2048 + 512 * h + 8 * cc); }
            }
#pragma unroll
            for (int kk2 = 0; kk2 < 2; ++kk2) { const bf16x8 mb = frag_nat(Mf, P1040, 16 * wr, 64 * kb + 32 * kk2, lane);
#pragma unroll
                for (int et = 0; et < 16; ++et) { acc[et] = MFMA16(frag_tr(Tt, P1040, 32 * kk2, 256 * we + 16 * et, lane), mb, acc[et]); if ((et & 3) == 3) asm volatile("" ::: "memory"); } }
        }
        { const bf16* S = ST + ((size_t)(h * 16 + k) * 512) * 512;
#pragma unroll
          for (int c = 0; c < 8; ++c) { const int ch = tid + 512 * c, r = ch >> 3, cc = ch & 7; pre[c] = *(const v4u*)(S + (size_t)r * 512 + 8 * cc); } }
#pragma unroll 1
        for (int it = 0; it < 16; ++it) {
            const int dir = it >> 3, dsl = it & 7; const float sc = dir ? s_b : s_f;
            __syncthreads();
#pragma unroll
            for (int c = 0; c < 8; ++c) { const int ch = tid + 512 * c, r = ch >> 3, cc = ch & 7; *(LAS v4u*)(Tt + r * P144 + 16 * cc) = pre[c]; }
            bf16x8 qs[2];
#pragma unroll
            for (int kk = 0; kk < 2; ++kk) { float q8[8]; qprime8(xcrow, WQK, 512 * h + 64 * dsl + 32 * kk + 8 * fq, q8);
#pragma unroll
                for (int e = 0; e < 8; ++e) q8[e] *= sc;
                qs[kk] = __builtin_bit_cast(bf16x8, pack8(q8)); }
            __syncthreads();
            if (it < 15) { const int nd = (it + 1) >> 3, ns = (it + 1) & 7; const bf16* S = ST + ((size_t)((nd * 4 + h) * 16 + k) * 512) * 512 + 64 * ns;
#pragma unroll
                for (int c = 0; c < 8; ++c) { const int ch = tid + 512 * c, r = ch >> 3, cc = ch & 7; pre[c] = *(const v4u*)(S + (size_t)r * 512 + 8 * cc); } }
#pragma unroll
            for (int kk = 0; kk < 2; ++kk)
#pragma unroll
                for (int et = 0; et < 16; ++et) { acc[et] = MFMA16(frag_nat(Tt, P144, 256 * we + 16 * et, 32 * kk, lane), qs[kk], acc[et]); if ((et & 3) == 3) asm volatile("" ::: "memory"); }
        }
        float sm = 0.f;
#pragma unroll
        for (int et = 0; et < 16; ++et) { const float* w = args.in[I_MLWV] + (size_t)(128 * h + 64 * we + 4 * et + fq) * 16; const f32x4 a = acc[et]; f32x4 o;
            o.x = a.x * w[0] + a.y * w[4] + a.z * w[8] + a.w * w[12]; o.y = a.x * w[1] + a.y * w[5] + a.z * w[9] + a.w * w[13];
            o.z = a.x * w[2] + a.y * w[6] + a.z * w[10] + a.w * w[14]; o.w = a.x * w[3] + a.y * w[7] + a.z * w[11] + a.w * w[15];
            acc[et] = o; sm += (o.x + o.y) + (o.z + o.w); asm volatile("" ::: "memory"); }
        sm += __shfl_xor(sm, 16); sm += __shfl_xor(sm, 32);
        LAS float* XS = AJL;
        __syncthreads();
        if (fq == 0) XS[wave * 16 + fr] = sm;
        __syncthreads();
        const float mean = (sm + XS[(wave ^ 1) * 16 + fr]) * (1.f / 512.f); float sq = 0.f;
#pragma unroll
        for (int et = 0; et < 16; ++et) { acc[et] = acc[et] - mean; sq += (acc[et].x * acc[et].x + acc[et].y * acc[et].y) + (acc[et].z * acc[et].z + acc[et].w * acc[et].w); }
        sq += __shfl_xor(sq, 16); sq += __shfl_xor(sq, 32);
        if (fq == 0) XS[128 + wave * 16 + fr] = sq;
        __syncthreads();
        const float rstd = 1.0f / sqrtf((sq + XS[128 + (wave ^ 1) * 16 + fr]) * (1.f / 512.f) + LN_EPS);
#pragma unroll
        for (int et = 0; et < 16; ++et) { const int ch = 512 * h + 256 * we + 16 * et + 4 * fq;
            const f32x4 nw = *(const f32x4*)(args.in[I_MLNW] + ch), sk = *(const f32x4*)(args.in[I_MLSKIP] + ch), xcv = unpack4(*(const v2u*)(xcrow + ch)), zz = unpack4(*(const v2u*)(Z + (size_t)row * 2048 + ch));
            f32x4 y = acc[et] * rstd * nw + sk * xcv;
            y.x *= silu_f(zz.x); y.y *= silu_f(zz.y); y.z *= silu_f(zz.z); y.w *= silu_f(zz.w);
            *(v2u*)(Z + (size_t)row * 2048 + ch) = pack4(y); asm volatile("" ::: "memory"); }
    }
    __syncthreads();
}


#ifndef MK_PER_PHASE
#define MK_PER_PHASE 0
#endif
constexpr int N_PHASES = 25;
__global__ void __launch_bounds__(NWAVES * 64, 2) mk_fwd(Args args) {
    extern __shared__ __attribute__((aligned(16))) unsigned char lds_raw[];
    LAS unsigned char* lds = (LAS unsigned char*)lds_raw;
    volatile LAS unsigned* MISC = (volatile LAS unsigned*)(lds + MISC_OFF);
    const int tid = threadIdx.x, lane = tid & 63, wave = __builtin_amdgcn_readfirstlane(tid >> 6);
    const int G = gridDim.x, bx = blockIdx.x;
    const int vcu = (G % 8 == 0) ? (bx % 8) * (G / 8) + bx / 8 : bx;
    const int gw = vcu * NWAVES + wave, NGW = G * NWAVES;
    unsigned char* ws = args.ws;
    gu32* ctl = (gu32*)(ws + WS_CTL);
    float* MOD = (float*)(ws + CTL_MOD);
    unsigned char* dob = (unsigned char*)args.out;
    for (int u = tid; u < (LDS_BYTES - LDSCTL_OFF) / 4; u += NWAVES * 64) ((LAS unsigned*)(lds + LDSCTL_OFF))[u] = 0u;
    __syncthreads();
    XcdBarrier bar; bar.bar = (unsigned*)(ctl + CW_BAR); bar.x = 0; bar.st = nullptr;
    if (!MK_PER_PHASE) bar = xcd_barrier_post((unsigned*)(ctl + CW_BAR), MISC + 8);
    const int lo = args.ph_lo, hi = args.ph_hi;
#define IN(k) (lo <= (k) && (k) < hi)
#define SEAM(k) do { if (IN(k) && IN((k) + 1)) xcd_barrier(bar); } while (0)

    if (IN(0)) {
        LAS float* scr = (LAS float*)(lds + wave * 16384);
        conv_abin(args.in[I_ABIN], (bf16*)(ws + WS_W_IN), scr, gw, NGW, lane);
        conv_plain(args.in[I_ABOUT], 2048, 1024, (bf16*)(ws + WS_W_OUT), scr, gw, NGW, lane);
        conv_ffn1(args.in[I_W1], args.in[I_W3], (bf16*)(ws + WS_W_F1), scr, gw, NGW, lane);
        conv_plain(args.in[I_W2], FFH, 1024, (bf16*)(ws + WS_W_F2), scr, gw, NGW, lane);
        __syncthreads();
        LAS float* sc = (LAS float*)lds;
        LAS float* part = (LAS float*)(lds + 16384);
        for (int i = tid; i < 3 * 1024; i += 512) { const int v = i >> 10, k = i & 1023; const float cv = v == 0 ? args.in[I_CCTX][k] : args.in[I_C][(v - 1) * DM + k]; sc[i] = silu_f(cv); }
        __syncthreads();
        for (int u = bx; u < 192; u += G) {
            const int layer = u / 96, cb = u % 96, n = cb * 64 + lane;
            const float* W = args.in[I_ADAW] + (size_t)layer * DM * 6144 + (size_t)(wave * 128) * 6144 + n;
            float a0 = 0.f, a1 = 0.f, a2 = 0.f;
#pragma unroll 8
            for (int kk = 0; kk < 128; ++kk) { const float wv = W[(size_t)kk * 6144]; const int k = wave * 128 + kk; a0 += sc[k] * wv; a1 += sc[1024 + k] * wv; a2 += sc[2048 + k] * wv; }
            part[(wave * 3 + 0) * 64 + lane] = a0; part[(wave * 3 + 1) * 64 + lane] = a1; part[(wave * 3 + 2) * 64 + lane] = a2;
            __syncthreads();
            if (tid < 192) { const int v = tid >> 6, l = tid & 63; float s = args.in[I_ADAB][layer * 6144 + cb * 64 + l];
#pragma unroll
                for (int w = 0; w < 8; ++w) s += part[(w * 3 + v) * 64 + l];
                MOD[(size_t)(layer * 3 + v) * 6144 + cb * 64 + l] = s; }
            __syncthreads();
        }
        for (int i = bx * 512 + tid; i < 512 * 16; i += G * 512) { const int blk = i >> 4, d = (i >> 2) & 3, dp = i & 3; const float* q = args.in[I_MLWQ] + blk * 16 + d * 4; const float* k = args.in[I_MLWK] + blk * 16 + dp * 4;
            ((float*)(ws + WS_WQK))[i] = 0.04419417382415922f * (q[0] * k[0] + q[1] * k[1] + q[2] * k[2] + q[3] * k[3]); }
    }
    SEAM(0);
    if (IN(1)) {
        LAS float* wdt = (LAS float*)lds;
        for (int i = tid; i < 1024 * 4; i += 512) { const int k = i >> 2, q = i & 3; *(LAS f32x4*)(wdt + k * 16 + 4 * q) = *(const f32x4*)(args.in[I_ABIN] + (size_t)k * ABIN + 3072 + 4 * q); }
        __syncthreads();
        norm_rows<true>(args.in[I_CTX], args.in[I_X], args.in[I_NMIX], MOD, 0, (bf16*)(dob + DO_H), 0, 0, R, gw, NGW, lane, wdt, (float*)(ws + WS_DTRAW));
        __syncthreads();
    }
    SEAM(1);
    if (IN(2)) {
        pg8::Gemm g{(const bf16*)(dob + DO_H), (const bf16*)(ws + WS_W_IN), R, 6144, DM}; pg8::StaticOrder S; S.init(R, 6144, G, bx);
        pg8::EpiInProj E{(bf16*)(ws + WS_ZG), (bf16*)(ws + WS_XBC), (bf16*)(ws + WS_QK), (bf16*)(ws + WS_V), (bf16*)(ws + WS_HALO)};
        pg8::gemm_phase<pg8::EpiInProj, pg8::StaticOrder, true, true>(lds, g, S, E);
    }
    SEAM(2);
    if (IN(3)) { phase_l0_prep(args, ws, lds, tid, lane, wave, bx, G, gw, NGW); }
    SEAM(3);
    if (IN(4)) { phase_l0_scan(args, ws, dob, lds, tid, lane, wave, bx, G); }
    SEAM(4);
    if (IN(5)) { phase_l0_y(args, ws, dob, lds, tid, lane, wave, bx, G); }
    SEAM(5);
    if (IN(6)) {
        pg8::Gemm g{(const bf16*)(ws + WS_ZG), (const bf16*)(ws + WS_W_OUT), R, DM, 2048}; pg8::StaticOrder S; S.init(R, DM, G, bx);
        pg8::EpiResid E{args.in[I_CTX], args.in[I_X], (float*)(ws + WS_XCTX), args.out, MOD + 2 * 1024, 0};
        pg8::gemm_phase<pg8::EpiResid, pg8::StaticOrder, true, true>(lds, g, S, E);
    }
    SEAM(6);
    if (IN(7)) { norm_rows<false>((const float*)(ws + WS_XCTX), args.out, args.in[I_NFFN], MOD, 3, (bf16*)(ws + WS_HF0), 0, 0, R, gw, NGW, lane, nullptr, nullptr); }
    SEAM(7);
    if (IN(8)) {
        pg8::Gemm g{(const bf16*)(ws + WS_HF0), (const bf16*)(ws + WS_W_F1), R, 5632, DM}; pg8::StaticOrder S; S.init(R, 5632, G, bx);
        pg8::EpiSwiglu E{(bf16*)(ws + WS_HH0), FFH};
        pg8::gemm_phase<pg8::EpiSwiglu, pg8::StaticOrder, true, true>(lds, g, S, E);
    }
    SEAM(8);
    if (IN(9)) {
        pg8::Gemm g{(const bf16*)(ws + WS_HH0), (const bf16*)(ws + WS_W_F2), R, DM, FFH}; pg8::StaticOrder S; S.init(R, DM, G, bx);
        pg8::EpiResid E{(const float*)(ws + WS_XCTX), args.out, (float*)(ws + WS_XCTX), args.out, MOD + 5 * 1024, 0};
        pg8::gemm_phase<pg8::EpiResid, pg8::StaticOrder, true, true>(lds, g, S, E);
    }
    SEAM(9);
    if (IN(10)) {
        norm_rows<false>((const float*)(ws + WS_XCTX), args.out, args.in[I_NMIX] + DM, MOD + 3 * 6144, 0, (bf16*)(ws + WS_H1), 0, 0, R, gw, NGW, lane, nullptr, nullptr);
        conv_plain(args.in[I_MLUP], DM, 4096, (bf16*)(ws + WS_W_UP), (LAS float*)(lds + wave * 16384), gw, NGW, lane);
        for (int i = bx * 512 + tid; i < 16 * 6144; i += G * 512) { const int gt = i / 6144, kk = i % 6144; ((bf16*)(ws + WS_GWT))[i] = (bf16)f2bf(args.in[I_MLGW][(size_t)kk * 16 + gt]); }
    }
    SEAM(10);
    if (IN(11)) {
        pg8::Gemm g{(const bf16*)(ws + WS_H1), (const bf16*)(ws + WS_W_UP), R, 4096, DM}; pg8::StaticOrder S; S.init(R, 4096, G, bx);
        pg8::EpiSplit2 E{(bf16*)(ws + WS_XM), (bf16*)(ws + WS_Z), 2048, 8};
        pg8::gemm_phase<pg8::EpiSplit2, pg8::StaticOrder, true, true>(lds, g, S, E);
    }
    SEAM(11);
    {
        if (IN(12)) {
            phase_l1_prep(args, ws, lds, tid, lane, wave, bx, G, 0);
            if (0 == 1) {
                LAS float* scr = (LAS float*)(lds + wave * 16384);
                __syncthreads();
                conv_plain(args.in[I_MLDOWN], 2048, 1024, (bf16*)(ws + WS_W_DN), scr, gw, NGW, lane);
                conv_ffn1(args.in[I_W1] + (size_t)DM * FFH, args.in[I_W3] + (size_t)DM * FFH, (bf16*)(ws + WS_W_F1B), scr, gw, NGW, lane);
                conv_plain(args.in[I_W2] + (size_t)FFH * DM, FFH, 1024, (bf16*)(ws + WS_W_F2B), scr, gw, NGW, lane);
            }
        }
        SEAM(12);
        if (IN(13)) { phase_l1_gatescan(args, ws, lds, tid, lane, wave, bx, G, gw, NGW, 0); }
        SEAM(13);
        if (IN(14)) { phase_l1_scan(args, ws, lds, tid, lane, wave, bx, G, 0); }
        SEAM(14);
        if (IN(15)) { phase_l1_y(args, ws, lds, tid, lane, wave, bx, G, 0); }
        SEAM(15);
    }
    {
        if (IN(16)) {
            phase_l1_prep(args, ws, lds, tid, lane, wave, bx, G, 1);
            if (1 == 1) {
                LAS float* scr = (LAS float*)(lds + wave * 16384);
                __syncthreads();
                conv_plain(args.in[I_MLDOWN], 2048, 1024, (bf16*)(ws + WS_W_DN), scr, gw, NGW, lane);
                conv_ffn1(args.in[I_W1] + (size_t)DM * FFH, args.in[I_W3] + (size_t)DM * FFH, (bf16*)(ws + WS_W_F1B), scr, gw, NGW, lane);
                conv_plain(args.in[I_W2] + (size_t)FFH * DM, FFH, 1024, (bf16*)(ws + WS_W_F2B), scr, gw, NGW, lane);
            }
        }
        SEAM(16);
        if (IN(17)) { phase_l1_gatescan(args, ws, lds, tid, lane, wave, bx, G, gw, NGW, 1); }
        SEAM(17);
        if (IN(18)) { phase_l1_scan(args, ws, lds, tid, lane, wave, bx, G, 1); }
        SEAM(18);
        if (IN(19)) { phase_l1_y(args, ws, lds, tid, lane, wave, bx, G, 1); }
        SEAM(19);
    }
    if (IN(20)) {
        pg8::Gemm g{(const bf16*)(ws + WS_Z) + (size_t)RL0 * 2048, (const bf16*)(ws + WS_W_DN), MLAT, DM, 2048}; pg8::StaticOrder S; S.init(MLAT, DM, G, bx);
        pg8::EpiResid E{(const float*)(ws + WS_XCTX), args.out, (float*)(ws + WS_XCTX), args.out, MOD + 3 * 6144 + 2 * 1024, RL0};
        pg8::gemm_phase<pg8::EpiResid, pg8::StaticOrder, true, true>(lds, g, S, E);
    }
    SEAM(20);
    if (IN(21)) { norm_rows<false>((const float*)(ws + WS_XCTX), args.out, args.in[I_NFFN] + DM, MOD + 3 * 6144, 3, (bf16*)(ws + WS_HF1), RL0, RL0, R, gw, NGW, lane, nullptr, nullptr); }
    SEAM(21);
    if (IN(22)) {
        pg8::Gemm g{(const bf16*)(ws + WS_HF1), (const bf16*)(ws + WS_W_F1B), MLAT, 5632, DM}; pg8::StaticOrder S; S.init(MLAT, 5632, G, bx);
        pg8::EpiSwiglu E{(bf16*)(ws + WS_HH1), FFH};
        pg8::gemm_phase<pg8::EpiSwiglu, pg8::StaticOrder, true, true>(lds, g, S, E);
    }
    SEAM(22);
    if (IN(23)) {
        pg8::Gemm g{(const bf16*)(ws + WS_HH1), (const bf16*)(ws + WS_W_F2B), MLAT, DM, FFH}; pg8::StaticOrder S; S.init(MLAT, DM, G, bx);
        pg8::EpiResid E{(const float*)(ws + WS_XCTX), args.out, (float*)(ws + WS_XCTX), args.out, MOD + 3 * 6144 + 5 * 1024, RL0};
        pg8::gemm_phase<pg8::EpiResid, pg8::StaticOrder, true, true>(lds, g, S, E);
    }
    SEAM(23);
    if (IN(24)) {
        const float* w = args.in[I_FNW];
        for (int m = gw; m < MLAT; m += NGW) {
            float* row = args.out + (size_t)m * DM; f32x4 v[4]; float ss = 0.f;
#pragma unroll
            for (int j = 0; j < 4; ++j) { v[j] = *(const f32x4*)(row + 4 * lane + 256 * j); ss += (v[j].x * v[j].x + v[j].y * v[j].y) + (v[j].z * v[j].z + v[j].w * v[j].w); }
            const float rstd = 1.0f / sqrtf(wave_sum(ss) * (1.f / DM) + RMS_EPS);
#pragma unroll
            for (int j = 0; j < 4; ++j) { const f32x4 wv = *(const f32x4*)(w + 4 * lane + 256 * j); *(f32x4*)(row + 4 * lane + 256 * j) = v[j] * rstd * wv; }
        }
    }
#undef IN
#undef SEAM
}

extern "C" void kernel_launch(void* const* d_in, const int* in_sizes, int n_in, void* d_out, int out_size, void* d_ws, size_t ws_size, hipStream_t stream) {
    static int grid = 0;
    if (grid == 0) {
        if (n_in != 35 || out_size != MLAT * DM || ws_size < WS_END) { fprintf(stderr, "kernel_launch: unexpected problem: n_in %d out %d ws %zu\n", n_in, out_size, ws_size); grid = -1; return; }
        int dev = 0, cus = 0;
        if (hipGetDevice(&dev) != hipSuccess || hipDeviceGetAttribute(&cus, hipDeviceAttributeMultiprocessorCount, dev) != hipSuccess) { grid = -1; return; }
        if (hipFuncSetAttribute((const void*)mk_fwd, hipFuncAttributeMaxDynamicSharedMemorySize, LDS_BYTES) != hipSuccess) { fprintf(stderr, "kernel_launch: hipFuncSetAttribute failed\n"); grid = -1; return; }
        int per_cu = 0;
        if (hipOccupancyMaxActiveBlocksPerMultiprocessor(&per_cu, (const void*)mk_fwd, NWAVES * 64, LDS_BYTES) != hipSuccess || per_cu < 1) fprintf(stderr, "kernel_launch: occupancy query says %d\n", per_cu);
        (void)hipGetLastError();
        grid = cus;
    }
    if (grid < 0) return;
    if (hipMemsetAsync((char*)d_ws + WS_CTL, 0, CTL_ZERO_BYTES, stream) != hipSuccess) return;
    Args a{};
    for (int i = 0; i < 35; ++i) a.in[i] = (const float*)d_in[i];
    a.out = (float*)d_out; a.ws = (unsigned char*)d_ws;
#if MK_PER_PHASE
    for (int p = 0; p < N_PHASES; ++p) { a.ph_lo = p; a.ph_hi = p + 1; hipLaunchKernelGGL(mk_fwd, dim3(grid), dim3(NWAVES * 64), LDS_BYTES, stream, a); }
#else
    a.ph_lo = 0; a.ph_hi = N_PHASES;
    hipLaunchKernelGGL(mk_fwd, dim3(grid), dim3(NWAVES * 64), LDS_BYTES, stream, a);
#endif
}
```

```cpp
#include <hip/hip_runtime.h>
#include <cstdio>
#include <cstdint>
namespace pg8 {
#define PG8_LAS __attribute__((address_space(3)))
typedef unsigned short bf16_t;
typedef short bf16x8 __attribute__((ext_vector_type(8)));
typedef float f32x4 __attribute__((ext_vector_type(4)));
typedef unsigned u32x4 __attribute__((ext_vector_type(4)));
constexpr int BM = 256, BK = 64, HALF = 128, HTB = HALF * BK * 2  , STAGE_BYTES = 8 * HTB, NXCD = 8, WGM = 8;

__host__ __device__ __forceinline__ int lds_byte(int r, int c) { const int st = (r >> 4) * 2 + (c >> 5), rr = r & 15, cc = c & 31, ob = rr * 64 + cc * 2; return st * 1024 + (ob ^ (((ob >> 9) & 1) << 5)); }
__host__ __device__ __forceinline__ void stage_rc(int b, int& R, int& C) { const int st = b / 1024, sb = b % 1024, swz = sb ^ (((sb >> 9) & 1) << 5); R = (st >> 1) * 16 + swz / 64; C = (st & 1) * 32 + (swz % 64) / 2; }
__host__ __device__ __forceinline__ int perm32(int rho) { const int n = rho >> 4, i = rho & 15; return 8 * (i >> 2) + 4 * n + (i & 3); }

struct Unit { int pm, pn; };
struct Gemm { const bf16_t* A; const bf16_t* Bt; int M, N, K; };

struct StaticOrder {
    int nM, nN, nwg, G, c;
    __host__ __device__ void init(int M, int N, int G_, int c_) { nM = M / BM; nN = N / BM; nwg = nM * nN; G = G_; c = c_; }
    __host__ __device__ bool next(int i, Unit& u) const {
        const long L = (long)i * G + c; if (L >= nwg) return false;
        int wgid = (int)L; { const int q = nwg / NXCD, r = nwg % NXCD, xcd = wgid % NXCD, off = wgid / NXCD; wgid = (xcd < r ? xcd * (q + 1) : r * (q + 1) + (xcd - r) * q) + off; }
        const int nig = WGM * nN, gid = wgid / nig, fm = gid * WGM, gsz = (nM - fm) < WGM ? (nM - fm) : WGM;
        u.pm = fm + ((wgid % nig) % gsz); u.pn = (wgid % nig) / gsz; return true;
    }
    __device__ __forceinline__ void a_ready(const Unit&) const {}
    __device__ __forceinline__ void done(const Unit&) const {}
};

__device__ __forceinline__ unsigned cvt_pk_bf16(float lo, float hi) { unsigned r; asm volatile("v_cvt_pk_bf16_f32 %0, %1, %2" : "=v"(r) : "v"(lo), "v"(hi)); return r; }
__device__ __forceinline__ float fast_silu(float a) { return a * __builtin_amdgcn_rcpf(1.0f + __expf(-a)); }

struct EpiInProj {
    static constexpr bool PERM = true, AFTER_DRAIN = false;
    bf16_t *ZG, *XBC, *QK, *V, *HALO;
    __device__ __forceinline__ void operator()(const f32x4 (&acc)[2][2][4][2], const Unit& u, int wr, int wc, int fr, int fq) const {
        const int pn = u.pn; bf16_t* base; int ld, c0; bool halo = false;
        if (pn < 4) { base = ZG; ld = 2048; c0 = 256 * pn; }
        else if (pn < 12) { base = XBC; ld = 2048; c0 = 256 * (pn - 4); halo = true; }
        else if (pn < 16) { base = QK; ld = 1024; c0 = 256 * (pn - 12); }
        else if (pn < 20) { base = V; ld = 1024; c0 = 256 * (pn - 16); }
        else { base = ZG; ld = 2048; c0 = 1024 + 256 * (pn - 20); }
        const int row0 = u.pm * BM + wr * 64 + fr, col = c0 + wc * 32 + 8 * fq;
#pragma unroll
        for (int ai = 0; ai < 2; ++ai)
#pragma unroll
            for (int m = 0; m < 4; ++m) { const int r = row0 + ai * HALF + m * 16; bf16_t* rowp = base + (size_t)r * ld + col;
                const int rr = r & 31; const bool hrow = halo && (rr < 2 || rr >= 30);
#pragma unroll
                for (int bj = 0; bj < 2; ++bj) { const f32x4 v0 = acc[ai][bj][m][0], v1 = acc[ai][bj][m][1];
                    u32x4 w; w.x = cvt_pk_bf16(v0[0], v0[1]); w.y = cvt_pk_bf16(v0[2], v0[3]); w.z = cvt_pk_bf16(v1[0], v1[1]); w.w = cvt_pk_bf16(v1[2], v1[3]);
                    *(u32x4*)(rowp + bj * HALF) = w;
                    if (hrow) { const int slot = rr < 2 ? rr : rr - 28; *(u32x4*)(HALO + ((size_t)(r >> 5) * 4 + slot) * 2048 + col + bj * HALF) = w; } } }
    }
};
struct EpiSplit2 {
    static constexpr bool PERM = true, AFTER_DRAIN = false;
    bf16_t *O0, *O1; int ld, split_tiles;
    __device__ __forceinline__ void operator()(const f32x4 (&acc)[2][2][4][2], const Unit& u, int wr, int wc, int fr, int fq) const {
        bf16_t* base = u.pn < split_tiles ? O0 : O1; const int c0 = 256 * (u.pn < split_tiles ? u.pn : u.pn - split_tiles);
        const int row0 = u.pm * BM + wr * 64 + fr, col = c0 + wc * 32 + 8 * fq;
#pragma unroll
        for (int ai = 0; ai < 2; ++ai)
#pragma unroll
            for (int m = 0; m < 4; ++m) { bf16_t* rowp = base + (size_t)(row0 + ai * HALF + m * 16) * ld + col;
#pragma unroll
                for (int bj = 0; bj < 2; ++bj) { const f32x4 v0 = acc[ai][bj][m][0], v1 = acc[ai][bj][m][1];
                    u32x4 w; w.x = cvt_pk_bf16(v0[0], v0[1]); w.y = cvt_pk_bf16(v0[2], v0[3]); w.z = cvt_pk_bf16(v1[0], v1[1]); w.w = cvt_pk_bf16(v1[2], v1[3]);
                    *(u32x4*)(rowp + bj * HALF) = w; } }
    }
};
struct EpiSwiglu {
    static constexpr bool PERM = true, AFTER_DRAIN = false;
    bf16_t* O; int ld;
    __device__ __forceinline__ void operator()(const f32x4 (&acc)[2][2][4][2], const Unit& u, int wr, int wc, int fr, int fq) const {
        const int row0 = u.pm * BM + wr * 64 + fr, col = u.pn * HALF + wc * 32 + 8 * fq;
#pragma unroll
        for (int ai = 0; ai < 2; ++ai)
#pragma unroll
            for (int m = 0; m < 4; ++m) { bf16_t* rowp = O + (size_t)(row0 + ai * HALF + m * 16) * ld + col;
                float h[8];
#pragma unroll
                for (int n = 0; n < 2; ++n)
#pragma unroll
                    for (int j = 0; j < 4; ++j) h[4 * n + j] = fast_silu(acc[ai][0][m][n][j]) * acc[ai][1][m][n][j];
                u32x4 w; w.x = cvt_pk_bf16(h[0], h[1]); w.y = cvt_pk_bf16(h[2], h[3]); w.z = cvt_pk_bf16(h[4], h[5]); w.w = cvt_pk_bf16(h[6], h[7]);
                *(u32x4*)rowp = w; }
    }
};
struct EpiResid {
    static constexpr bool PERM = false, AFTER_DRAIN = false;
    const float *resC, *resL; float *outC, *outL; const float* gate; int row_off;
    __device__ __forceinline__ void operator()(const f32x4 (&acc)[2][2][4][2], const Unit& u, int wr, int wc, int fr, int fq) const {
        const int t0 = u.pm * BM + row_off; const float* res; float* out; const float* g; int rbase;
        if (t0 < 512) { res = resC; out = outC; g = gate; rbase = t0; }
        else { res = resL; out = outL; rbase = t0 - 512; g = gate + (size_t)(1 + (rbase >> 13)) * 6144; }
        const int row0 = rbase + wr * 64 + fr, col0 = u.pn * BM + wc * 32 + 4 * fq;
        f32x4 gv[2][2];
#pragma unroll
        for (int bj = 0; bj < 2; ++bj)
#pragma unroll
            for (int n = 0; n < 2; ++n) gv[bj][n] = *(const f32x4*)(g + col0 + bj * HALF + n * 16);
#pragma unroll
        for (int ai = 0; ai < 2; ++ai)
#pragma unroll
            for (int m = 0; m < 4; ++m) { const size_t off = (size_t)(row0 + ai * HALF + m * 16) * 1024 + col0;
#pragma unroll
                for (int bj = 0; bj < 2; ++bj)
#pragma unroll
                    for (int n = 0; n < 2; ++n) { const f32x4 bs = *(const f32x4*)(res + off + bj * HALF + n * 16);
                        *(f32x4*)(out + off + bj * HALF + n * 16) = bs + gv[bj][n] * acc[ai][bj][m][n]; }
                if (m & 1) asm volatile("" ::: "memory"); }
    }
};


template <class Epi, class Sched, bool ALIGN_EPI = false, bool SP2 = false>
__device__ __forceinline__ void gemm_phase(PG8_LAS unsigned char* lds, const Gemm g, const Sched& S, const Epi& E) {
    const int tid = threadIdx.x, wid = __builtin_amdgcn_readfirstlane(tid >> 6), lane = tid & 63, wr = wid >> 2, wc = wid & 3, fr = lane & 15, fq = lane >> 4;
    const int K = g.K, nt = K / BK;
    unsigned voffA[2], voffB[2];
#pragma unroll
    for (int i = 0; i < 2; ++i) { int R, C; stage_rc(tid * 16 + i * 8192, R, C); const int Rb = Epi::PERM ? ((R & ~31) + perm32(R & 31)) : R;
        voffA[i] = (unsigned)(R * K + C) * 2u; voffB[i] = (unsigned)(Rb * K + C) * 2u; }
    const size_t kstep = (size_t)(BK * 2);
    const size_t hstep = (size_t)HALF * K * 2;
    const size_t tstep = 2 * hstep;
    const unsigned ldsw = (unsigned)wid * 1024u;
    const int aoff = lds_byte(wr * 64 + fr, fq * 8), boff = lds_byte(wc * 32 + fr, fq * 8);
#define PG8_SA(b, h) (((b) * 2 + (h)) * HTB)
#define PG8_SB(b, h) ((4 + (b) * 2 + (h)) * HTB)
#define PG8_STAGE(bufoff, gbase, voff) do { _Pragma("unroll") for (int _i = 0; _i < 2; ++_i) \
        __builtin_amdgcn_global_load_lds((const unsigned*)((const char*)(gbase) + (voff)[_i]), (PG8_LAS unsigned*)(lds + (bufoff) + ldsw + _i * 8192), 16, 0, 0); } while (0)
#define PG8_LDA(dst, b, h) do { _Pragma("unroll") for (int m = 0; m < 4; ++m) _Pragma("unroll") for (int k = 0; k < 2; ++k) dst[m][k] = *(const PG8_LAS bf16x8*)(lds + PG8_SA(b, h) + aoff + m * 2048 + k * 1024); } while (0)
#define PG8_LDB(dst, b, h) do { _Pragma("unroll") for (int n = 0; n < 2; ++n) _Pragma("unroll") for (int k = 0; k < 2; ++k) dst[n][k] = *(const PG8_LAS bf16x8*)(lds + PG8_SB(b, h) + boff + n * 2048 + k * 1024); } while (0)
#define PG8_MMA(ai, bj, At, Bt) do { __builtin_amdgcn_s_setprio(1); _Pragma("unroll") for (int m = 0; m < 4; ++m) _Pragma("unroll") for (int n = 0; n < 2; ++n) _Pragma("unroll") for (int k = 0; k < 2; ++k) \
        acc[ai][bj][m][n] = __builtin_amdgcn_mfma_f32_16x16x32_bf16(Bt[n][k], At[m][k], acc[ai][bj][m][n], 0, 0, 0); __builtin_amdgcn_s_setprio(0); } while (0)
#define PG8_WAIT_V(n) asm volatile("s_waitcnt vmcnt(" #n ")" ::: "memory")
#define PG8_WAIT_L(n) asm volatile("s_waitcnt lgkmcnt(" #n ")" ::: "memory")
#define PG8_BAR __builtin_amdgcn_s_barrier()
#define PG8_SCHED __builtin_amdgcn_sched_barrier(0)
    Unit cur, nxt; int ui = 0;
    if (!S.next(0, cur)) return;
    f32x4 acc[2][2][4][2];
#pragma unroll
    for (int a = 0; a < 2; ++a)
#pragma unroll
        for (int b = 0; b < 2; ++b)
#pragma unroll
            for (int m = 0; m < 4; ++m)
#pragma unroll
                for (int n = 0; n < 2; ++n) acc[a][b][m][n] = (f32x4){0.f, 0.f, 0.f, 0.f};
    bf16x8 At[4][2], B0[2][2], B1[2][2];
    const char* cA = (const char*)g.A + (size_t)cur.pm * tstep; const char* cB = (const char*)g.Bt + (size_t)cur.pn * tstep;
    S.a_ready(cur);
    if constexpr (SP2) {
        PG8_STAGE(PG8_SB(0, 0), cB, voffB); PG8_STAGE(PG8_SB(0, 1), cB + hstep, voffB); PG8_STAGE(PG8_SA(0, 0), cA, voffA); PG8_STAGE(PG8_SA(0, 1), cA + hstep, voffA);
        if (wr == 1) PG8_BAR;
        PG8_WAIT_V(2); PG8_BAR;
        PG8_STAGE(PG8_SB(1, 0), cB + kstep, voffB); PG8_STAGE(PG8_SA(1, 0), cA + kstep, voffA); PG8_STAGE(PG8_SB(1, 1), cB + hstep + kstep, voffB);
        PG8_WAIT_V(6); PG8_BAR;
    } else {
        PG8_STAGE(PG8_SB(0, 0), cB, voffB); PG8_STAGE(PG8_SA(0, 0), cA, voffA); PG8_STAGE(PG8_SB(0, 1), cB + hstep, voffB); PG8_STAGE(PG8_SA(0, 1), cA + hstep, voffA);
        if (wr == 1) PG8_BAR;
        PG8_WAIT_V(4); PG8_BAR;
        PG8_STAGE(PG8_SB(1, 0), cB + kstep, voffB); PG8_STAGE(PG8_SA(1, 0), cA + kstep, voffA); PG8_STAGE(PG8_SB(1, 1), cB + hstep + kstep, voffB);
        PG8_WAIT_V(6); PG8_BAR;
    }
    for (;;) {
        const bool has_next = S.next(ui + 1, nxt);
        const char* nA = has_next ? (const char*)g.A + (size_t)nxt.pm * tstep : cA; const char* nB = has_next ? (const char*)g.Bt + (size_t)nxt.pn * tstep : cB;
        for (int t = 0; t < nt; t += 2) {
            const bool last = (t == nt - 2);
            const char* a1 = cA + (size_t)(t + 1) * kstep;
            const char* a2 = last ? nA : cA + (size_t)(t + 2) * kstep; const char* b2 = last ? nB : cB + (size_t)(t + 2) * kstep;
            const char* a3 = a2 + kstep; const char* b3 = b2 + kstep;
            if (last && has_next) S.a_ready(nxt);
            if constexpr (SP2) {
            PG8_LDB(B0, 0, 0); PG8_LDB(B1, 0, 1); PG8_SCHED; PG8_LDA(At, 0, 0); PG8_STAGE(PG8_SA(1, 1), a1 + hstep, voffA);
            PG8_WAIT_V(8); PG8_WAIT_L(0); PG8_BAR; PG8_MMA(0, 0, At, B0); PG8_MMA(0, 1, At, B1); PG8_BAR; PG8_SCHED;
            PG8_LDA(At, 0, 1); PG8_STAGE(PG8_SB(0, 0), b2, voffB); PG8_STAGE(PG8_SB(0, 1), b2 + hstep, voffB); PG8_STAGE(PG8_SA(0, 0), a2, voffA);
            PG8_WAIT_V(8); PG8_WAIT_L(0); PG8_BAR; PG8_MMA(1, 0, At, B0); PG8_MMA(1, 1, At, B1); PG8_BAR; PG8_SCHED;
            PG8_LDB(B0, 1, 0); PG8_LDB(B1, 1, 1); PG8_SCHED; PG8_LDA(At, 1, 0); PG8_STAGE(PG8_SA(0, 1), a2 + hstep, voffA);
            PG8_WAIT_V(8); PG8_WAIT_L(0); PG8_BAR; PG8_MMA(0, 0, At, B0); PG8_MMA(0, 1, At, B1); PG8_BAR; PG8_SCHED;
            PG8_LDA(At, 1, 1); PG8_STAGE(PG8_SB(1, 0), b3, voffB); PG8_STAGE(PG8_SB(1, 1), b3 + hstep, voffB); PG8_STAGE(PG8_SA(1, 0), a3, voffA);
            PG8_WAIT_V(8); PG8_WAIT_L(0); PG8_BAR; PG8_MMA(1, 0, At, B0); PG8_MMA(1, 1, At, B1); PG8_BAR; PG8_SCHED;
            } else {
            PG8_LDB(B0, 0, 0); PG8_SCHED; PG8_LDA(At, 0, 0); PG8_STAGE(PG8_SA(1, 1), a1 + hstep, voffA);
            PG8_WAIT_L(8); PG8_BAR; PG8_WAIT_L(0); PG8_MMA(0, 0, At, B0); PG8_BAR; PG8_SCHED;
            PG8_LDB(B1, 0, 1); PG8_STAGE(PG8_SB(0, 0), b2, voffB);
            PG8_BAR; PG8_WAIT_L(0); PG8_MMA(0, 1, At, B1); PG8_BAR;
            PG8_LDA(At, 0, 1); PG8_STAGE(PG8_SA(0, 0), a2, voffA);
            PG8_BAR; PG8_WAIT_L(0); PG8_MMA(1, 0, At, B0); PG8_BAR; PG8_SCHED;
            PG8_STAGE(PG8_SB(0, 1), b2 + hstep, voffB);
            PG8_WAIT_V(6); PG8_BAR; PG8_MMA(1, 1, At, B1); PG8_BAR;
            PG8_LDB(B0, 1, 0); PG8_SCHED; PG8_LDA(At, 1, 0); PG8_STAGE(PG8_SA(0, 1), a2 + hstep, voffA);
            PG8_WAIT_L(8); PG8_BAR; PG8_WAIT_L(0); PG8_MMA(0, 0, At, B0); PG8_BAR; PG8_SCHED;
            PG8_LDB(B1, 1, 1); PG8_STAGE(PG8_SB(1, 0), b3, voffB);
            PG8_BAR; PG8_WAIT_L(0); PG8_MMA(0, 1, At, B1); PG8_BAR;
            PG8_LDA(At, 1, 1); PG8_STAGE(PG8_SA(1, 0), a3, voffA);
            PG8_BAR; PG8_WAIT_L(0); PG8_MMA(1, 0, At, B0); PG8_BAR; PG8_SCHED;
            PG8_STAGE(PG8_SB(1, 1), b3 + hstep, voffB);
            PG8_WAIT_V(6); PG8_BAR; PG8_MMA(1, 1, At, B1); PG8_BAR;
            }
        }
        if constexpr (ALIGN_EPI) { if (wr == 0) PG8_BAR; }
        if constexpr (!Epi::AFTER_DRAIN) { E(acc, cur, wr, wc, fr, fq); S.done(cur); }
        if (!has_next) break;
#pragma unroll
        for (int a = 0; a < 2; ++a)
#pragma unroll
            for (int b = 0; b < 2; ++b)
#pragma unroll
                for (int m = 0; m < 4; ++m)
#pragma unroll
                    for (int n = 0; n < 2; ++n) acc[a][b][m][n] = (f32x4){0.f, 0.f, 0.f, 0.f};
        cur = nxt; cA = nA; cB = nB; ++ui;
        if constexpr (ALIGN_EPI) { if (wr == 1) PG8_BAR; }
    }
    PG8_WAIT_V(0);
    if constexpr (!ALIGN_EPI) { if (wr == 0) PG8_BAR; }
    PG8_BAR;
    if constexpr (Epi::AFTER_DRAIN) { E.fused(acc, cur, wr, wc, fr, fq, lds, wid, lane); S.done(cur); }
#undef PG8_SA
#undef PG8_SB
#undef PG8_STAGE
#undef PG8_LDA
#undef PG8_LDB
#undef PG8_MMA
#undef PG8_WAIT_V
#undef PG8_WAIT_L
#undef PG8_BAR
#undef PG8_SCHED
}
}


constexpr int NWAVES = 8;
constexpr int DM = 1024, SEQ = 8192, CTXL = 256, NB = 2;
constexpr int R = NB * (SEQ + CTXL);
constexpr int RL0 = NB * CTXL;
constexpr int MLAT = NB * SEQ;
constexpr int FFH = 2816;
constexpr int ABIN = 6160;
constexpr float RMS_EPS = 1e-6f, LN_EPS = 1e-5f;

constexpr size_t MiB = 1u << 20;
constexpr size_t WS_CTL = 0, CTL_ZERO_BYTES = 1 * MiB;
constexpr size_t CTL_MOD = 256 * 1024;
constexpr size_t WS_XCTX = 1 * MiB;
constexpr size_t WS_DTRAW = 3 * MiB, WS_DTF = WS_DTRAW + 1280 * 1024, WS_DTB = WS_DTF + 1280 * 1024, WS_CSF = WS_DTB + 1280 * 1024, WS_RB = WS_CSF + 1280 * 1024;
constexpr size_t WS_WQK = 9 * MiB + 256 * 1024;
constexpr size_t WS_HALO = 9 * MiB + 512 * 1024;
constexpr size_t WS_W_IN = 18 * MiB, WS_W_OUT = 30 * MiB, WS_W_F1 = 34 * MiB, WS_W_F2 = 45 * MiB;
constexpr size_t WS_ZG = 51 * MiB, WS_XBC = 117 * MiB, WS_QK = 183 * MiB, WS_V = 216 * MiB;
constexpr size_t WS_HF0 = WS_V, WS_HH0 = WS_XBC;
constexpr size_t WS_GATE = 3 * MiB, WS_BC = WS_GATE + 1280 * 1024, WS_AJ = WS_BC + 768 * 1024, WS_CM = WS_AJ + 768 * 1024, WS_CH = WS_CM + 768 * 1024, WS_NV = WS_CH + 256 * 1024;
constexpr size_t WS_W_UP = 10 * MiB, WS_H1 = 18 * MiB, WS_XC = 18 * MiB, WS_XM = 51 * MiB, WS_Z = 117 * MiB, WS_ST1 = 183 * MiB;
constexpr size_t WS_W_DN = 53 * MiB, WS_W_F1B = 57 * MiB, WS_W_F2B = 68 * MiB;
constexpr size_t WS_HF1 = WS_Z, WS_HH1 = 150 * MiB;
constexpr size_t WS_END = 256 * MiB;
constexpr size_t DO_H = 0, DO_ST_SSD = 0, DO_ST_RET = 16 * MiB;
constexpr int CW_TMO = 0, CW_CODE = 1, CW_BAR = 4096;

constexpr int RING_BYTES = 131072;
constexpr int SCR_BYTES = 143360;
constexpr int LDSCTL_OFF = SCR_BYTES, MISC_OFF = LDSCTL_OFF + 320;
constexpr int LDS_BYTES = 147456;

#define GAS __attribute__((address_space(1)))
#define LAS __attribute__((address_space(3)))
typedef unsigned short bf16;
typedef unsigned v4u __attribute__((ext_vector_type(4)));
typedef unsigned v2u __attribute__((ext_vector_type(2)));
typedef float f32x4 __attribute__((ext_vector_type(4)));
typedef short bf16x8 __attribute__((ext_vector_type(8)));
typedef short s16x4 __attribute__((ext_vector_type(4)));
typedef GAS unsigned gu32;
#define RLX_AGENT __ATOMIC_RELAXED, __HIP_MEMORY_SCOPE_AGENT
#define LDS_WAIT() asm volatile("s_waitcnt lgkmcnt(0)" ::: "memory")
#define VM_WAIT() asm volatile("s_waitcnt vmcnt(0)" ::: "memory")
__device__ __forceinline__ unsigned f2bf(float f) { unsigned u = __builtin_bit_cast(unsigned, f); return (u + 0x7fffu + ((u >> 16) & 1u)) >> 16; }
typedef float f32x2_t __attribute__((ext_vector_type(2)));
typedef __bf16 bf16x2_t __attribute__((ext_vector_type(2)));
__device__ __forceinline__ unsigned pk2(float lo, float hi) { f32x2_t v = {lo, hi}; bf16x2_t b = __builtin_convertvector(v, bf16x2_t); return __builtin_bit_cast(unsigned, b); }
__device__ __forceinline__ float bf2f(unsigned short h) { return __builtin_bit_cast(float, (unsigned)h << 16); }
__device__ __forceinline__ float bflo(unsigned w) { return __builtin_bit_cast(float, w << 16); }
__device__ __forceinline__ float bfhi(unsigned w) { return __builtin_bit_cast(float, w & 0xffff0000u); }
__device__ __forceinline__ float silu_f(float a) { return a * __builtin_amdgcn_rcpf(1.0f + __expf(-a)); }
__device__ __forceinline__ float softplus_f(float x) { return x > 20.f ? x : log1pf(__expf(x)); }
__device__ __forceinline__ float logsig_f(float x) { return x >= 0.f ? -log1pf(__expf(-x)) : x - log1pf(__expf(x)); }
__device__ __forceinline__ float wave_sum(float v) {
#pragma unroll
    for (int o = 1; o < 64; o <<= 1) v += __shfl_xor(v, o);
    return v;
}
__device__ __forceinline__ float wave_max(float v) {
#pragma unroll
    for (int o = 1; o < 64; o <<= 1) v = fmaxf(v, __shfl_xor(v, o));
    return v;
}

#define XB_TMO      128
#define XB_XCNT(j)  (256  + 64 * (j))
#define XB_XSUB(j)  (1280 + 64 * (j))
#define XB_XGEN(j)  (2304 + 64 * (j))
#define XB_TOP      3328
#define XB_TOPGEN   3392
#define XCD_BAR_WORDS 3456
#define XB_SPIN_CAP (1u << 18)

__device__ __forceinline__ unsigned xb_ld(unsigned* p)              { return __hip_atomic_load(p, __ATOMIC_RELAXED, __HIP_MEMORY_SCOPE_AGENT); }
__device__ __forceinline__ unsigned xb_add(unsigned* p, unsigned v) { return __hip_atomic_fetch_add(p, v, __ATOMIC_RELAXED, __HIP_MEMORY_SCOPE_AGENT); }
__device__ __forceinline__ unsigned xb_xcc_id() { return (unsigned)__builtin_amdgcn_s_getreg((3 << 11) | 20) & 0xFu; }
#define XB_SPIN(cond, bar) do { unsigned _sp = 0; while (cond) { __builtin_amdgcn_s_sleep(1); \
    if ((++_sp & 255u) == 0u) { if (xb_ld(&(bar)[XB_TMO])) break; if (_sp > XB_SPIN_CAP) { atomicAdd(&(bar)[XB_TMO], 1u); break; } } } } while (0)

struct XcdBarrier {
    unsigned* bar; unsigned x;
    volatile LAS unsigned* st;
};

__device__ __forceinline__ XcdBarrier xcd_barrier_post(unsigned* bar, volatile LAS unsigned* st) {
    XcdBarrier b; b.bar = bar; b.x = xb_xcc_id(); b.st = st;
    if (threadIdx.x == 0) (void)xb_add(&bar[XB_XCNT(b.x)], 1u);
    return b;
}
__device__ __forceinline__ void xcd_barrier_complete(unsigned* bar, unsigned x, unsigned& nloc, unsigned& nx) {
    const unsigned G = gridDim.x * gridDim.y * gridDim.z;
    unsigned sum, cnt, mine, sp = 0u;
    for (;;) {
        sum = 0u; cnt = 0u; mine = 0u;
#pragma unroll
        for (unsigned j = 0; j < 16; ++j) { const unsigned c = xb_ld(&bar[XB_XCNT(j)]); sum += c; cnt += (c > 0u) ? 1u : 0u; mine = (j == x) ? c : mine; }
        if (sum == G) break;
        __builtin_amdgcn_s_sleep(1);
        if ((++sp & 255u) == 0u) { if (xb_ld(&bar[XB_TMO])) break; if (sp > XB_SPIN_CAP) { atomicAdd(&bar[XB_TMO], 1u); break; } }
    }
    nloc = mine > 0u ? mine : 1u; nx = cnt > 0u ? cnt : 1u;
}

__device__ __forceinline__ void xcd_barrier(const XcdBarrier& b) {
    asm volatile("s_waitcnt vmcnt(0)" ::: "memory");
    __syncthreads();
    if (threadIdx.x == 0) {
        unsigned* bar = b.bar;
        __builtin_amdgcn_s_waitcnt(0);
        unsigned nloc = b.st[0], nx = b.st[1];
        if (nloc == 0u) { xcd_barrier_complete(bar, b.x, nloc, nx); b.st[0] = nloc; b.st[1] = nx; }
        const unsigned old = xb_add(&bar[XB_XSUB(b.x)], 1u);
        const unsigned gen = old / nloc;
        if (old + 1u == (gen + 1u) * nloc) {
            __builtin_amdgcn_fence(__ATOMIC_RELEASE, "agent");
            asm volatile("s_waitcnt vmcnt(0)" ::: "memory");
            const unsigned og = xb_add(&bar[XB_TOP], 1u);
            const unsigned tg = og / nx;
            if (og + 1u == (tg + 1u) * nx) xb_add(&bar[XB_TOPGEN], 1u);
            else XB_SPIN(xb_ld(&bar[XB_TOPGEN]) == tg, bar);
            __builtin_amdgcn_fence(__ATOMIC_ACQUIRE, "agent");
            xb_add(&bar[XB_XGEN(b.x)], 1u);
            asm volatile("s_waitcnt vmcnt(0)" ::: "memory");
        } else {
            XB_SPIN(xb_ld(&bar[XB_XGEN(b.x)]) == gen, bar);
            __builtin_amdgcn_fence(__ATOMIC_ACQUIRE, "agent");
            asm volatile("s_waitcnt vmcnt(0)" ::: "memory");
        }
    }
    __syncthreads();
}


struct Args { const float* in[35]; float* out; unsigned char* ws; int ph_lo, ph_hi; };
enum { I_X = 0, I_C, I_CTX, I_CCTX, I_ADAW, I_ADAB, I_NMIX, I_NFFN, I_W1, I_W3, I_W2, I_ABIN, I_ABCW, I_ABCB, I_DTBF, I_DTBB, I_ALF, I_ALB, I_SSDD, I_SSDNW,
       I_RLF, I_RLB, I_ABOUT, I_MLUP, I_MLCW, I_MLCB, I_MLWQ, I_MLWK, I_MLWV, I_MLGW, I_MLGB, I_MLNW, I_MLSKIP, I_MLDOWN, I_FNW };

__device__ __forceinline__ void transpose_item(const float* W, int ldw, int K, bf16* WT, int kb, int src_n0, int dst_n0, LAS float* scr, int lane) {
    const int k0 = 64 * kb;
#pragma unroll 8
    for (int i = 0; i < 32; ++i) { const int kk = 2 * i + (lane >> 5); scr[kk * 33 + (lane & 31)] = W[(size_t)(k0 + kk) * ldw + src_n0 + (lane & 31)]; }
    LDS_WAIT(); asm volatile("" ::: "memory");
    const int c = lane & 7;
#pragma unroll
    for (int j = 0; j < 4; ++j) { const int n = (lane >> 3) + 8 * j; const LAS float* s = scr + (8 * c) * 33 + n;
        v4u o; o.x = pk2(s[0 * 33], s[1 * 33]); o.y = pk2(s[2 * 33], s[3 * 33]); o.z = pk2(s[4 * 33], s[5 * 33]); o.w = pk2(s[6 * 33], s[7 * 33]);
        *(GAS v4u*)(WT + (size_t)(dst_n0 + n) * K + k0 + 8 * c) = o; }
    LDS_WAIT(); asm volatile("" ::: "memory");
}
__device__ __forceinline__ void conv_plain(const float* W, int K, int N, bf16* WT, LAS float* scr, int gw, int NGW, int lane) {
    const int nblk = N / 32, nit = (K / 64) * nblk;
    for (int it = gw; it < nit; it += NGW) { const int kb = it / nblk, nb = it % nblk; transpose_item(W, N, K, WT, kb, 32 * nb, 32 * nb, scr, lane); }
}
__device__ __forceinline__ void conv_ffn1(const float* w1, const float* w3, bf16* WT, LAS float* scr, int gw, int NGW, int lane) {
    const int nblk = 5632 / 32, nit = (1024 / 64) * nblk;
    for (int it = gw; it < nit; it += NGW) { const int kb = it / nblk, nb = it % nblk; const int n0 = 32 * nb, pn = n0 >> 8, within = n0 & 255;
        const float* W = within < 128 ? w1 : w3; const int sc = 128 * pn + (within & 127);
        transpose_item(W, FFH, 1024, WT, kb, sc, n0, scr, lane); }
}
__device__ __forceinline__ void conv_abin(const float* W, bf16* WT, LAS float* scr, int gw, int NGW, int lane) {
    const int nblk = 6144 / 32, nit = (1024 / 64) * nblk;
    for (int it = gw; it < nit; it += NGW) { const int kb = it / nblk, nb = it % nblk; const int n0 = 32 * nb;
        transpose_item(W, ABIN, 1024, WT, kb, n0 + (n0 >= 3072 ? 16 : 0), n0, scr, lane); }
}

template <bool WITH_DT>
__device__ __forceinline__ void norm_rows(const float* srcC, const float* srcL, const float* w, const float* mod, int si, bf16* dst, int dst_off, int row_lo, int row_hi,
                                          int gw, int NGW, int lane, const LAS float* wdt, float* dtraw) {
    for (int m = row_lo + gw; m < row_hi; m += NGW) {
        const float* src = m < RL0 ? srcC + (size_t)m * DM : srcL + (size_t)(m - RL0) * DM;
        const float* mv = mod + (size_t)(m < RL0 ? 0 : 1 + ((m - RL0) >> 13)) * 6144 + si * 1024;
        f32x4 v[4]; float ss = 0.f;
#pragma unroll
        for (int j = 0; j < 4; ++j) { v[j] = *(const f32x4*)(src + 4 * lane + 256 * j); ss += (v[j].x * v[j].x + v[j].y * v[j].y) + (v[j].z * v[j].z + v[j].w * v[j].w); }
        const float rstd = 1.0f / sqrtf(wave_sum(ss) * (1.f / DM) + RMS_EPS);
#pragma unroll
        for (int j = 0; j < 4; ++j) { const int c = 4 * lane + 256 * j; const f32x4 wv = *(const f32x4*)(w + c), sh = *(const f32x4*)(mv + c), sc = *(const f32x4*)(mv + 1024 + c);
            v[j] = (v[j] * rstd * wv) * (sc + 1.0f) + sh;
            v2u o; o.x = pk2(v[j].x, v[j].y); o.y = pk2(v[j].z, v[j].w);
            *(v2u*)(dst + (size_t)(m - dst_off) * DM + c) = o; }
        if constexpr (WITH_DT) {
            float d[16];
#pragma unroll
            for (int c = 0; c < 16; ++c) d[c] = 0.f;
#pragma unroll
            for (int j = 0; j < 4; ++j) {
#pragma unroll
                for (int e = 0; e < 4; ++e) { const int k = 4 * lane + 256 * j + e; const float hv = v[j][e]; const LAS f32x4* wp = (const LAS f32x4*)(wdt + k * 16);
                    const f32x4 w0 = wp[0], w1 = wp[1], w2 = wp[2], w3 = wp[3];
                    d[0] += hv * w0.x; d[1] += hv * w0.y; d[2] += hv * w0.z; d[3] += hv * w0.w; d[4] += hv * w1.x; d[5] += hv * w1.y; d[6] += hv * w1.z; d[7] += hv * w1.w;
                    d[8] += hv * w2.x; d[9] += hv * w2.y; d[10] += hv * w2.z; d[11] += hv * w2.w; d[12] += hv * w3.x; d[13] += hv * w3.y; d[14] += hv * w3.z; d[15] += hv * w3.w; }
                asm volatile("" ::: "memory");
            }
            float mine = 0.f;
#pragma unroll
            for (int c = 0; c < 16; ++c) { const float s = wave_sum(d[c]); if (lane == c) mine = s; }
            if (lane < 16) dtraw[(size_t)m * 16 + lane] = mine;
        }
    }
}


#define MFMA16(a, b, c) __builtin_amdgcn_mfma_f32_16x16x32_bf16(a, b, c, 0, 0, 0)
__device__ __forceinline__ bf16x8 frag_nat(const LAS unsigned char* base, int pitch, int r0, int k0, int lane) {
    return *(const LAS bf16x8*)(base + (r0 + (lane & 15)) * pitch + (k0 + 8 * (lane >> 4)) * 2);
}
__device__ __forceinline__ bf16x8 frag_tr(const LAS unsigned char* base, int pitch, int k0, int i0, int lane) {
    const int g = lane >> 4, q = (lane & 15) >> 2, p = lane & 3;
    const LAS unsigned char* a = base + (k0 + 8 * g + q) * pitch + (i0 + 4 * p) * 2;
    const s16x4 lo = __builtin_bit_cast(s16x4, __builtin_amdgcn_ds_read_tr16_b64_v4i16((LAS s16x4*)a));
    const s16x4 hi = __builtin_bit_cast(s16x4, __builtin_amdgcn_ds_read_tr16_b64_v4i16((LAS s16x4*)(a + 4 * pitch)));
    bf16x8 r; r[0] = lo[0]; r[1] = lo[1]; r[2] = lo[2]; r[3] = lo[3]; r[4] = hi[0]; r[5] = hi[1]; r[6] = hi[2]; r[7] = hi[3]; return r;
}
__device__ __forceinline__ v2u pack4(f32x4 v) { v2u o; o.x = pk2(v.x, v.y); o.y = pk2(v.z, v.w); return o; }
__device__ __forceinline__ f32x4 unpack4(v2u w) { f32x4 r; r.x = bflo(w.x); r.y = bfhi(w.x); r.z = bflo(w.y); r.w = bfhi(w.y); return r; }
__device__ __forceinline__ v4u scale8(v4u x, float s) { v4u o; o.x = pk2(bflo(x.x) * s, bfhi(x.x) * s); o.y = pk2(bflo(x.y) * s, bfhi(x.y) * s); o.z = pk2(bflo(x.z) * s, bfhi(x.z) * s); o.w = pk2(bflo(x.w) * s, bfhi(x.w) * s); return o; }

__device__ __forceinline__ void chunk_rows(int ci, int& base, int& L) { if (ci < 2) { base = 256 * ci; L = 256; } else { base = RL0 + 512 * (ci - 2); L = 512; } }

__device__ __forceinline__ void conv8(const v4u (&x)[5], const float (&cw)[5][8], const float (&cb)[8], v4u& out) {
    float o[8];
#pragma unroll
    for (int c = 0; c < 8; ++c) o[c] = cb[c];
#pragma unroll
    for (int k = 0; k < 5; ++k) { const v4u v = x[k];
        o[0] += cw[k][0] * bflo(v.x); o[1] += cw[k][1] * bfhi(v.x); o[2] += cw[k][2] * bflo(v.y); o[3] += cw[k][3] * bfhi(v.y);
        o[4] += cw[k][4] * bflo(v.z); o[5] += cw[k][5] * bfhi(v.z); o[6] += cw[k][6] * bflo(v.w); o[7] += cw[k][7] * bfhi(v.w); }
#pragma unroll
    for (int c = 0; c < 8; ++c) o[c] = silu_f(o[c]);
    out.x = pk2(o[0], o[1]); out.y = pk2(o[2], o[3]); out.z = pk2(o[4], o[5]); out.w = pk2(o[6], o[7]);
}
__device__ __forceinline__ void phase_l0_prep(const Args& args, unsigned char* ws, LAS unsigned char* lds, int tid, int lane, int wave, int bx, int G, int gw, int NGW) {
    bf16* XBC = (bf16*)(ws + WS_XBC); const bf16* HALO = (const bf16*)(ws + WS_HALO);
    {
        const int cg = tid & 255, c0 = 8 * cg;
        float cw[5][8], cb[8];
#pragma unroll
        for (int k = 0; k < 5; ++k)
#pragma unroll
            for (int c = 0; c < 8; ++c) cw[k][c] = args.in[I_ABCW][k * 2048 + c0 + c];
#pragma unroll
        for (int c = 0; c < 8; ++c) cb[c] = args.in[I_ABCB][c0 + c];
        for (int u = bx; u < 264; u += G) {
            const int blk = 2 * u + (tid >> 8), r0 = 32 * blk;
            int slo, shi; if (r0 < RL0) { slo = r0 & ~255; shi = slo + 256; } else { slo = RL0 + ((r0 - RL0) & ~8191); shi = slo + 8192; }
            const v4u zero = (v4u){0u, 0u, 0u, 0u};
            v4u raw[20];
            raw[0] = r0 > slo ? *(const v4u*)(HALO + ((size_t)(blk - 1) * 4 + 2) * 2048 + c0) : zero;
            raw[1] = r0 > slo ? *(const v4u*)(HALO + ((size_t)(blk - 1) * 4 + 3) * 2048 + c0) : zero;
#pragma unroll
            for (int t = 0; t < 18; ++t) raw[2 + t] = *(const v4u*)(XBC + (size_t)(r0 + t) * 2048 + c0);
#pragma unroll
            for (int t = 0; t < 16; ++t) { v4u x5[5] = {raw[t], raw[t + 1], raw[t + 2], raw[t + 3], raw[t + 4]}; v4u o; conv8(x5, cw, cb, o); *(v4u*)(XBC + (size_t)(r0 + t) * 2048 + c0) = o; }
            raw[0] = raw[16]; raw[1] = raw[17]; raw[2] = raw[18]; raw[3] = raw[19];
#pragma unroll
            for (int t = 0; t < 14; ++t) raw[4 + t] = *(const v4u*)(XBC + (size_t)(r0 + 18 + t) * 2048 + c0);
            raw[18] = r0 + 32 < shi ? *(const v4u*)(HALO + ((size_t)(blk + 1) * 4 + 0) * 2048 + c0) : zero;
            raw[19] = r0 + 32 < shi ? *(const v4u*)(HALO + ((size_t)(blk + 1) * 4 + 1) * 2048 + c0) : zero;
#pragma unroll
            for (int t = 0; t < 16; ++t) { v4u x5[5] = {raw[t], raw[t + 1], raw[t + 2], raw[t + 3], raw[t + 4]}; v4u o; conv8(x5, cw, cb, o); *(v4u*)(XBC + (size_t)(r0 + 16 + t) * 2048 + c0) = o; }
        }
    }
    {
        bf16* QK = (bf16*)(ws + WS_QK);
        const float inv = exp2f(-(float)(lane & 31) * (13.287712379549449f / 32.0f));
        for (int m = gw; m < R; m += NGW) {
            bf16* row = QK + (size_t)m * 1024;
            float cs = 1.f, sn = 0.f;
            if (m >= RL0) { const int t = (m - RL0) & 8191; const float ang = (float)(lane < 32 ? (t >> 6) : (t & 63)) * inv; sincosf(ang, &sn, &cs); }
#pragma unroll
            for (int hh = 0; hh < 8; ++hh) { const float x1 = bf2f(row[128 * hh + lane]), x2 = bf2f(row[128 * hh + 64 + lane]); const float sc = hh >= 4 ? 0.08838834764831845f : 1.0f;
                row[128 * hh + lane] = (bf16)f2bf((x1 * cs - x2 * sn) * sc); row[128 * hh + 64 + lane] = (bf16)f2bf((x1 * sn + x2 * cs) * sc); }
        }
    }
    {
        const float* dtraw = (const float*)(ws + WS_DTRAW); float* DTF = (float*)(ws + WS_DTF); float* DTB = (float*)(ws + WS_DTB); float* CSF = (float*)(ws + WS_CSF); float* RBA = (float*)(ws + WS_RB);
        for (int wu = gw; wu < 34 * 16; wu += NGW) {
            const int ci = wu >> 4, h = wu & 15; int base, L; chunk_rows(ci, base, L);
            const float bf_ = args.in[I_DTBF][h], bb_ = args.in[I_DTBB][h], af = __expf(args.in[I_ALF][h]), ab = __expf(args.in[I_ALB][h]);
            const int per = L >> 6, t0 = lane * per;
            float dtf[8], dtb[8], laf[8], lab[8]; float sf = 0.f, sb = 0.f;
#pragma unroll
            for (int t = 0; t < 8; ++t) if (t < per) { const float rawv = dtraw[(size_t)(base + t0 + t) * 16 + h]; dtf[t] = softplus_f(rawv + bf_); dtb[t] = softplus_f(rawv + bb_); laf[t] = -dtf[t] * af; lab[t] = -dtb[t] * ab; sf += laf[t]; sb += lab[t]; }
            float pf = sf, pb = sb;
#pragma unroll
            for (int o = 1; o < 64; o <<= 1) { const float a = __shfl_up(pf, o), c = __shfl_down(pb, o); if (lane >= o) pf += a; if (lane + o < 64) pb += c; }
            float runf = pf - sf;
#pragma unroll
            for (int t = 0; t < 8; ++t) if (t < per) { runf += laf[t]; const size_t o = (size_t)(base + t0 + t) * 16 + h; CSF[o] = runf; DTF[o] = dtf[t]; DTB[o] = dtb[t]; }
            float runb = pb - sb;
#pragma unroll
            for (int t = 7; t >= 0; --t) if (t < per) { runb += lab[t]; RBA[(size_t)(base + t0 + t) * 16 + h] = runb; }
        }
    }
}

constexpr int SCAN_PITCH = 144;
__device__ __forceinline__ void phase_l0_scan(const Args& args, unsigned char* ws, unsigned char* dob, LAS unsigned char* lds, int tid, int lane, int wave, int bx, int G) {
    LAS unsigned char* Kt = lds; LAS unsigned char* Vt = lds + 128 * SCAN_PITCH; LAS float* TB = (LAS float*)(lds + 256 * SCAN_PITCH);
    const float* DTF = (const float*)(ws + WS_DTF); const float* DTB = (const float*)(ws + WS_DTB); const float* CSF = (const float*)(ws + WS_CSF); const float* RBA = (const float*)(ws + WS_RB);
    for (int u = bx; u < 256; u += G) {
        const bool ssd = u < 128; int b, dir, h; const bf16* Ksrc; const bf16* Vsrc; int ld; bf16* Sout; float lg = 0.f;
        if (ssd) { const int s = u >> 1, nt = u & 1; b = s >> 5; dir = (s >> 4) & 1; h = s & 15; ld = 2048;
            Ksrc = (const bf16*)(ws + WS_XBC) + 1024 + 128 * (h >> 2) + 64 * nt; Vsrc = (const bf16*)(ws + WS_XBC) + 64 * h;
            Sout = (bf16*)(dob + DO_ST_SSD) + (size_t)s * 16 * 8192 + 64 * nt; }
        else { const int v = u - 128, s = v >> 3, t = v & 7, et = t >> 1, dt = t & 1; b = s >> 3; dir = (s >> 2) & 1; h = s & 3; ld = 1024;
            Ksrc = (const bf16*)(ws + WS_QK) + 512 + 128 * h + 64 * dt; Vsrc = (const bf16*)(ws + WS_V) + 256 * h + 64 * et;
            Sout = (bf16*)(dob + DO_ST_RET) + (size_t)s * 16 * 32768 + (size_t)(64 * et) * 128 + 64 * dt;
            lg = logsig_f(args.in[dir ? I_RLB : I_RLF][h]); }
        const size_t kstride = ssd ? 8192 : 32768;
        const int wd = wave & 3, we = wave >> 2;
        __syncthreads();
        if (tid < 17) { const int stp = tid; int base, L; if (stp == 0) { base = 256 * b; L = 256; } else { const int k = dir ? 16 - stp : stp - 1; base = RL0 + 8192 * b + 512 * k; L = 512; }
            float wref = 0.f, A;
            if (ssd) { wref = dir ? RBA[(size_t)base * 16 + h] : CSF[(size_t)(base + L - 1) * 16 + h]; A = __expf(wref); } else A = __expf((float)L * lg);
            TB[stp] = wref; TB[32 + stp] = A; }
        __syncthreads();
        f32x4 acc[2] = {(f32x4){0.f, 0.f, 0.f, 0.f}, (f32x4){0.f, 0.f, 0.f, 0.f}};
        const int srow = tid >> 2, sc16 = tid & 3;
        const bf16* kp = Ksrc + 16 * sc16; const bf16* vp = Vsrc + 16 * sc16;
#define L0S_STP(si) ((si) < 2 ? 0 : 1 + (((si) - 2) >> 2))
#define L0S_LOAD(si, K0, K1, V0, V1, W) do { const int stp_ = L0S_STP(si), t0_ = (si) < 2 ? 128 * (si) : 128 * (((si) - 2) & 3); int r_, L_; \
            if (stp_ == 0) { r_ = 256 * b + t0_ + srow; L_ = 256; } else { const int kq_ = dir ? 16 - stp_ : stp_ - 1; r_ = RL0 + 8192 * b + 512 * kq_ + t0_ + srow; L_ = 512; } \
            const int jl_ = t0_ + srow; \
            if (ssd) W = dir ? __expf(TB[stp_] - RBA[(size_t)r_ * 16 + h]) * DTB[(size_t)r_ * 16 + h] : __expf(TB[stp_] - CSF[(size_t)r_ * 16 + h]) * DTF[(size_t)r_ * 16 + h]; \
            else W = dir ? __expf((float)jl_ * lg) : __expf((float)(L_ - 1 - jl_) * lg); \
            K0 = *(const v4u*)(kp + (size_t)r_ * ld); K1 = *(const v4u*)(kp + (size_t)r_ * ld + 8); V0 = *(const v4u*)(vp + (size_t)r_ * ld); V1 = *(const v4u*)(vp + (size_t)r_ * ld + 8); } while (0)
#define L0S_STORE(kidx) do { _Pragma("unroll") for (int t2 = 0; t2 < 2; ++t2) { const int e = 32 * we + 16 * t2 + (lane & 15), d = 16 * wd + 4 * (lane >> 4); \
            *(v2u*)(Sout + (size_t)(kidx) * kstride + (size_t)e * 128 + d) = pack4(acc[t2]); } } while (0)
#define L0S_STEP(si, K0, K1, V0, V1, W) do { const int stp_ = L0S_STP(si); \
            if ((si) == 0 || ((si) >= 2 && (((si) - 2) & 3) == 0)) { if (stp_ >= 1) L0S_STORE(dir ? 16 - stp_ : stp_ - 1); const float A_ = TB[32 + stp_]; acc[0] = acc[0] * A_; acc[1] = acc[1] * A_; } \
            __syncthreads(); \
            *(LAS v4u*)(Kt + srow * SCAN_PITCH + 32 * sc16) = scale8(K0, W); *(LAS v4u*)(Kt + srow * SCAN_PITCH + 32 * sc16 + 16) = scale8(K1, W); \
            *(LAS v4u*)(Vt + srow * SCAN_PITCH + 32 * sc16) = V0; *(LAS v4u*)(Vt + srow * SCAN_PITCH + 32 * sc16 + 16) = V1; \
            __syncthreads(); \
            if ((si) + 2 < 62) L0S_LOAD((si) + 2, K0, K1, V0, V1, W); \
            _Pragma("unroll") for (int kk = 0; kk < 4; ++kk) { const bf16x8 a = frag_tr(Kt, SCAN_PITCH, 32 * kk, 16 * wd, lane); \
                _Pragma("unroll") for (int t2 = 0; t2 < 2; ++t2) { const bf16x8 bb = frag_tr(Vt, SCAN_PITCH, 32 * kk, 32 * we + 16 * t2, lane); acc[t2] = MFMA16(a, bb, acc[t2]); } } } while (0)
        v4u ka0, ka1, va0, va1, kb0, kb1, vb0, vb1; float wa, wb;
        L0S_LOAD(0, ka0, ka1, va0, va1, wa); L0S_LOAD(1, kb0, kb1, vb0, vb1, wb);
#pragma unroll 1
        for (int si = 0; si < 62; si += 2) { L0S_STEP(si, ka0, ka1, va0, va1, wa); L0S_STEP(si + 1, kb0, kb1, vb0, vb1, wb); }
        L0S_STORE(dir ? 0 : 15);
#undef L0S_STP
#undef L0S_LOAD
#undef L0S_STORE
#undef L0S_STEP
    }
    __syncthreads();
}


constexpr int Y_KT = 0, Y_VT = 17408, Y_MT = 51200, Y_SC = 69632, Y_ST = 73728;
constexpr int P272 = 272, P528 = 528, P144 = 144;
__device__ __forceinline__ void phase_l0_y(const Args& args, unsigned char* ws, unsigned char* dob, LAS unsigned char* lds, int tid, int lane, int wave, int bx, int G, bool dry = false) {
    LAS unsigned char* Kt = lds + Y_KT; LAS unsigned char* Vt = lds + Y_VT; LAS unsigned char* Mt = lds + Y_MT; LAS float* SC = (LAS float*)(lds + Y_SC); LAS unsigned char* St = lds + Y_ST;
    bf16* ZG = (bf16*)(ws + WS_ZG); const bf16* XBC = (const bf16*)(ws + WS_XBC); const bf16* QK = (const bf16*)(ws + WS_QK); const bf16* VV = (const bf16*)(ws + WS_V);
    const float* DTF = (const float*)(ws + WS_DTF); const float* DTB = (const float*)(ws + WS_DTB); const float* CSF = (const float*)(ws + WS_CSF); const float* RBA = (const float*)(ws + WS_RB);
    const int fr = lane & 15, fq = lane >> 4;
    for (int u = bx; u < 1056; u += G) {
        const bool ssd = u < 528; const int idx = ssd ? u : u - 528; const int grp = idx & 3, br = idx >> 2, b = br / 66, rbk = br % 66;
        int cb0, L, i0, kchunk = -1;
        if (rbk < 2) { cb0 = 256 * b; L = 256; i0 = 128 * rbk; } else { const int lk = rbk - 2; kchunk = lk >> 2; cb0 = RL0 + 8192 * b + 512 * kchunk; L = 512; i0 = 128 * (lk & 3); }
        const int il = i0 + 16 * wave + fr;
        const int row = cb0 + il;
        const int nkb = L >> 6;
        if (ssd) {
            const int g = grp;
            bf16x8 cf[4];
#pragma unroll
            for (int kk = 0; kk < 4; ++kk) cf[kk] = *(const bf16x8*)(XBC + (size_t)row * 2048 + 1536 + 128 * g + 32 * kk + 8 * fq);
            float csi[4], rbi[4];
#pragma unroll
            for (int hh = 0; hh < 4; ++hh) { csi[hh] = CSF[(size_t)row * 16 + 4 * g + hh]; rbi[hh] = RBA[(size_t)row * 16 + 4 * g + hh]; }
            f32x4 acc[4][4];
#pragma unroll
            for (int hh = 0; hh < 4; ++hh)
#pragma unroll
                for (int pt = 0; pt < 4; ++pt) acc[hh][pt] = (f32x4){0.f, 0.f, 0.f, 0.f};
            const int Rw = (i0 >> 4) + wave;
            v4u pk[2], pv[4];
#define SSD_LOAD(kbv) do { const int krow0_ = cb0 + 64 * (kbv); \
                _Pragma("unroll") for (int c = 0; c < 2; ++c) { const int ch = tid + 512 * c, r = ch >> 4, cc = ch & 15; pk[c] = *(const v4u*)(XBC + (size_t)(krow0_ + r) * 2048 + 1024 + 128 * g + 8 * cc); } \
                _Pragma("unroll") for (int c = 0; c < 4; ++c) { const int ch = tid + 512 * c, r = ch >> 5, cc = ch & 31; pv[c] = *(const v4u*)(XBC + (size_t)(krow0_ + r) * 2048 + 256 * g + 8 * cc); } \
                } while (0)
            SSD_LOAD(0);
            for (int kb = 0; kb < nkb; ++kb) {
                __syncthreads();
#pragma unroll
                for (int c = 0; c < 2; ++c) { const int ch = tid + 512 * c, r = ch >> 4, cc = ch & 15; *(LAS v4u*)(Kt + r * P272 + 16 * cc) = pk[c]; }
#pragma unroll
                for (int c = 0; c < 4; ++c) { const int ch = tid + 512 * c, r = ch >> 5, cc = ch & 31; *(LAS v4u*)(Vt + r * P528 + 16 * cc) = pv[c]; }
                if (tid < 256) { const int r = tid >> 2, hh = tid & 3; const size_t o = (size_t)(cb0 + 64 * kb + r) * 16 + 4 * g + hh; SC[0 * 256 + r * 4 + hh] = CSF[o]; SC[1 * 256 + r * 4 + hh] = RBA[o]; SC[2 * 256 + r * 4 + hh] = DTF[o]; SC[3 * 256 + r * 4 + hh] = DTB[o]; }
                __syncthreads();
                if (kb + 1 < nkb) SSD_LOAD(kb + 1);
                f32x4 Gt[4];
#pragma unroll
                for (int t = 0; t < 4; ++t) { Gt[t] = (f32x4){0.f, 0.f, 0.f, 0.f};
#pragma unroll
                    for (int kk = 0; kk < 4; ++kk) Gt[t] = MFMA16(frag_nat(Kt, P272, 16 * t, 32 * kk, lane), cf[kk], Gt[t]); }
#pragma unroll
                for (int hh = 0; hh < 4; ++hh) {
#pragma unroll
                    for (int t = 0; t < 4; ++t) { f32x4 m; const int T = 4 * kb + t;
                        if (T < Rw) {
#pragma unroll
                            for (int r = 0; r < 4; ++r) { const int jk = 16 * t + 4 * fq + r; m[r] = Gt[t][r] * __expf(csi[hh] - SC[0 * 256 + jk * 4 + hh]) * SC[2 * 256 + jk * 4 + hh]; } }
                        else if (T > Rw) {
#pragma unroll
                            for (int r = 0; r < 4; ++r) { const int jk = 16 * t + 4 * fq + r; m[r] = Gt[t][r] * __expf(rbi[hh] - SC[1 * 256 + jk * 4 + hh]) * SC[3 * 256 + jk * 4 + hh]; } }
                        else {
#pragma unroll
                            for (int r = 0; r < 4; ++r) { const int jk = 16 * t + 4 * fq + r, jj = 4 * fq + r;
                                const float csj = SC[0 * 256 + jk * 4 + hh], rbj = SC[1 * 256 + jk * 4 + hh], dtfj = SC[2 * 256 + jk * 4 + hh], dtbj = SC[3 * 256 + jk * 4 + hh];
                                const float x = jj < fr ? csi[hh] - csj : (jj > fr ? rbi[hh] - rbj : 0.f);
                                const float sv = jj < fr ? dtfj : (jj > fr ? dtbj : dtfj + dtbj);
                                m[r] = Gt[t][r] * __expf(x) * sv; } }
                        *(LAS v2u*)(Mt + (16 * wave + fr) * P144 + (16 * t + 4 * fq) * 2) = pack4(m); }
                    LDS_WAIT();
#pragma unroll
                    for (int kk2 = 0; kk2 < 2; ++kk2) { const bf16x8 mb = frag_nat(Mt, P144, 16 * wave, 32 * kk2, lane);
#pragma unroll
                        for (int pt = 0; pt < 4; ++pt) acc[hh][pt] = MFMA16(frag_tr(Vt, P528, 32 * kk2, 64 * hh + 16 * pt, lane), mb, acc[hh][pt]); }
                }
            }
#undef SSD_LOAD
            if (kchunk >= 0) {
#pragma unroll 1
                for (int hh = 0; hh < 4; ++hh) {
                    const int h = 4 * g + hh;
                    __syncthreads();
#pragma unroll
                    for (int dir = 0; dir < 2; ++dir) { const bf16* S = (const bf16*)(dob + DO_ST_SSD) + ((size_t)(b * 32 + dir * 16 + h) * 16 + kchunk) * 8192;
#pragma unroll
                        for (int c = 0; c < 2; ++c) { const int ch = tid + 512 * c, r = ch >> 4, cc = ch & 15; *(LAS v4u*)(St + dir * 17408 + r * P272 + 16 * cc) = *(const v4u*)(S + r * 128 + 8 * cc); } }
                    __syncthreads();
                    float Ei[2] = {__expf(csi[0]), __expf(rbi[0])};
                    if (hh == 1) { Ei[0] = __expf(csi[1]); Ei[1] = __expf(rbi[1]); } else if (hh == 2) { Ei[0] = __expf(csi[2]); Ei[1] = __expf(rbi[2]); } else if (hh == 3) { Ei[0] = __expf(csi[3]); Ei[1] = __expf(rbi[3]); }
#pragma unroll
                    for (int dir = 0; dir < 2; ++dir)
#pragma unroll
                        for (int pt = 0; pt < 4; ++pt) { f32x4 T = (f32x4){0.f, 0.f, 0.f, 0.f};
#pragma unroll
                            for (int kk = 0; kk < 4; ++kk) T = MFMA16(frag_nat(St + dir * 17408, P272, 16 * pt, 32 * kk, lane), cf[kk], T);
                            const f32x4 add = T * Ei[dir];
                            if (hh == 0) acc[0][pt] += add; else if (hh == 1) acc[1][pt] += add; else if (hh == 2) acc[2][pt] += add; else acc[3][pt] += add; }
                }
            }
            float ssq = 0.f;
#pragma unroll
            for (int hh = 0; hh < 4; ++hh) { const float dsk = args.in[I_SSDD][4 * g + hh];
#pragma unroll
                for (int pt = 0; pt < 4; ++pt) { const int ch = 256 * g + 64 * hh + 16 * pt + 4 * fq;
                    const f32x4 xs = unpack4(*(const v2u*)(XBC + (size_t)row * 2048 + ch)), zz = unpack4(*(const v2u*)(ZG + (size_t)row * 2048 + ch));
                    f32x4 y = acc[hh][pt] + xs * dsk;
                    y.x *= silu_f(zz.x); y.y *= silu_f(zz.y); y.z *= silu_f(zz.z); y.w *= silu_f(zz.w);
                    acc[hh][pt] = y; ssq += (y.x * y.x + y.y * y.y) + (y.z * y.z + y.w * y.w); } }
            ssq += __shfl_xor(ssq, 16); ssq += __shfl_xor(ssq, 32);
            const float rstd = 1.0f / sqrtf(ssq * (1.f / 256.f) + RMS_EPS);
#pragma unroll
            for (int hh = 0; hh < 4; ++hh)
#pragma unroll
                for (int pt = 0; pt < 4; ++pt) { const int ch = 256 * g + 64 * hh + 16 * pt + 4 * fq; const f32x4 nw = *(const f32x4*)(args.in[I_SSDNW] + ch);
                    if (!dry) *(v2u*)(ZG + (size_t)row * 2048 + ch) = pack4(acc[hh][pt] * rstd * nw); }
        } else {
            const int h = grp;
            const float lgf = logsig_f(args.in[I_RLF][h]), lgb = logsig_f(args.in[I_RLB][h]);
            bf16x8 qf[4];
#pragma unroll
            for (int kk = 0; kk < 4; ++kk) qf[kk] = *(const bf16x8*)(QK + (size_t)row * 1024 + 128 * h + 32 * kk + 8 * fq);
            f32x4 acc[16];
#pragma unroll
            for (int et = 0; et < 16; ++et) acc[et] = (f32x4){0.f, 0.f, 0.f, 0.f};
            const int Rw = (i0 >> 4) + wave;
            v4u pk[2], pv[4];
#define RET_LOAD(kbv) do { const int krow0_ = cb0 + 64 * (kbv); \
                _Pragma("unroll") for (int c = 0; c < 2; ++c) { const int ch = tid + 512 * c, r = ch >> 4, cc = ch & 15; pk[c] = *(const v4u*)(QK + (size_t)(krow0_ + r) * 1024 + 512 + 128 * h + 8 * cc); } \
                _Pragma("unroll") for (int c = 0; c < 4; ++c) { const int ch = tid + 512 * c, r = ch >> 5, cc = ch & 31; pv[c] = *(const v4u*)(VV + (size_t)(krow0_ + r) * 1024 + 256 * h + 8 * cc); } } while (0)
            RET_LOAD(0);
            for (int kb = 0; kb < nkb; ++kb) {
                __syncthreads();
#pragma unroll
                for (int c = 0; c < 2; ++c) { const int ch = tid + 512 * c, r = ch >> 4, cc = ch & 15; *(LAS v4u*)(Kt + r * P272 + 16 * cc) = pk[c]; }
#pragma unroll
                for (int c = 0; c < 4; ++c) { const int ch = tid + 512 * c, r = ch >> 5, cc = ch & 31; *(LAS v4u*)(Vt + r * P528 + 16 * cc) = pv[c]; }
                __syncthreads();
                if (kb + 1 < nkb) RET_LOAD(kb + 1);
#pragma unroll
                for (int t = 0; t < 4; ++t) { f32x4 Gt = (f32x4){0.f, 0.f, 0.f, 0.f};
#pragma unroll
                    for (int kk = 0; kk < 4; ++kk) Gt = MFMA16(frag_nat(Kt, P272, 16 * t, 32 * kk, lane), qf[kk], Gt);
                    f32x4 m; const int T = 4 * kb + t;
#pragma unroll
                    for (int r = 0; r < 4; ++r) { const int j = 64 * kb + 16 * t + 4 * fq + r;
                        float f;
                        if (T < Rw) f = __expf((float)(il - j) * lgf); else if (T > Rw) f = __expf((float)(j - il) * lgb);
                        else f = j < il ? __expf((float)(il - j) * lgf) : (j > il ? __expf((float)(j - il) * lgb) : 2.0f);
                        m[r] = Gt[r] * f; }
                    *(LAS v2u*)(Mt + (16 * wave + fr) * P144 + (16 * t + 4 * fq) * 2) = pack4(m); }
                LDS_WAIT();
#pragma unroll
                for (int kk2 = 0; kk2 < 2; ++kk2) { const bf16x8 mb = frag_nat(Mt, P144, 16 * wave, 32 * kk2, lane);
#pragma unroll
                    for (int et = 0; et < 16; ++et) acc[et] = MFMA16(frag_tr(Vt, P528, 32 * kk2, 16 * et, lane), mb, acc[et]); }
            }
#undef RET_LOAD
            if (kchunk >= 0) {
#pragma unroll 1
                for (int dir = 0; dir < 2; ++dir) {
                    const bf16* S = (const bf16*)(dob + DO_ST_RET) + (size_t)__builtin_amdgcn_readfirstlane(((b * 8 + dir * 4 + h) * 16 + kchunk)) * 32768;
                    __syncthreads();
#pragma unroll
                    for (int c = 0; c < 8; ++c) { const int ch = tid + 512 * c, r = ch >> 4, cc = ch & 15; *(LAS v4u*)(St + r * P272 + 16 * cc) = *(const v4u*)(S + r * 128 + 8 * cc); }
                    __syncthreads();
                    const float Ei = dir ? __expf((float)(L - il) * lgb) : __expf((float)(il + 1) * lgf);
#pragma unroll
                    for (int et = 0; et < 16; ++et) { f32x4 T = (f32x4){0.f, 0.f, 0.f, 0.f};
#pragma unroll
                        for (int kk = 0; kk < 4; ++kk) T = MFMA16(frag_nat(St, P272, 16 * et, 32 * kk, lane), qf[kk], T);
                        acc[et] += T * Ei; }
                }
            }
            float sm = 0.f;
#pragma unroll
            for (int et = 0; et < 16; ++et) sm += (acc[et].x + acc[et].y) + (acc[et].z + acc[et].w);
            sm += __shfl_xor(sm, 16); sm += __shfl_xor(sm, 32);
            const float mean = sm * (1.f / 256.f); float sq = 0.f;
#pragma unroll
            for (int et = 0; et < 16; ++et) { acc[et] = acc[et] - mean; sq += (acc[et].x * acc[et].x + acc[et].y * acc[et].y) + (acc[et].z * acc[et].z + acc[et].w * acc[et].w); }
            sq += __shfl_xor(sq, 16); sq += __shfl_xor(sq, 32);
            const float rstd = 1.0f / sqrtf(sq * (1.f / 256.f) + LN_EPS);
#pragma unroll
            for (int et = 0; et < 16; ++et) { const int ch = 1024 + 256 * h + 16 * et + 4 * fq; const f32x4 gg = unpack4(*(const v2u*)(ZG + (size_t)row * 2048 + ch));
                f32x4 y = acc[et] * rstd; y.x *= silu_f(gg.x); y.y *= silu_f(gg.y); y.z *= silu_f(gg.z); y.w *= silu_f(gg.w);
                if (!dry) *(v2u*)(ZG + (size_t)row * 2048 + ch) = pack4(y); }
        }
        __syncthreads();
    }
}


constexpr size_t WS_GWT = 7 * MiB;
constexpr size_t WS_MIN = 7 * MiB + 256 * 1024;
__device__ __forceinline__ int xc_row(int r, int b) { return r < RL0 ? r - 256 * b : 256 + (r - RL0 - 8192 * b); }
__device__ __forceinline__ void bw8(const float (&x)[8], const float* w  , float (&o)[8]) {
#pragma unroll
    for (int bl = 0; bl < 2; ++bl)
#pragma unroll
        for (int e = 0; e < 4; ++e) o[4 * bl + e] = x[4 * bl] * w[16 * bl + e] + x[4 * bl + 1] * w[16 * bl + 4 + e] + x[4 * bl + 2] * w[16 * bl + 8 + e] + x[4 * bl + 3] * w[16 * bl + 12 + e];
}
__device__ __forceinline__ void unpack8(v4u v, float (&o)[8]) { o[0] = bflo(v.x); o[1] = bfhi(v.x); o[2] = bflo(v.y); o[3] = bfhi(v.y); o[4] = bflo(v.z); o[5] = bfhi(v.z); o[6] = bflo(v.w); o[7] = bfhi(v.w); }
__device__ __forceinline__ v4u pack8(const float (&o)[8]) { v4u r; r.x = pk2(o[0], o[1]); r.y = pk2(o[2], o[3]); r.z = pk2(o[4], o[5]); r.w = pk2(o[6], o[7]); return r; }

constexpr size_t WS_GVT = WS_GWT + 65536;
__device__ __forceinline__ void phase_l1_prep(const Args& args, unsigned char* ws, LAS unsigned char* lds, int tid, int lane, int wave, int bx, int G, int b) {
    const bf16* XM = (const bf16*)(ws + WS_XM); bf16* XC = (bf16*)(ws + WS_XC); const bf16* GXT = (const bf16*)(ws + WS_GWT); const bf16* GVT = (const bf16*)(ws + WS_GVT); float* GATE = (float*)(ws + WS_GATE);
    const float* cwp = args.in[I_MLCW]; const float* cbp = args.in[I_MLCB];
    LAS float* GL = (LAS float*)lds;
    const int st = wave >> 2, kq = wave & 3, fr = lane & 15, fq = lane >> 4;
    for (int u = bx; u < 264; u += G) {
        const int tb = u < 8 ? 256 * b + 32 * u : RL0 + 8192 * b + 32 * (u - 8);
        const int slo = u < 8 ? 256 * b : RL0 + 8192 * b, shi = u < 8 ? slo + 256 : slo + 8192;
        const int r = tb + 16 * st + fr, xr = xc_row(r, b);
        f32x4 gacc = (f32x4){0.f, 0.f, 0.f, 0.f};
#pragma unroll 2
        for (int c32 = 0; c32 < 16; ++c32) {
            const int cb = 512 * kq + 32 * c32 + 8 * fq;
            v4u xw[5];
#pragma unroll
            for (int k = 0; k < 5; ++k) { const int rr = r + k - 2; xw[k] = (v4u){0u, 0u, 0u, 0u}; if (rr >= slo && rr < shi) xw[k] = *(const v4u*)(XM + (size_t)rr * 2048 + cb); }
            const bf16x8 gx = *(const bf16x8*)(GXT + (size_t)fr * 2048 + cb), gv = *(const bf16x8*)(GVT + (size_t)fr * 2048 + cb);
            f32x4 a0 = *(const f32x4*)(cbp + cb), a1 = *(const f32x4*)(cbp + cb + 4);
#pragma unroll
            for (int k = 0; k < 5; ++k) { const f32x4 w0 = *(const f32x4*)(cwp + k * 2048 + cb), w1 = *(const f32x4*)(cwp + k * 2048 + cb + 4); const v4u v = xw[k];
                a0.x += w0.x * bflo(v.x); a0.y += w0.y * bfhi(v.x); a0.z += w0.z * bflo(v.y); a0.w += w0.w * bfhi(v.y);
                a1.x += w1.x * bflo(v.z); a1.y += w1.y * bfhi(v.z); a1.z += w1.z * bflo(v.w); a1.w += w1.w * bfhi(v.w); }
            v4u xcp; xcp.x = pk2(silu_f(a0.x), silu_f(a0.y)); xcp.y = pk2(silu_f(a0.z), silu_f(a0.w)); xcp.z = pk2(silu_f(a1.x), silu_f(a1.y)); xcp.w = pk2(silu_f(a1.z), silu_f(a1.w));
            *(v4u*)(XC + (size_t)xr * 2048 + cb) = xcp;
            gacc = MFMA16(gx, __builtin_bit_cast(bf16x8, xcp), gacc); gacc = MFMA16(gv, __builtin_bit_cast(bf16x8, xw[2]), gacc);
        }
        __syncthreads();
#pragma unroll
        for (int rr = 0; rr < 4; ++rr) GL[((st * 4 + kq) * 16 + 4 * fq + rr) * 16 + fr] = gacc[rr];
        __syncthreads();
        { const int s2 = tid >> 8, gt = (tid >> 4) & 15, tk = tid & 15;
            float s = args.in[I_MLGB][gt];
#pragma unroll
            for (int q = 0; q < 4; ++q) s += GL[((s2 * 4 + q) * 16 + gt) * 16 + tk];
            GATE[(size_t)(tb + 16 * s2 + tk) * 16 + gt] = s; }
        __syncthreads();
    }
}

__device__ __forceinline__ void phase_l1_gatescan(const Args& args, unsigned char* ws, LAS unsigned char* lds, int tid, int lane, int wave, int bx, int G, int gw, int NGW, int b) {
    const float* GATE = (const float*)(ws + WS_GATE); float* BC = (float*)(ws + WS_BC); float* AJ = (float*)(ws + WS_AJ); float* CM = (float*)(ws + WS_CM); float* CH = (float*)(ws + WS_CH);
    for (int wu = gw; wu < 8 * 17; wu += NGW) {
        const int sl = wu / 17, c17 = wu % 17, dir = sl >> 2, h = sl & 3;
        const int base = c17 == 0 ? 256 * b : RL0 + 8192 * b + 512 * (c17 - 1), L = c17 == 0 ? 256 : 512, per = L >> 6, t0 = lane * per;
        float fc[8], ic[8]; float s = 0.f;
#pragma unroll
        for (int t = 0; t < 8; ++t) if (t < per) { const size_t o = (size_t)(base + t0 + t) * 16; fc[t] = logsig_f(GATE[o + (dir ? 12 : 4) + h]); ic[t] = GATE[o + (dir ? 8 : 0) + h]; s += fc[t]; }
        float p = s;
#pragma unroll
        for (int o = 1; o < 64; o <<= 1) { const float up = __shfl_up(p, o), dn = __shfl_down(p, o); if (!dir) { if (lane >= o) p += up; } else { if (lane + o < 64) p += dn; } }
        const float total = dir ? __shfl(p, 0) : __shfl(p, 63);
        float run = p - s, a[8], bcv[8]; float mx = -3.0e38f;
        if (!dir) {
#pragma unroll
            for (int t = 0; t < 8; ++t) if (t < per) { run += fc[t]; bcv[t] = run; a[t] = ic[t] - run; mx = fmaxf(mx, a[t]); }
        } else {
#pragma unroll
            for (int t = 7; t >= 0; --t) if (t < per) { run += fc[t]; bcv[t] = run; a[t] = ic[t] - run; mx = fmaxf(mx, a[t]); }
        }
        float pm = mx;
#pragma unroll
        for (int o = 1; o < 64; o <<= 1) { const float up = __shfl_up(pm, o), dn = __shfl_down(pm, o); if (!dir) { if (lane >= o) pm = fmaxf(pm, up); } else { if (lane + o < 64) pm = fmaxf(pm, dn); } }
        const float cmax = dir ? __shfl(pm, 0) : __shfl(pm, 63);
        float excl = !dir ? __shfl_up(pm, 1) : __shfl_down(pm, 1);
        if ((!dir && lane == 0) || (dir && lane == 63)) excl = -3.0e38f;
        float rm = excl;
        if (!dir) {
#pragma unroll
            for (int t = 0; t < 8; ++t) if (t < per) { rm = fmaxf(rm, a[t]); const size_t o = (size_t)(base + t0 + t) * 8 + sl; BC[o] = bcv[t]; AJ[o] = a[t]; CM[o] = rm; }
        } else {
#pragma unroll
            for (int t = 7; t >= 0; --t) if (t < per) { rm = fmaxf(rm, a[t]); const size_t o = (size_t)(base + t0 + t) * 8 + sl; BC[o] = bcv[t]; AJ[o] = a[t]; CM[o] = rm; }
        }
        if (lane == 0) { CH[((b * 8 + sl) * 17 + c17) * 2] = total; CH[((b * 8 + sl) * 17 + c17) * 2 + 1] = cmax; }
    }
}

__device__ __forceinline__ void m_chain(const float* CH, int b, int sl, LAS float* m_in, LAS float* mul) {
    const int dir = sl >> 2; float m = 0.f;
    for (int step = 0; step < 17; ++step) { const int c17 = step == 0 ? 0 : (dir ? 17 - step : step); const float be = CH[((b * 8 + sl) * 17 + c17) * 2], cx = CH[((b * 8 + sl) * 17 + c17) * 2 + 1];
        const float mu = fmaxf(m, cx); m_in[step] = m; mul[step] = mu; m = be + mu; }
}

__device__ __forceinline__ void phase_l1_scan(const Args& args, unsigned char* ws, LAS unsigned char* lds, int tid, int lane, int wave, int bx, int G, int b) {
    const bf16* XM = (const bf16*)(ws + WS_XM); const bf16* XC = (const bf16*)(ws + WS_XC); const float* AJ = (const float*)(ws + WS_AJ); const float* CH = (const float*)(ws + WS_CH);
    bf16* ST = (bf16*)(ws + WS_ST1); float* NV = (float*)(ws + WS_NV);
    LAS unsigned char* Kt = lds; LAS unsigned char* Vt = lds + 128 * P144; LAS float* MS = (LAS float*)(lds + 128 * P144 + 128 * P272);
    const int fr = lane & 15, fq = lane >> 4, wd = wave & 3, we = wave >> 2;
    const bf16x8 ones = (bf16x8){(short)0x3F80, (short)0x3F80, (short)0x3F80, (short)0x3F80, (short)0x3F80, (short)0x3F80, (short)0x3F80, (short)0x3F80};
    for (int u = bx; u < 256; u += G) {
        const int sl = u >> 5, t = u & 31, et = t >> 3, dt = t & 7, dir = sl >> 2, h = sl & 3;
        __syncthreads();
        if (tid == 0) m_chain(CH, b, sl, MS, MS + 32);
        __syncthreads();
        if (t == 0 && tid < 17) ((float*)(ws + WS_MIN))[(b * 8 + sl) * 17 + tid] = MS[tid];
        f32x4 acc[4]; f32x4 nacc = (f32x4){0.f, 0.f, 0.f, 0.f};
#pragma unroll
        for (int i = 0; i < 4; ++i) acc[i] = (f32x4){0.f, 0.f, 0.f, 0.f};
        const int srow = tid >> 2, q4 = tid & 3;
        const bf16* xcb = XC + 512 * h + 64 * dt + 16 * q4; const bf16* xmb = XM + 512 * h + 128 * et + 32 * q4;
#define L1S_STP(si) ((si) < 2 ? 0 : 1 + (((si) - 2) >> 2))
#define L1S_LOAD(si, K0, K1, VV, W) do { const int stp_ = L1S_STP(si), t0_ = (si) < 2 ? 128 * (si) : 128 * (((si) - 2) & 3); int r_, xr_; \
            if (stp_ == 0) { r_ = 256 * b + t0_ + srow; xr_ = t0_ + srow; } else { const int kq_ = dir ? 16 - stp_ : stp_ - 1; r_ = RL0 + 8192 * b + 512 * kq_ + t0_ + srow; xr_ = 256 + 512 * kq_ + t0_ + srow; } \
            W = __expf(AJ[(size_t)r_ * 8 + sl] - MS[32 + stp_]); K0 = *(const v4u*)(xcb + (size_t)xr_ * 2048); K1 = *(const v4u*)(xcb + (size_t)xr_ * 2048 + 8); \
            _Pragma("unroll") for (int c = 0; c < 4; ++c) VV[c] = *(const v4u*)(xmb + (size_t)r_ * 2048 + 8 * c); } while (0)
#define L1S_STORE(kidx) do { bf16* So = ST + ((size_t)(sl * 16 + (kidx)) * 512) * 512; \
            _Pragma("unroll") for (int t4 = 0; t4 < 4; ++t4) { const int e = 128 * et + 64 * we + 16 * t4 + fr, d = 64 * dt + 16 * wd + 4 * fq; *(v2u*)(So + (size_t)e * 512 + d) = pack4(acc[t4]); } \
            if (et == 0 && we == 0 && fr == 0) *(f32x4*)(NV + (size_t)(sl * 16 + (kidx)) * 512 + 64 * dt + 16 * wd + 4 * fq) = nacc; } while (0)
#define L1S_STEP(si, K0, K1, VV, W) do { const int stp_ = L1S_STP(si); \
            if ((si) == 0 || ((si) >= 2 && (((si) - 2) & 3) == 0)) { if (stp_ >= 1) L1S_STORE(dir ? 16 - stp_ : stp_ - 1); const float wc_ = __expf(MS[stp_] - MS[32 + stp_]); \
                _Pragma("unroll") for (int i = 0; i < 4; ++i) acc[i] = acc[i] * wc_; nacc = nacc * wc_; } \
            __syncthreads(); \
            *(LAS v4u*)(Kt + srow * P144 + 32 * q4) = scale8(K0, W); *(LAS v4u*)(Kt + srow * P144 + 32 * q4 + 16) = scale8(K1, W); \
            _Pragma("unroll") for (int c = 0; c < 4; ++c) *(LAS v4u*)(Vt + srow * P272 + 64 * q4 + 16 * c) = VV[c]; \
            __syncthreads(); \
            if ((si) + 2 < 62) L1S_LOAD((si) + 2, K0, K1, VV, W); \
            _Pragma("unroll") for (int kk = 0; kk < 4; ++kk) { const bf16x8 a = frag_tr(Kt, P144, 32 * kk, 16 * wd, lane); \
                _Pragma("unroll") for (int t4 = 0; t4 < 4; ++t4) acc[t4] = MFMA16(a, frag_tr(Vt, P272, 32 * kk, 64 * we + 16 * t4, lane), acc[t4]); \
                nacc = MFMA16(a, ones, nacc); } } while (0)
        v4u ka0, ka1, va[4], kb0, kb1, vb[4]; float wa, wb;
        L1S_LOAD(0, ka0, ka1, va, wa); L1S_LOAD(1, kb0, kb1, vb, wb);
#pragma unroll 1
        for (int si = 0; si < 62; si += 2) { L1S_STEP(si, ka0, ka1, va, wa); L1S_STEP(si + 1, kb0, kb1, vb, wb); }
        L1S_STORE(dir ? 0 : 15);
#undef L1S_STP
#undef L1S_LOAD
#undef L1S_STORE
#undef L1S_STEP
    }
    __syncthreads();
}


constexpr int P1040 = 1040;
constexpr int LY_AJ = 139264;
constexpr int LY_MT = 66560;
__device__ __forceinline__ void qprime8(const bf16* xcrow, const float* WQK, int cb, float (&o)[8]) {
    float x[8]; unpack8(*(const v4u*)(xcrow + cb), x);
    bw8(x, WQK + (cb >> 2) * 16, o);
}
__device__ __forceinline__ void phase_l1_y(const Args& args, unsigned char* ws, LAS unsigned char* lds, int tid0, int lane0, int wave, int bx, int G, int b, bool dry = false) {
    const bf16* XM = (const bf16*)(ws + WS_XM); const bf16* XC = (const bf16*)(ws + WS_XC); bf16* Z = (bf16*)(ws + WS_Z);
    const float* AJ = (const float*)(ws + WS_AJ); const float* BC = (const float*)(ws + WS_BC); const float* CM = (const float*)(ws + WS_CM); const float* CH = (const float*)(ws + WS_CH);
    const bf16* ST = (const bf16*)(ws + WS_ST1); const float* NV = (const float*)(ws + WS_NV); const float* WQK = (const float*)(ws + WS_WQK);
    LAS float* AJL = (LAS float*)(lds + LY_AJ);
    LAS unsigned char* Mf = lds;
    LAS unsigned char* Tt = lds + 66560;
    const int wr = wave >> 1, we = wave & 1;
    for (int u = bx; u < 512; u += G) {
        int tid = tid0, lane = lane0; asm volatile("" : "+v"(tid), "+v"(lane));
        const int fr = lane & 15, fq = lane >> 4;
        const int h = u >> 7, k = (u >> 3) & 15, rb = u & 7;
        const int base = RL0 + 8192 * b + 512 * k, xb = 256 + 512 * k, i0 = 64 * rb;
        const int il = i0 + 16 * wr + fr, row = base + il; const bf16* xcrow = XC + (size_t)(xb + il) * 2048;
        const int Rw = 4 * rb + wr;
        __syncthreads();
        const float m_in_f = ((const float*)(ws + WS_MIN))[(b * 8 + h) * 17 + k + 1], m_in_b = ((const float*)(ws + WS_MIN))[(b * 8 + 4 + h) * 17 + 16 - k];
        const float mu_f = fmaxf(m_in_f, CM[(size_t)row * 8 + h]), mu_b = fmaxf(m_in_b, CM[(size_t)row * 8 + 4 + h]);
        const float bc_f = BC[(size_t)row * 8 + h], bc_b = BC[(size_t)row * 8 + 4 + h];
        for (int i = tid; i < 1024; i += 512) { const int d = i >> 9, j = i & 511; AJL[i] = AJ[(size_t)(base + j) * 8 + 4 * d + h]; }
        f32x4 Gt[4][4];
#pragma unroll
        for (int kb = 0; kb < 4; ++kb)
#pragma unroll
            for (int t = 0; t < 4; ++t) Gt[kb][t] = (f32x4){0.f, 0.f, 0.f, 0.f};
        float qn_f = 0.f, qn_b = 0.f;
        const float* nf = NV + (size_t)(h * 16 + k) * 512; const float* nb = NV + (size_t)((4 + h) * 16 + k) * 512;
        v4u pa[8]; int tA = tid; asm volatile("" : "+v"(tA));
#pragma unroll
        for (int c = 0; c < 8; ++c) { const int ch = tA + 512 * c, r = ch >> 3, cc = ch & 7; pa[c] = *(const v4u*)(XC + (size_t)(xb + r) * 2048 + 512 * h + 8 * cc); }
#pragma unroll 1
        for (int ds = 0; ds < 8; ++ds) {
            __syncthreads();
#pragma unroll
            for (int c = 0; c < 8; ++c) { const int ch = tA + 512 * c, r = ch >> 3, cc = ch & 7; *(LAS v4u*)(lds + r * P144 + 16 * cc) = pa[c]; }
            bf16x8 qf[2];
#pragma unroll
            for (int kk = 0; kk < 2; ++kk) { const int dl = 64 * ds + 32 * kk + 8 * fq; float q8[8]; qprime8(xcrow, WQK, 512 * h + dl, q8);
#pragma unroll
                for (int e = 0; e < 8; ++e) { qn_f += q8[e] * nf[dl + e]; qn_b += q8[e] * nb[dl + e]; }
                qf[kk] = __builtin_bit_cast(bf16x8, pack8(q8)); asm volatile("" ::: "memory"); }
            __syncthreads();
            if (ds < 7) {
                asm volatile("" : "+v"(tA));
#pragma unroll
                for (int c = 0; c < 8; ++c) { const int ch = tA + 512 * c, r = ch >> 3, cc = ch & 7; pa[c] = *(const v4u*)(XC + (size_t)(xb + r) * 2048 + 512 * h + 64 * (ds + 1) + 8 * cc); }
            }
#pragma unroll
            for (int kb = 0; kb < 4; ++kb) {
#pragma unroll
                for (int t = 0; t < 4; ++t) {
#pragma unroll
                    for (int kk = 0; kk < 2; ++kk) Gt[kb][t] = MFMA16(frag_nat(lds, P144, 64 * (4 * we + kb) + 16 * t, 32 * kk, lane), qf[kk], Gt[kb][t]);
                    asm volatile("" ::: "memory"); } }
        }
        qn_f += __shfl_xor(qn_f, 16); qn_f += __shfl_xor(qn_f, 32); qn_b += __shfl_xor(qn_b, 16); qn_b += __shfl_xor(qn_b, 32);
        float rsf = 0.f, rsb = 0.f;
#pragma unroll
        for (int kb = 0; kb < 4; ++kb)
#pragma unroll
            for (int t = 0; t < 4; ++t) { const int T = 4 * (4 * we + kb) + t, j0 = 16 * T + 4 * fq; const f32x4 g = Gt[kb][t];
                if (T < Rw) { rsf += g.x * __expf(AJL[j0] - mu_f) + g.y * __expf(AJL[j0 + 1] - mu_f) + g.z * __expf(AJL[j0 + 2] - mu_f) + g.w * __expf(AJL[j0 + 3] - mu_f); }
                else if (T > Rw) { rsb += g.x * __expf(AJL[512 + j0] - mu_b) + g.y * __expf(AJL[512 + j0 + 1] - mu_b) + g.z * __expf(AJL[512 + j0 + 2] - mu_b) + g.w * __expf(AJL[512 + j0 + 3] - mu_b); }
                else {
#pragma unroll
                    for (int r = 0; r < 4; ++r) { const int jj = 4 * fq + r; const float ef = __expf(AJL[j0 + r] - mu_f), eb = __expf(AJL[512 + j0 + r] - mu_b);
                        rsf += jj <= fr ? g[r] * ef : 0.f; rsb += jj >= fr ? g[r] * eb : 0.f; } }
                asm volatile("" ::: "memory"); }
        rsf += __shfl_xor(rsf, 16); rsf += __shfl_xor(rsf, 32); rsb += __shfl_xor(rsb, 16); rsb += __shfl_xor(rsb, 32);
        __syncthreads();
        { LAS float* RS = (LAS float*)lds; if (fq == 0) { RS[(wave * 16 + fr) * 2] = rsf; RS[(wave * 16 + fr) * 2 + 1] = rsb; }
          __syncthreads();
          rsf += RS[((wave ^ 1) * 16 + fr) * 2]; rsb += RS[((wave ^ 1) * 16 + fr) * 2 + 1]; }
        const float wp_f = __expf(m_in_f - mu_f), wp_b = __expf(m_in_b - mu_b);
        const float dn_f = fmaxf(fabsf(rsf + wp_f * qn_f), __expf(-bc_f - mu_f)), dn_b = fmaxf(fabsf(rsb + wp_b * qn_b), __expf(-bc_b - mu_b));
        const float inv_f = 1.0f / dn_f, inv_b = 1.0f / dn_b, s_f = wp_f * inv_f, s_b = wp_b * inv_b;
        __syncthreads();
#pragma unroll
        for (int kb = 0; kb < 4; ++kb)
#pragma unroll
            for (int t = 0; t < 4; ++t) { const int T = 4 * (4 * we + kb) + t, j0 = 16 * T + 4 * fq; const f32x4 g = Gt[kb][t]; f32x4 m;
                if (T < Rw) { m.x = g.x * __expf(AJL[j0] - mu_f) * inv_f; m.y = g.y * __expf(AJL[j0 + 1] - mu_f) * inv_f; m.z = g.z * __expf(AJL[j0 + 2] - mu_f) * inv_f; m.w = g.w * __expf(AJL[j0 + 3] - mu_f) * inv_f; }
                else if (T > Rw) { m.x = g.x * __expf(AJL[512 + j0] - mu_b) * inv_b; m.y = g.y * __expf(AJL[512 + j0 + 1] - mu_b) * inv_b; m.z = g.z * __expf(AJL[512 + j0 + 2] - mu_b) * inv_b; m.w = g.w * __expf(AJL[512 + j0 + 3] - mu_b) * inv_b; }
                else {
#pragma unroll
                    for (int r = 0; r < 4; ++r) { const int jj = 4 * fq + r; const float ef = __expf(AJL[j0 + r] - mu_f) * inv_f, eb = __expf(AJL[512 + j0 + r] - mu_b) * inv_b;
                        m[r] = g[r] * ((jj <= fr ? ef : 0.f) + (jj >= fr ? eb : 0.f)); } }
                *(LAS v2u*)(Mf + (16 * wr + fr) * P1040 + j0 * 2) = pack4(m); asm volatile("" ::: "memory"); }
        f32x4 acc[16];
#pragma unroll
        for (int et = 0; et < 16; ++et) acc[et] = (f32x4){0.f, 0.f, 0.f, 0.f};
        v4u pre[8]; int tB = tid; asm volatile("" : "+v"(tB));
#pragma unroll
        for (int c = 0; c < 8; ++c) { const int ch = tB + 512 * c, r = ch >> 6, cc = ch & 63; pre[c] = *(const v4u*)(XM + (size_t)(base + r) * 2048 + 512 * h + 8 * cc); }
#pragma unroll 1
        for (int kb = 0; kb < 8; ++kb) {
            __syncthreads();
#pragma unroll
            for (int c = 0; c < 8; ++c) { const int ch = tB + 512 * c, r = ch >> 6, cc = ch & 63; *(LAS v4u*)(Tt + r * P1040 + 16 * cc) = pre[c]; }
            __syncthreads();
            if (kb < 7) {
                asm volatile("" : "+v"(tB));
#pragma unroll
                for (int c = 0; c < 8; ++c) { const int ch = tB + 512 * c, r = ch >> 6, cc = ch & 63; pre[c] = *(const v4u*)(XM + (size_t)(base + 64 * (kb + 1) + r) * 2048 + 512 * h + 8 * cc); }
            }
#pragma unroll
            for (int kk2 = 0; kk2 < 2; ++kk2) { const bf16x8 mb = frag_nat(Mf, P1040, 16 * wr, 64 * kb + 32 * kk2, lane);
#pragma unroll
                for (int et = 0; et < 16; ++et) { acc[et] = MFMA16(frag_tr(Tt, P1040, 32 * kk2, 256 * we + 16 * et, lane), mb, acc[et]); if ((et & 3) == 3) asm volatile("" ::: "memory"); } }
        }
        int tC = tid; asm volatile("" : "+v"(tC));
        { const bf16* S = ST + ((size_t)(h * 16 + k) * 512) * 512;
#pragma unroll
          for (int c = 0; c < 8; ++c) { const int ch = tC + 512 * c, r = ch >> 3, cc = ch & 7; pre[c] = *(const v4u*)(S + (size_t)r * 512 + 8 * cc); } }
#pragma unroll 1
        for (int it = 0; it < 16; ++it) {
            const int dir = it >> 3, dsl = it & 7; const float sc = dir ? s_b : s_f;
            __syncthreads();
#pragma unroll
            for (int c = 0; c < 8; ++c) { const int ch = tC + 512 * c, r = ch >> 3, cc = ch & 7; *(LAS v4u*)(Tt + r * P144 + 16 * cc) = pre[c]; }
            bf16x8 qs[2];
#pragma unroll
            for (int kk = 0; kk < 2; ++kk) { float q8[8]; qprime8(xcrow, WQK, 512 * h + 64 * dsl + 32 * kk + 8 * fq, q8);
#pragma unroll
                for (int e = 0; e < 8; ++e) q8[e] *= sc;
                qs[kk] = __builtin_bit_cast(bf16x8, pack8(q8)); }
            __syncthreads();
            if (it < 15) { asm volatile("" : "+v"(tC)); const int nd = (it + 1) >> 3, ns = (it + 1) & 7; const bf16* S = ST + ((size_t)((nd * 4 + h) * 16 + k) * 512) * 512 + 64 * ns;
#pragma unroll
                for (int c = 0; c < 8; ++c) { const int ch = tC + 512 * c, r = ch >> 3, cc = ch & 7; pre[c] = *(const v4u*)(S + (size_t)r * 512 + 8 * cc); } }
#pragma unroll
            for (int kk = 0; kk < 2; ++kk)
#pragma unroll
                for (int et = 0; et < 16; ++et) { acc[et] = MFMA16(frag_nat(Tt, P144, 256 * we + 16 * et, 32 * kk, lane), qs[kk], acc[et]); if ((et & 3) == 3) asm volatile("" ::: "memory"); }
        }
        float sm = 0.f;
#pragma unroll
        for (int et = 0; et < 16; ++et) { const float* w = args.in[I_MLWV] + (size_t)(128 * h + 64 * we + 4 * et + fq) * 16; const f32x4 a = acc[et]; f32x4 o;
            o.x = a.x * w[0] + a.y * w[4] + a.z * w[8] + a.w * w[12]; o.y = a.x * w[1] + a.y * w[5] + a.z * w[9] + a.w * w[13];
            o.z = a.x * w[2] + a.y * w[6] + a.z * w[10] + a.w * w[14]; o.w = a.x * w[3] + a.y * w[7] + a.z * w[11] + a.w * w[15];
            acc[et] = o; sm += (o.x + o.y) + (o.z + o.w); asm volatile("" ::: "memory"); }
        sm += __shfl_xor(sm, 16); sm += __shfl_xor(sm, 32);
        LAS float* XS = AJL;
        __syncthreads();
        if (fq == 0) XS[wave * 16 + fr] = sm;
        __syncthreads();
        const float mean = (sm + XS[(wave ^ 1) * 16 + fr]) * (1.f / 512.f); float sq = 0.f;
#pragma unroll
        for (int et = 0; et < 16; ++et) { acc[et] = acc[et] - mean; sq += (acc[et].x * acc[et].x + acc[et].y * acc[et].y) + (acc[et].z * acc[et].z + acc[et].w * acc[et].w); }
        sq += __shfl_xor(sq, 16); sq += __shfl_xor(sq, 32);
        if (fq == 0) XS[128 + wave * 16 + fr] = sq;
        __syncthreads();
        const float rstd = 1.0f / sqrtf((sq + XS[128 + (wave ^ 1) * 16 + fr]) * (1.f / 512.f) + LN_EPS);
#pragma unroll
        for (int et = 0; et < 16; ++et) { const int ch = 512 * h + 256 * we + 16 * et + 4 * fq;
            const f32x4 nw = *(const f32x4*)(args.in[I_MLNW] + ch), sk = *(const f32x4*)(args.in[I_MLSKIP] + ch), xcv = unpack4(*(const v2u*)(xcrow + ch)), zz = unpack4(*(const v2u*)(Z + (size_t)row * 2048 + ch));
            f32x4 y = acc[et] * rstd * nw + sk * xcv;
            y.x *= silu_f(zz.x); y.y *= silu_f(zz.y); y.z *= silu_f(zz.z); y.w *= silu_f(zz.w);
            if (!dry) *(v2u*)(Z + (size_t)row * 2048 + ch) = pack4(y); asm volatile("" ::: "memory"); }
    }
    __syncthreads();
}


#ifndef MK_PER_PHASE
#define MK_PER_PHASE 0
#endif
constexpr int N_PHASES = 25;
#ifndef PROBE_MASK
#define PROBE_MASK 0
#endif
#define DUP(k) (((PROBE_MASK) >> (k)) & 1)
__global__ void __launch_bounds__(NWAVES * 64, 2) mk_fwd(Args args) {
    extern __shared__ __attribute__((aligned(16))) unsigned char lds_raw[];
    LAS unsigned char* lds = (LAS unsigned char*)lds_raw;
    volatile LAS unsigned* MISC = (volatile LAS unsigned*)(lds + MISC_OFF);
    const int tid = threadIdx.x, lane = tid & 63, wave = __builtin_amdgcn_readfirstlane(tid >> 6);
    const int G = gridDim.x, bx = blockIdx.x;
    const int vcu = (G % 8 == 0) ? (bx % 8) * (G / 8) + bx / 8 : bx;
    const int gw = vcu * NWAVES + wave, NGW = G * NWAVES;
    unsigned char* ws = args.ws;
    gu32* ctl = (gu32*)(ws + WS_CTL);
    float* MOD = (float*)(ws + CTL_MOD);
    unsigned char* dob = (unsigned char*)args.out;
    for (int u = tid; u < (LDS_BYTES - LDSCTL_OFF) / 4; u += NWAVES * 64) ((LAS unsigned*)(lds + LDSCTL_OFF))[u] = 0u;
    __syncthreads();
    XcdBarrier bar; bar.bar = (unsigned*)(ctl + CW_BAR); bar.x = 0; bar.st = nullptr;
    if (!MK_PER_PHASE) bar = xcd_barrier_post((unsigned*)(ctl + CW_BAR), MISC + 8);
    const int lo = args.ph_lo, hi = args.ph_hi;
#define IN(k) (lo <= (k) && (k) < hi)
#define SEAM(k) do { if (IN(k) && IN((k) + 1)) xcd_barrier(bar); } while (0)

    if (IN(0)) {
        LAS float* scr = (LAS float*)(lds + wave * 16384);
        conv_abin(args.in[I_ABIN], (bf16*)(ws + WS_W_IN), scr, gw, NGW, lane);
        conv_plain(args.in[I_ABOUT], 2048, 1024, (bf16*)(ws + WS_W_OUT), scr, gw, NGW, lane);
        conv_ffn1(args.in[I_W1], args.in[I_W3], (bf16*)(ws + WS_W_F1), scr, gw, NGW, lane);
        conv_plain(args.in[I_W2], FFH, 1024, (bf16*)(ws + WS_W_F2), scr, gw, NGW, lane);
        __syncthreads();
        LAS float* sc = (LAS float*)lds;
        LAS float* part = (LAS float*)(lds + 16384);
        for (int i = tid; i < 3 * 1024; i += 512) { const int v = i >> 10, k = i & 1023; const float cv = v == 0 ? args.in[I_CCTX][k] : args.in[I_C][(v - 1) * DM + k]; sc[i] = silu_f(cv); }
        __syncthreads();
        for (int u = bx; u < 192; u += G) {
            const int layer = u / 96, cb = u % 96, n = cb * 64 + lane;
            const float* W = args.in[I_ADAW] + (size_t)layer * DM * 6144 + (size_t)(wave * 128) * 6144 + n;
            float a0 = 0.f, a1 = 0.f, a2 = 0.f;
#pragma unroll 8
            for (int kk = 0; kk < 128; ++kk) { const float wv = W[(size_t)kk * 6144]; const int k = wave * 128 + kk; a0 += sc[k] * wv; a1 += sc[1024 + k] * wv; a2 += sc[2048 + k] * wv; }
            part[(wave * 3 + 0) * 64 + lane] = a0; part[(wave * 3 + 1) * 64 + lane] = a1; part[(wave * 3 + 2) * 64 + lane] = a2;
            __syncthreads();
            if (tid < 192) { const int v = tid >> 6, l = tid & 63; float s = args.in[I_ADAB][layer * 6144 + cb * 64 + l];
#pragma unroll
                for (int w = 0; w < 8; ++w) s += part[(w * 3 + v) * 64 + l];
                MOD[(size_t)(layer * 3 + v) * 6144 + cb * 64 + l] = s; }
            __syncthreads();
        }
        for (int i = bx * 512 + tid; i < 512 * 16; i += G * 512) { const int blk = i >> 4, d = (i >> 2) & 3, dp = i & 3; const float* q = args.in[I_MLWQ] + blk * 16 + d * 4; const float* k = args.in[I_MLWK] + blk * 16 + dp * 4;
            ((float*)(ws + WS_WQK))[i] = 0.04419417382415922f * (q[0] * k[0] + q[1] * k[1] + q[2] * k[2] + q[3] * k[3]); }
    }
    SEAM(0);
    if (IN(1)) {
        LAS float* wdt = (LAS float*)lds;
        for (int i = tid; i < 1024 * 4; i += 512) { const int k = i >> 2, q = i & 3; *(LAS f32x4*)(wdt + k * 16 + 4 * q) = *(const f32x4*)(args.in[I_ABIN] + (size_t)k * ABIN + 3072 + 4 * q); }
        __syncthreads();
        norm_rows<true>(args.in[I_CTX], args.in[I_X], args.in[I_NMIX], MOD, 0, (bf16*)(dob + DO_H), 0, 0, R, gw, NGW, lane, wdt, (float*)(ws + WS_DTRAW));
        __syncthreads();
    }
    SEAM(1);
    if (IN(2)) {
        pg8::Gemm g{(const bf16*)(dob + DO_H), (const bf16*)(ws + WS_W_IN), R, 6144, DM}; pg8::StaticOrder S; S.init(R, 6144, G, bx);
        pg8::EpiInProj E{(bf16*)(ws + WS_ZG), (bf16*)(ws + WS_XBC), (bf16*)(ws + WS_QK), (bf16*)(ws + WS_V), (bf16*)(ws + WS_HALO)};
        pg8::gemm_phase<pg8::EpiInProj, pg8::StaticOrder, true, true>(lds, g, S, E);
    }
    SEAM(2);
    if (IN(3)) { phase_l0_prep(args, ws, lds, tid, lane, wave, bx, G, gw, NGW); }
    SEAM(3);
    if (DUP(4) && IN(4)) { phase_l0_scan(args, ws, dob, lds, tid, lane, wave, bx, G); xcd_barrier(bar); }
    if (IN(4)) { phase_l0_scan(args, ws, dob, lds, tid, lane, wave, bx, G); }
    SEAM(4);
    if (DUP(5) && IN(5)) { phase_l0_y(args, ws, dob, lds, tid, lane, wave, bx, G, lo == 0); xcd_barrier(bar); }
    if (IN(5)) { phase_l0_y(args, ws, dob, lds, tid, lane, wave, bx, G); }
    SEAM(5);
    if (IN(6)) {
        pg8::Gemm g{(const bf16*)(ws + WS_ZG), (const bf16*)(ws + WS_W_OUT), R, DM, 2048}; pg8::StaticOrder S; S.init(R, DM, G, bx);
        pg8::EpiResid E{args.in[I_CTX], args.in[I_X], (float*)(ws + WS_XCTX), args.out, MOD + 2 * 1024, 0};
        pg8::gemm_phase<pg8::EpiResid, pg8::StaticOrder, true, true>(lds, g, S, E);
    }
    SEAM(6);
    if (IN(7)) { norm_rows<false>((const float*)(ws + WS_XCTX), args.out, args.in[I_NFFN], MOD, 3, (bf16*)(ws + WS_HF0), 0, 0, R, gw, NGW, lane, nullptr, nullptr); }
    SEAM(7);
    if (IN(8)) {
        pg8::Gemm g{(const bf16*)(ws + WS_HF0), (const bf16*)(ws + WS_W_F1), R, 5632, DM}; pg8::StaticOrder S; S.init(R, 5632, G, bx);
        pg8::EpiSwiglu E{(bf16*)(ws + WS_HH0), FFH};
        pg8::gemm_phase<pg8::EpiSwiglu, pg8::StaticOrder, true, true>(lds, g, S, E);
    }
    SEAM(8);
    if (IN(9)) {
        pg8::Gemm g{(const bf16*)(ws + WS_HH0), (const bf16*)(ws + WS_W_F2), R, DM, FFH}; pg8::StaticOrder S; S.init(R, DM, G, bx);
        pg8::EpiResid E{(const float*)(ws + WS_XCTX), args.out, (float*)(ws + WS_XCTX), args.out, MOD + 5 * 1024, 0};
        pg8::gemm_phase<pg8::EpiResid, pg8::StaticOrder, true, true>(lds, g, S, E);
    }
    SEAM(9);
    if (IN(10)) {
        norm_rows<false>((const float*)(ws + WS_XCTX), args.out, args.in[I_NMIX] + DM, MOD + 3 * 6144, 0, (bf16*)(ws + WS_H1), 0, 0, R, gw, NGW, lane, nullptr, nullptr);
        conv_plain(args.in[I_MLUP], DM, 4096, (bf16*)(ws + WS_W_UP), (LAS float*)(lds + wave * 16384), gw, NGW, lane);
        for (int i = bx * 512 + tid; i < 2 * 16 * 2048; i += G * 512) { const int which = i >> 15, gt = (i >> 11) & 15, d = i & 2047, blk = d >> 2, dd = d & 3; const float* gw = args.in[I_MLGW];
            float s = 0.f;
            if (which == 0) { const float* q = args.in[I_MLWQ] + blk * 16 + dd * 4; const float* k = args.in[I_MLWK] + blk * 16 + dd * 4;
#pragma unroll
                for (int c = 0; c < 4; ++c) s += q[c] * gw[(size_t)(4 * blk + c) * 16 + gt] + k[c] * gw[(size_t)(2048 + 4 * blk + c) * 16 + gt]; }
            else { const float* v = args.in[I_MLWV] + blk * 16 + dd * 4;
#pragma unroll
                for (int c = 0; c < 4; ++c) s += v[c] * gw[(size_t)(4096 + 4 * blk + c) * 16 + gt]; }
            ((bf16*)(ws + WS_GWT))[i] = (bf16)f2bf(s); }
    }
    SEAM(10);
    if (IN(11)) {
        pg8::Gemm g{(const bf16*)(ws + WS_H1), (const bf16*)(ws + WS_W_UP), R, 4096, DM}; pg8::StaticOrder S; S.init(R, 4096, G, bx);
        pg8::EpiSplit2 E{(bf16*)(ws + WS_XM), (bf16*)(ws + WS_Z), 2048, 8};
        pg8::gemm_phase<pg8::EpiSplit2, pg8::StaticOrder, true, true>(lds, g, S, E);
    }
    SEAM(11);
    {
        if (IN(12)) {
            phase_l1_prep(args, ws, lds, tid, lane, wave, bx, G, 0);
            if (0 == 1) {
                LAS float* scr = (LAS float*)(lds + wave * 16384);
                __syncthreads();
                conv_plain(args.in[I_MLDOWN], 2048, 1024, (bf16*)(ws + WS_W_DN), scr, gw, NGW, lane);
                conv_ffn1(args.in[I_W1] + (size_t)DM * FFH, args.in[I_W3] + (size_t)DM * FFH, (bf16*)(ws + WS_W_F1B), scr, gw, NGW, lane);
                conv_plain(args.in[I_W2] + (size_t)FFH * DM, FFH, 1024, (bf16*)(ws + WS_W_F2B), scr, gw, NGW, lane);
            }
        }
        SEAM(12);
        if (DUP(13) && IN(13)) { phase_l1_prep(args, ws, lds, tid, lane, wave, bx, G, 0); xcd_barrier(bar); phase_l1_gatescan(args, ws, lds, tid, lane, wave, bx, G, gw, NGW, 0); xcd_barrier(bar); }
        if (IN(13)) { phase_l1_gatescan(args, ws, lds, tid, lane, wave, bx, G, gw, NGW, 0); }
        SEAM(13);
        if (DUP(14) && IN(14)) { phase_l1_scan(args, ws, lds, tid, lane, wave, bx, G, 0); xcd_barrier(bar); }
        if (IN(14)) { phase_l1_scan(args, ws, lds, tid, lane, wave, bx, G, 0); }
        SEAM(14);
        if (DUP(15) && IN(15)) { phase_l1_y(args, ws, lds, tid, lane, wave, bx, G, 0, lo == 0); xcd_barrier(bar); }
        if (IN(15)) { phase_l1_y(args, ws, lds, tid, lane, wave, bx, G, 0); }
        SEAM(15);
    }
    {
        if (IN(16)) {
            phase_l1_prep(args, ws, lds, tid, lane, wave, bx, G, 1);
            if (1 == 1) {
                LAS float* scr = (LAS float*)(lds + wave * 16384);
                __syncthreads();
                conv_plain(args.in[I_MLDOWN], 2048, 1024, (bf16*)(ws + WS_W_DN), scr, gw, NGW, lane);
                conv_ffn1(args.in[I_W1] + (size_t)DM * FFH, args.in[I_W3] + (size_t)DM * FFH, (bf16*)(ws + WS_W_F1B), scr, gw, NGW, lane);
                conv_plain(args.in[I_W2] + (size_t)FFH * DM, FFH, 1024, (bf16*)(ws + WS_W_F2B), scr, gw, NGW, lane);
            }
        }
        SEAM(16);
        if (DUP(13) && IN(17)) { phase_l1_prep(args, ws, lds, tid, lane, wave, bx, G, 1); xcd_barrier(bar); phase_l1_gatescan(args, ws, lds, tid, lane, wave, bx, G, gw, NGW, 1); xcd_barrier(bar); }
        if (IN(17)) { phase_l1_gatescan(args, ws, lds, tid, lane, wave, bx, G, gw, NGW, 1); }
        SEAM(17);
        if (DUP(14) && IN(18)) { phase_l1_scan(args, ws, lds, tid, lane, wave, bx, G, 1); xcd_barrier(bar); }
        if (IN(18)) { phase_l1_scan(args, ws, lds, tid, lane, wave, bx, G, 1); }
        SEAM(18);
        if (DUP(15) && IN(19)) { phase_l1_y(args, ws, lds, tid, lane, wave, bx, G, 1, lo == 0); xcd_barrier(bar); }
        if (IN(19)) { phase_l1_y(args, ws, lds, tid, lane, wave, bx, G, 1); }
        SEAM(19);
    }
    if (IN(20)) {
        pg8::Gemm g{(const bf16*)(ws + WS_Z) + (size_t)RL0 * 2048, (const bf16*)(ws + WS_W_DN), MLAT, DM, 2048}; pg8::StaticOrder S; S.init(MLAT, DM, G, bx);
        pg8::EpiResid E{(const float*)(ws + WS_XCTX), args.out, (float*)(ws + WS_XCTX), args.out, MOD + 3 * 6144 + 2 * 1024, RL0};
        pg8::gemm_phase<pg8::EpiResid, pg8::StaticOrder, true, true>(lds, g, S, E);
    }
    SEAM(20);
    if (IN(21)) { norm_rows<false>((const float*)(ws + WS_XCTX), args.out, args.in[I_NFFN] + DM, MOD + 3 * 6144, 3, (bf16*)(ws + WS_HF1), RL0, RL0, R, gw, NGW, lane, nullptr, nullptr); }
    SEAM(21);
    if (IN(22)) {
        pg8::Gemm g{(const bf16*)(ws + WS_HF1), (const bf16*)(ws + WS_W_F1B), MLAT, 5632, DM}; pg8::StaticOrder S; S.init(MLAT, 5632, G, bx);
        pg8::EpiSwiglu E{(bf16*)(ws + WS_HH1), FFH};
        pg8::gemm_phase<pg8::EpiSwiglu, pg8::StaticOrder, true, true>(lds, g, S, E);
    }
    SEAM(22);
    if (IN(23)) {
        pg8::Gemm g{(const bf16*)(ws + WS_HH1), (const bf16*)(ws + WS_W_F2B), MLAT, DM, FFH}; pg8::StaticOrder S; S.init(MLAT, DM, G, bx);
        pg8::EpiResid E{(const float*)(ws + WS_XCTX), args.out, (float*)(ws + WS_XCTX), args.out, MOD + 3 * 6144 + 5 * 1024, RL0};
        pg8::gemm_phase<pg8::EpiResid, pg8::StaticOrder, true, true>(lds, g, S, E);
    }
    SEAM(23);
    if (IN(24)) {
        const float* w = args.in[I_FNW];
        for (int m = gw; m < MLAT; m += NGW) {
            float* row = args.out + (size_t)m * DM; f32x4 v[4]; float ss = 0.f;
#pragma unroll
            for (int j = 0; j < 4; ++j) { v[j] = *(const f32x4*)(row + 4 * lane + 256 * j); ss += (v[j].x * v[j].x + v[j].y * v[j].y) + (v[j].z * v[j].z + v[j].w * v[j].w); }
            const float rstd = 1.0f / sqrtf(wave_sum(ss) * (1.f / DM) + RMS_EPS);
#pragma unroll
            for (int j = 0; j < 4; ++j) { const f32x4 wv = *(const f32x4*)(w + 4 * lane + 256 * j); *(f32x4*)(row + 4 * lane + 256 * j) = v[j] * rstd * wv; }
        }
    }
#undef IN
#undef SEAM
}

extern "C" void kernel_launch(void* const* d_in, const int* in_sizes, int n_in, void* d_out, int out_size, void* d_ws, size_t ws_size, hipStream_t stream) {
    static int grid = 0;
    if (grid == 0) {
        if (n_in != 35 || out_size != MLAT * DM || ws_size < WS_END) { fprintf(stderr, "kernel_launch: unexpected problem: n_in %d out %d ws %zu\n", n_in, out_size, ws_size); grid = -1; return; }
        int dev = 0, cus = 0;
        if (hipGetDevice(&dev) != hipSuccess || hipDeviceGetAttribute(&cus, hipDeviceAttributeMultiprocessorCount, dev) != hipSuccess) { grid = -1; return; }
        if (hipFuncSetAttribute((const void*)mk_fwd, hipFuncAttributeMaxDynamicSharedMemorySize, LDS_BYTES) != hipSuccess) { fprintf(stderr, "kernel_launch: hipFuncSetAttribute failed\n"); grid = -1; return; }
        int per_cu = 0;
        if (hipOccupancyMaxActiveBlocksPerMultiprocessor(&per_cu, (const void*)mk_fwd, NWAVES * 64, LDS_BYTES) != hipSuccess || per_cu < 1) fprintf(stderr, "kernel_launch: occupancy query says %d\n", per_cu);
        (void)hipGetLastError();
        grid = cus;
    }
    if (grid < 0) return;
    if (hipMemsetAsync((char*)d_ws + WS_CTL, 0, CTL_ZERO_BYTES, stream) != hipSuccess) return;
    Args a{};
    for (int i = 0; i < 35; ++i) a.in[i] = (const float*)d_in[i];
    a.out = (float*)d_out; a.ws = (unsigned char*)d_ws;
#if MK_PER_PHASE
    for (int p = 0; p < N_PHASES; ++p) { a.ph_lo = p; a.ph_hi = p + 1; hipLaunchKernelGGL(mk_fwd, dim3(grid), dim3(NWAVES * 64), LDS_BYTES, stream, a); }
#else
    a.ph_lo = 0; a.ph_hi = N_PHASES;
    hipLaunchKernelGGL(mk_fwd, dim3(grid), dim3(NWAVES * 64), LDS_BYTES, stream, a);
#endif
}
```

```cpp
#include <hip/hip_runtime.h>
#include <cstdio>
#include <cstdint>
#define BARRIER2 1
namespace pg8 {
#define PG8_LAS __attribute__((address_space(3)))
typedef unsigned short bf16_t;
typedef short bf16x8 __attribute__((ext_vector_type(8)));
typedef float f32x4 __attribute__((ext_vector_type(4)));
typedef unsigned u32x4 __attribute__((ext_vector_type(4)));
constexpr int BM = 256, BK = 64, HALF = 128, HTB = HALF * BK * 2  , STAGE_BYTES = 8 * HTB, NXCD = 8, WGM = 8;

__host__ __device__ __forceinline__ int lds_byte(int r, int c) { const int st = (r >> 4) * 2 + (c >> 5), rr = r & 15, cc = c & 31, ob = rr * 64 + cc * 2; return st * 1024 + (ob ^ (((ob >> 9) & 1) << 5)); }
__host__ __device__ __forceinline__ void stage_rc(int b, int& R, int& C) { const int st = b / 1024, sb = b % 1024, swz = sb ^ (((sb >> 9) & 1) << 5); R = (st >> 1) * 16 + swz / 64; C = (st & 1) * 32 + (swz % 64) / 2; }
__host__ __device__ __forceinline__ int perm32(int rho) { const int n = rho >> 4, i = rho & 15; return 8 * (i >> 2) + 4 * n + (i & 3); }

struct Unit { int pm, pn; };
struct Gemm { const bf16_t* A; const bf16_t* Bt; int M, N, K; };

struct StaticOrder {
    int nM, nN, nwg, G, c;
    __host__ __device__ void init(int M, int N, int G_, int c_) { nM = M / BM; nN = N / BM; nwg = nM * nN; G = G_; c = c_; }
    __host__ __device__ bool next(int i, Unit& u) const {
        const long L = (long)i * G + c; if (L >= nwg) return false;
        int wgid = (int)L; { const int q = nwg / NXCD, r = nwg % NXCD, xcd = wgid % NXCD, off = wgid / NXCD; wgid = (xcd < r ? xcd * (q + 1) : r * (q + 1) + (xcd - r) * q) + off; }
        const int nig = WGM * nN, gid = wgid / nig, fm = gid * WGM, gsz = (nM - fm) < WGM ? (nM - fm) : WGM;
        u.pm = fm + ((wgid % nig) % gsz); u.pn = (wgid % nig) / gsz; return true;
    }
    __device__ __forceinline__ void a_ready(const Unit&) const {}
    __device__ __forceinline__ void done(const Unit&) const {}
};

__device__ __forceinline__ unsigned cvt_pk_bf16(float lo, float hi) { unsigned r; asm volatile("v_cvt_pk_bf16_f32 %0, %1, %2" : "=v"(r) : "v"(lo), "v"(hi)); return r; }
__device__ __forceinline__ float fast_silu(float a) { return a * __builtin_amdgcn_rcpf(1.0f + __expf(-a)); }

struct EpiInProj {
    static constexpr bool PERM = true, AFTER_DRAIN = false;
    bf16_t *ZG, *XBC, *QK, *V, *HALO;
    __device__ __forceinline__ void operator()(const f32x4 (&acc)[2][2][4][2], const Unit& u, int wr, int wc, int fr, int fq) const {
        const int pn = u.pn; bf16_t* base; int ld, c0; bool halo = false;
        if (pn < 4) { base = ZG; ld = 2048; c0 = 256 * pn; }
        else if (pn < 12) { base = XBC; ld = 2048; c0 = 256 * (pn - 4); halo = true; }
        else if (pn < 16) { base = QK; ld = 1024; c0 = 256 * (pn - 12); }
        else if (pn < 20) { base = V; ld = 1024; c0 = 256 * (pn - 16); }
        else { base = ZG; ld = 2048; c0 = 1024 + 256 * (pn - 20); }
        const int row0 = u.pm * BM + wr * 64 + fr, col = c0 + wc * 32 + 8 * fq;
#pragma unroll
        for (int ai = 0; ai < 2; ++ai)
#pragma unroll
            for (int m = 0; m < 4; ++m) { const int r = row0 + ai * HALF + m * 16; bf16_t* rowp = base + (size_t)r * ld + col;
                const int rr = r & 31; const bool hrow = halo && (rr < 2 || rr >= 30);
#pragma unroll
                for (int bj = 0; bj < 2; ++bj) { const f32x4 v0 = acc[ai][bj][m][0], v1 = acc[ai][bj][m][1];
                    u32x4 w; w.x = cvt_pk_bf16(v0[0], v0[1]); w.y = cvt_pk_bf16(v0[2], v0[3]); w.z = cvt_pk_bf16(v1[0], v1[1]); w.w = cvt_pk_bf16(v1[2], v1[3]);
                    *(u32x4*)(rowp + bj * HALF) = w;
                    if (hrow) { const int slot = rr < 2 ? rr : rr - 28; *(u32x4*)(HALO + ((size_t)(r >> 5) * 4 + slot) * 2048 + col + bj * HALF) = w; } } }
    }
};
struct EpiSplit2 {
    static constexpr bool PERM = true, AFTER_DRAIN = false;
    bf16_t *O0, *O1; int ld, split_tiles;
    __device__ __forceinline__ void operator()(const f32x4 (&acc)[2][2][4][2], const Unit& u, int wr, int wc, int fr, int fq) const {
        bf16_t* base = u.pn < split_tiles ? O0 : O1; const int c0 = 256 * (u.pn < split_tiles ? u.pn : u.pn - split_tiles);
        const int row0 = u.pm * BM + wr * 64 + fr, col = c0 + wc * 32 + 8 * fq;
#pragma unroll
        for (int ai = 0; ai < 2; ++ai)
#pragma unroll
            for (int m = 0; m < 4; ++m) { bf16_t* rowp = base + (size_t)(row0 + ai * HALF + m * 16) * ld + col;
#pragma unroll
                for (int bj = 0; bj < 2; ++bj) { const f32x4 v0 = acc[ai][bj][m][0], v1 = acc[ai][bj][m][1];
                    u32x4 w; w.x = cvt_pk_bf16(v0[0], v0[1]); w.y = cvt_pk_bf16(v0[2], v0[3]); w.z = cvt_pk_bf16(v1[0], v1[1]); w.w = cvt_pk_bf16(v1[2], v1[3]);
                    *(u32x4*)(rowp + bj * HALF) = w; } }
    }
};
struct EpiSwiglu {
    static constexpr bool PERM = true, AFTER_DRAIN = false;
    bf16_t* O; int ld;
    __device__ __forceinline__ void operator()(const f32x4 (&acc)[2][2][4][2], const Unit& u, int wr, int wc, int fr, int fq) const {
        const int row0 = u.pm * BM + wr * 64 + fr, col = u.pn * HALF + wc * 32 + 8 * fq;
#pragma unroll
        for (int ai = 0; ai < 2; ++ai)
#pragma unroll
            for (int m = 0; m < 4; ++m) { bf16_t* rowp = O + (size_t)(row0 + ai * HALF + m * 16) * ld + col;
                float h[8];
#pragma unroll
                for (int n = 0; n < 2; ++n)
#pragma unroll
                    for (int j = 0; j < 4; ++j) h[4 * n + j] = fast_silu(acc[ai][0][m][n][j]) * acc[ai][1][m][n][j];
                u32x4 w; w.x = cvt_pk_bf16(h[0], h[1]); w.y = cvt_pk_bf16(h[2], h[3]); w.z = cvt_pk_bf16(h[4], h[5]); w.w = cvt_pk_bf16(h[6], h[7]);
                *(u32x4*)rowp = w; }
    }
};
struct EpiResid {
    static constexpr bool PERM = false, AFTER_DRAIN = false;
    const float *resC, *resL; float *outC, *outL; const float* gate; int row_off;
    __device__ __forceinline__ void operator()(const f32x4 (&acc)[2][2][4][2], const Unit& u, int wr, int wc, int fr, int fq) const {
        const int t0 = u.pm * BM + row_off; const float* res; float* out; const float* g; int rbase;
        if (t0 < 512) { res = resC; out = outC; g = gate; rbase = t0; }
        else { res = resL; out = outL; rbase = t0 - 512; g = gate + (size_t)(1 + (rbase >> 13)) * 6144; }
        const int row0 = rbase + wr * 64 + fr, col0 = u.pn * BM + wc * 32 + 4 * fq;
        f32x4 gv[2][2];
#pragma unroll
        for (int bj = 0; bj < 2; ++bj)
#pragma unroll
            for (int n = 0; n < 2; ++n) gv[bj][n] = *(const f32x4*)(g + col0 + bj * HALF + n * 16);
#pragma unroll
        for (int ai = 0; ai < 2; ++ai)
#pragma unroll
            for (int m = 0; m < 4; ++m) { const size_t off = (size_t)(row0 + ai * HALF + m * 16) * 1024 + col0;
#pragma unroll
                for (int bj = 0; bj < 2; ++bj)
#pragma unroll
                    for (int n = 0; n < 2; ++n) { const f32x4 bs = *(const f32x4*)(res + off + bj * HALF + n * 16);
                        *(f32x4*)(out + off + bj * HALF + n * 16) = bs + gv[bj][n] * acc[ai][bj][m][n]; }
                if (m & 1) asm volatile("" ::: "memory"); }
    }
};


template <class Epi, class Sched, bool ALIGN_EPI = false, bool SP2 = false>
__device__ __forceinline__ void gemm_phase(PG8_LAS unsigned char* lds, const Gemm g, const Sched& S, const Epi& E) {
    const int tid = threadIdx.x, wid = __builtin_amdgcn_readfirstlane(tid >> 6), lane = tid & 63, wr = wid >> 2, wc = wid & 3, fr = lane & 15, fq = lane >> 4;
    const int K = g.K, nt = K / BK;
    unsigned voffA[2], voffB[2];
#pragma unroll
    for (int i = 0; i < 2; ++i) { int R, C; stage_rc(tid * 16 + i * 8192, R, C); const int Rb = Epi::PERM ? ((R & ~31) + perm32(R & 31)) : R;
        voffA[i] = (unsigned)(R * K + C) * 2u; voffB[i] = (unsigned)(Rb * K + C) * 2u; }
    const size_t kstep = (size_t)(BK * 2);
    const size_t hstep = (size_t)HALF * K * 2;
    const size_t tstep = 2 * hstep;
    const unsigned ldsw = (unsigned)wid * 1024u;
    const int aoff = lds_byte(wr * 64 + fr, fq * 8), boff = lds_byte(wc * 32 + fr, fq * 8);
#define PG8_SA(b, h) (((b) * 2 + (h)) * HTB)
#define PG8_SB(b, h) ((4 + (b) * 2 + (h)) * HTB)
#define PG8_STAGE(bufoff, gbase, voff) do { _Pragma("unroll") for (int _i = 0; _i < 2; ++_i) \
        __builtin_amdgcn_global_load_lds((const unsigned*)((const char*)(gbase) + (voff)[_i]), (PG8_LAS unsigned*)(lds + (bufoff) + ldsw + _i * 8192), 16, 0, 0); } while (0)
#define PG8_LDA(dst, b, h) do { _Pragma("unroll") for (int m = 0; m < 4; ++m) _Pragma("unroll") for (int k = 0; k < 2; ++k) dst[m][k] = *(const PG8_LAS bf16x8*)(lds + PG8_SA(b, h) + aoff + m * 2048 + k * 1024); } while (0)
#define PG8_LDB(dst, b, h) do { _Pragma("unroll") for (int n = 0; n < 2; ++n) _Pragma("unroll") for (int k = 0; k < 2; ++k) dst[n][k] = *(const PG8_LAS bf16x8*)(lds + PG8_SB(b, h) + boff + n * 2048 + k * 1024); } while (0)
#define PG8_MMA(ai, bj, At, Bt) do { __builtin_amdgcn_s_setprio(1); _Pragma("unroll") for (int m = 0; m < 4; ++m) _Pragma("unroll") for (int n = 0; n < 2; ++n) _Pragma("unroll") for (int k = 0; k < 2; ++k) \
        acc[ai][bj][m][n] = __builtin_amdgcn_mfma_f32_16x16x32_bf16(Bt[n][k], At[m][k], acc[ai][bj][m][n], 0, 0, 0); __builtin_amdgcn_s_setprio(0); } while (0)
#define PG8_WAIT_V(n) asm volatile("s_waitcnt vmcnt(" #n ")" ::: "memory")
#define PG8_WAIT_L(n) asm volatile("s_waitcnt lgkmcnt(" #n ")" ::: "memory")
#define PG8_BAR __builtin_amdgcn_s_barrier()
#define PG8_SCHED __builtin_amdgcn_sched_barrier(0)
    Unit cur, nxt; int ui = 0;
    if (!S.next(0, cur)) return;
    f32x4 acc[2][2][4][2];
#pragma unroll
    for (int a = 0; a < 2; ++a)
#pragma unroll
        for (int b = 0; b < 2; ++b)
#pragma unroll
            for (int m = 0; m < 4; ++m)
#pragma unroll
                for (int n = 0; n < 2; ++n) acc[a][b][m][n] = (f32x4){0.f, 0.f, 0.f, 0.f};
    bf16x8 At[4][2], B0[2][2], B1[2][2];
    const char* cA = (const char*)g.A + (size_t)cur.pm * tstep; const char* cB = (const char*)g.Bt + (size_t)cur.pn * tstep;
    S.a_ready(cur);
    if constexpr (SP2) {
        PG8_STAGE(PG8_SB(0, 0), cB, voffB); PG8_STAGE(PG8_SB(0, 1), cB + hstep, voffB); PG8_STAGE(PG8_SA(0, 0), cA, voffA); PG8_STAGE(PG8_SA(0, 1), cA + hstep, voffA);
        if (wr == 1) PG8_BAR;
        PG8_WAIT_V(2); PG8_BAR;
        PG8_STAGE(PG8_SB(1, 0), cB + kstep, voffB); PG8_STAGE(PG8_SA(1, 0), cA + kstep, voffA); PG8_STAGE(PG8_SB(1, 1), cB + hstep + kstep, voffB);
        PG8_WAIT_V(6); PG8_BAR;
    } else {
        PG8_STAGE(PG8_SB(0, 0), cB, voffB); PG8_STAGE(PG8_SA(0, 0), cA, voffA); PG8_STAGE(PG8_SB(0, 1), cB + hstep, voffB); PG8_STAGE(PG8_SA(0, 1), cA + hstep, voffA);
        if (wr == 1) PG8_BAR;
        PG8_WAIT_V(4); PG8_BAR;
        PG8_STAGE(PG8_SB(1, 0), cB + kstep, voffB); PG8_STAGE(PG8_SA(1, 0), cA + kstep, voffA); PG8_STAGE(PG8_SB(1, 1), cB + hstep + kstep, voffB);
        PG8_WAIT_V(6); PG8_BAR;
    }
    for (;;) {
        const bool has_next = S.next(ui + 1, nxt);
        const char* nA = has_next ? (const char*)g.A + (size_t)nxt.pm * tstep : cA; const char* nB = has_next ? (const char*)g.Bt + (size_t)nxt.pn * tstep : cB;
        for (int t = 0; t < nt; t += 2) {
            const bool last = (t == nt - 2);
            const char* a1 = cA + (size_t)(t + 1) * kstep;
            const char* a2 = last ? nA : cA + (size_t)(t + 2) * kstep; const char* b2 = last ? nB : cB + (size_t)(t + 2) * kstep;
            const char* a3 = a2 + kstep; const char* b3 = b2 + kstep;
            if (last && has_next) S.a_ready(nxt);
            if constexpr (SP2) {
            PG8_LDB(B0, 0, 0); PG8_LDB(B1, 0, 1); PG8_SCHED; PG8_LDA(At, 0, 0); PG8_STAGE(PG8_SA(1, 1), a1 + hstep, voffA);
            PG8_WAIT_V(8); PG8_WAIT_L(0); PG8_BAR; PG8_MMA(0, 0, At, B0); PG8_MMA(0, 1, At, B1); PG8_BAR; PG8_SCHED;
            PG8_LDA(At, 0, 1); PG8_STAGE(PG8_SB(0, 0), b2, voffB); PG8_STAGE(PG8_SB(0, 1), b2 + hstep, voffB); PG8_STAGE(PG8_SA(0, 0), a2, voffA);
            PG8_WAIT_V(8); PG8_WAIT_L(0); PG8_BAR; PG8_MMA(1, 0, At, B0); PG8_MMA(1, 1, At, B1); PG8_BAR; PG8_SCHED;
            PG8_LDB(B0, 1, 0); PG8_LDB(B1, 1, 1); PG8_SCHED; PG8_LDA(At, 1, 0); PG8_STAGE(PG8_SA(0, 1), a2 + hstep, voffA);
            PG8_WAIT_V(8); PG8_WAIT_L(0); PG8_BAR; PG8_MMA(0, 0, At, B0); PG8_MMA(0, 1, At, B1); PG8_BAR; PG8_SCHED;
            PG8_LDA(At, 1, 1); PG8_STAGE(PG8_SB(1, 0), b3, voffB); PG8_STAGE(PG8_SB(1, 1), b3 + hstep, voffB); PG8_STAGE(PG8_SA(1, 0), a3, voffA);
            PG8_WAIT_V(8); PG8_WAIT_L(0); PG8_BAR; PG8_MMA(1, 0, At, B0); PG8_MMA(1, 1, At, B1); PG8_BAR; PG8_SCHED;
            } else {
            PG8_LDB(B0, 0, 0); PG8_SCHED; PG8_LDA(At, 0, 0); PG8_STAGE(PG8_SA(1, 1), a1 + hstep, voffA);
            PG8_WAIT_L(8); PG8_BAR; PG8_WAIT_L(0); PG8_MMA(0, 0, At, B0); PG8_BAR; PG8_SCHED;
            PG8_LDB(B1, 0, 1); PG8_STAGE(PG8_SB(0, 0), b2, voffB);
            PG8_BAR; PG8_WAIT_L(0); PG8_MMA(0, 1, At, B1); PG8_BAR;
            PG8_LDA(At, 0, 1); PG8_STAGE(PG8_SA(0, 0), a2, voffA);
            PG8_BAR; PG8_WAIT_L(0); PG8_MMA(1, 0, At, B0); PG8_BAR; PG8_SCHED;
            PG8_STAGE(PG8_SB(0, 1), b2 + hstep, voffB);
            PG8_WAIT_V(6); PG8_BAR; PG8_MMA(1, 1, At, B1); PG8_BAR;
            PG8_LDB(B0, 1, 0); PG8_SCHED; PG8_LDA(At, 1, 0); PG8_STAGE(PG8_SA(0, 1), a2 + hstep, voffA);
            PG8_WAIT_L(8); PG8_BAR; PG8_WAIT_L(0); PG8_MMA(0, 0, At, B0); PG8_BAR; PG8_SCHED;
            PG8_LDB(B1, 1, 1); PG8_STAGE(PG8_SB(1, 0), b3, voffB);
            PG8_BAR; PG8_WAIT_L(0); PG8_MMA(0, 1, At, B1); PG8_BAR;
            PG8_LDA(At, 1, 1); PG8_STAGE(PG8_SA(1, 0), a3, voffA);
            PG8_BAR; PG8_WAIT_L(0); PG8_MMA(1, 0, At, B0); PG8_BAR; PG8_SCHED;
            PG8_STAGE(PG8_SB(1, 1), b3 + hstep, voffB);
            PG8_WAIT_V(6); PG8_BAR; PG8_MMA(1, 1, At, B1); PG8_BAR;
            }
        }
        if constexpr (ALIGN_EPI) { if (wr == 0) PG8_BAR; }
        if constexpr (!Epi::AFTER_DRAIN) { E(acc, cur, wr, wc, fr, fq); S.done(cur); }
        if (!has_next) break;
#pragma unroll
        for (int a = 0; a < 2; ++a)
#pragma unroll
            for (int b = 0; b < 2; ++b)
#pragma unroll
                for (int m = 0; m < 4; ++m)
#pragma unroll
                    for (int n = 0; n < 2; ++n) acc[a][b][m][n] = (f32x4){0.f, 0.f, 0.f, 0.f};
        cur = nxt; cA = nA; cB = nB; ++ui;
        if constexpr (ALIGN_EPI) { if (wr == 1) PG8_BAR; }
    }
    PG8_WAIT_V(0);
    if constexpr (!ALIGN_EPI) { if (wr == 0) PG8_BAR; }
    PG8_BAR;
    if constexpr (Epi::AFTER_DRAIN) { E.fused(acc, cur, wr, wc, fr, fq, lds, wid, lane); S.done(cur); }
#undef PG8_SA
#undef PG8_SB
#undef PG8_STAGE
#undef PG8_LDA
#undef PG8_LDB
#undef PG8_MMA
#undef PG8_WAIT_V
#undef PG8_WAIT_L
#undef PG8_BAR
#undef PG8_SCHED
}
}


constexpr int NWAVES = 8;
constexpr int DM = 1024, SEQ = 8192, CTXL = 256, NB = 2;
constexpr int R = NB * (SEQ + CTXL);
constexpr int RL0 = NB * CTXL;
constexpr int MLAT = NB * SEQ;
constexpr int FFH = 2816;
constexpr int ABIN = 6160;
constexpr float RMS_EPS = 1e-6f, LN_EPS = 1e-5f;

constexpr size_t MiB = 1u << 20;
constexpr size_t WS_CTL = 0, CTL_ZERO_BYTES = 1 * MiB;
constexpr size_t CTL_MOD = 256 * 1024;
constexpr size_t WS_XCTX = 1 * MiB;
constexpr size_t WS_DTRAW = 3 * MiB, WS_DTF = WS_DTRAW + 1280 * 1024, WS_DTB = WS_DTF + 1280 * 1024, WS_CSF = WS_DTB + 1280 * 1024, WS_RB = WS_CSF + 1280 * 1024;
constexpr size_t WS_WQK = 9 * MiB + 256 * 1024;
constexpr size_t WS_HALO = 9 * MiB + 512 * 1024;
constexpr size_t WS_W_IN = 18 * MiB, WS_W_OUT = 30 * MiB, WS_W_F1 = 34 * MiB, WS_W_F2 = 45 * MiB;
constexpr size_t WS_ZG = 51 * MiB, WS_XBC = 117 * MiB, WS_QK = 183 * MiB, WS_V = 216 * MiB;
constexpr size_t WS_HF0 = WS_V, WS_HH0 = WS_XBC;
constexpr size_t WS_GATE = 3 * MiB, WS_BC = WS_GATE + 1280 * 1024, WS_AJ = WS_BC + 768 * 1024, WS_CM = WS_AJ + 768 * 1024, WS_CH = WS_CM + 768 * 1024, WS_NV = WS_CH + 256 * 1024;
constexpr size_t WS_W_UP = 10 * MiB, WS_H1 = 18 * MiB, WS_XC = 18 * MiB, WS_XM = 51 * MiB, WS_Z = 117 * MiB, WS_ST1 = 183 * MiB;
constexpr size_t WS_W_DN = 53 * MiB, WS_W_F1B = 57 * MiB, WS_W_F2B = 68 * MiB;
constexpr size_t WS_HF1 = WS_Z, WS_HH1 = 150 * MiB;
constexpr size_t WS_END = 256 * MiB;
constexpr size_t DO_H = 0, DO_ST_SSD = 0, DO_ST_RET = 16 * MiB;
constexpr int CW_TMO = 0, CW_CODE = 1, CW_BAR = 4096;

constexpr int RING_BYTES = 131072;
constexpr int SCR_BYTES = 143360;
constexpr int LDSCTL_OFF = SCR_BYTES, MISC_OFF = LDSCTL_OFF + 320;
constexpr int LDS_BYTES = 147456;

#define GAS __attribute__((address_space(1)))
#define LAS __attribute__((address_space(3)))
typedef unsigned short bf16;
typedef unsigned v4u __attribute__((ext_vector_type(4)));
typedef unsigned v2u __attribute__((ext_vector_type(2)));
typedef float f32x4 __attribute__((ext_vector_type(4)));
typedef short bf16x8 __attribute__((ext_vector_type(8)));
typedef short s16x4 __attribute__((ext_vector_type(4)));
typedef GAS unsigned gu32;
#define RLX_AGENT __ATOMIC_RELAXED, __HIP_MEMORY_SCOPE_AGENT
#define LDS_WAIT() asm volatile("s_waitcnt lgkmcnt(0)" ::: "memory")
#define VM_WAIT() asm volatile("s_waitcnt vmcnt(0)" ::: "memory")
__device__ __forceinline__ unsigned f2bf(float f) { unsigned u = __builtin_bit_cast(unsigned, f); return (u + 0x7fffu + ((u >> 16) & 1u)) >> 16; }
typedef float f32x2_t __attribute__((ext_vector_type(2)));
typedef __bf16 bf16x2_t __attribute__((ext_vector_type(2)));
__device__ __forceinline__ unsigned pk2(float lo, float hi) { f32x2_t v = {lo, hi}; bf16x2_t b = __builtin_convertvector(v, bf16x2_t); return __builtin_bit_cast(unsigned, b); }
__device__ __forceinline__ float bf2f(unsigned short h) { return __builtin_bit_cast(float, (unsigned)h << 16); }
__device__ __forceinline__ float bflo(unsigned w) { return __builtin_bit_cast(float, w << 16); }
__device__ __forceinline__ float bfhi(unsigned w) { return __builtin_bit_cast(float, w & 0xffff0000u); }
__device__ __forceinline__ float silu_f(float a) { return a * __builtin_amdgcn_rcpf(1.0f + __expf(-a)); }
__device__ __forceinline__ float softplus_f(float x) { return x > 20.f ? x : log1pf(__expf(x)); }
__device__ __forceinline__ float logsig_f(float x) { return x >= 0.f ? -log1pf(__expf(-x)) : x - log1pf(__expf(x)); }
__device__ __forceinline__ float wave_sum(float v) {
#pragma unroll
    for (int o = 1; o < 64; o <<= 1) v += __shfl_xor(v, o);
    return v;
}
__device__ __forceinline__ float wave_max(float v) {
#pragma unroll
    for (int o = 1; o < 64; o <<= 1) v = fmaxf(v, __shfl_xor(v, o));
    return v;
}

#define XB_TMO      128
#define XB_XCNT(j)  (256  + 64 * (j))
#define XB_XSUB(j)  (1280 + 64 * (j))
#define XB_XGEN(j)  (2304 + 64 * (j))
#define XB_TOP      3328
#define XB_TOPGEN   3392
#define XCD_BAR_WORDS 3456
#define XB_SPIN_CAP (1u << 18)

__device__ __forceinline__ unsigned xb_ld(unsigned* p)              { return __hip_atomic_load(p, __ATOMIC_RELAXED, __HIP_MEMORY_SCOPE_AGENT); }
__device__ __forceinline__ unsigned xb_add(unsigned* p, unsigned v) { return __hip_atomic_fetch_add(p, v, __ATOMIC_RELAXED, __HIP_MEMORY_SCOPE_AGENT); }
__device__ __forceinline__ unsigned xb_xcc_id() { return (unsigned)__builtin_amdgcn_s_getreg((3 << 11) | 20) & 0xFu; }
#define XB_SPIN(cond, bar) do { unsigned _sp = 0; while (cond) { __builtin_amdgcn_s_sleep(1); \
    if ((++_sp & 255u) == 0u) { if (xb_ld(&(bar)[XB_TMO])) break; if (_sp > XB_SPIN_CAP) { atomicAdd(&(bar)[XB_TMO], 1u); break; } } } } while (0)

struct XcdBarrier {
    unsigned* bar; unsigned x;
    volatile LAS unsigned* st;
};

__device__ __forceinline__ XcdBarrier xcd_barrier_post(unsigned* bar, volatile LAS unsigned* st) {
    XcdBarrier b; b.bar = bar; b.x = xb_xcc_id(); b.st = st;
    if (threadIdx.x == 0) (void)xb_add(&bar[XB_XCNT(b.x)], 1u);
    return b;
}
__device__ __forceinline__ void xcd_barrier_complete(unsigned* bar, unsigned x, unsigned& nloc, unsigned& nx) {
    const unsigned G = gridDim.x * gridDim.y * gridDim.z;
    unsigned sum, cnt, mine, sp = 0u;
    for (;;) {
        sum = 0u; cnt = 0u; mine = 0u;
#pragma unroll
        for (unsigned j = 0; j < 16; ++j) { const unsigned c = xb_ld(&bar[XB_XCNT(j)]); sum += c; cnt += (c > 0u) ? 1u : 0u; mine = (j == x) ? c : mine; }
        if (sum == G) break;
        __builtin_amdgcn_s_sleep(1);
        if ((++sp & 255u) == 0u) { if (xb_ld(&bar[XB_TMO])) break; if (sp > XB_SPIN_CAP) { atomicAdd(&bar[XB_TMO], 1u); break; } }
    }
    nloc = mine > 0u ? mine : 1u; nx = cnt > 0u ? cnt : 1u;
}

__device__ __forceinline__ void xcd_barrier(const XcdBarrier& b) {
    asm volatile("s_waitcnt vmcnt(0)" ::: "memory");
    __syncthreads();
    if (threadIdx.x == 0) {
        unsigned* bar = b.bar;
        __builtin_amdgcn_s_waitcnt(0);
        unsigned nloc = b.st[0], nx = b.st[1];
        if (nloc == 0u) { xcd_barrier_complete(bar, b.x, nloc, nx); b.st[0] = nloc; b.st[1] = nx; }
        const unsigned old = xb_add(&bar[XB_XSUB(b.x)], 1u);
        const unsigned gen = old / nloc;
        if (old + 1u == (gen + 1u) * nloc) {
            __builtin_amdgcn_fence(__ATOMIC_RELEASE, "agent");
            asm volatile("s_waitcnt vmcnt(0)" ::: "memory");
            const unsigned og = xb_add(&bar[XB_TOP], 1u);
            const unsigned tg = og / nx;
            if (og + 1u == (tg + 1u) * nx) xb_add(&bar[XB_TOPGEN], 1u);
            else XB_SPIN(xb_ld(&bar[XB_TOPGEN]) == tg, bar);
            __builtin_amdgcn_fence(__ATOMIC_ACQUIRE, "agent");
            xb_add(&bar[XB_XGEN(b.x)], 1u);
            asm volatile("s_waitcnt vmcnt(0)" ::: "memory");
        } else {
            XB_SPIN(xb_ld(&bar[XB_XGEN(b.x)]) == gen, bar);
            __builtin_amdgcn_fence(__ATOMIC_ACQUIRE, "agent");
            asm volatile("s_waitcnt vmcnt(0)" ::: "memory");
        }
    }
    __syncthreads();
}


struct Args { const float* in[35]; float* out; unsigned char* ws; int ph_lo, ph_hi; };
enum { I_X = 0, I_C, I_CTX, I_CCTX, I_ADAW, I_ADAB, I_NMIX, I_NFFN, I_W1, I_W3, I_W2, I_ABIN, I_ABCW, I_ABCB, I_DTBF, I_DTBB, I_ALF, I_ALB, I_SSDD, I_SSDNW,
       I_RLF, I_RLB, I_ABOUT, I_MLUP, I_MLCW, I_MLCB, I_MLWQ, I_MLWK, I_MLWV, I_MLGW, I_MLGB, I_MLNW, I_MLSKIP, I_MLDOWN, I_FNW };

__device__ __forceinline__ void transpose_item(const float* W, int ldw, int K, bf16* WT, int kb, int src_n0, int dst_n0, LAS float* scr, int lane) {
    const int k0 = 64 * kb;
#pragma unroll 8
    for (int i = 0; i < 32; ++i) { const int kk = 2 * i + (lane >> 5); scr[kk * 33 + (lane & 31)] = W[(size_t)(k0 + kk) * ldw + src_n0 + (lane & 31)]; }
    LDS_WAIT(); asm volatile("" ::: "memory");
    const int c = lane & 7;
#pragma unroll
    for (int j = 0; j < 4; ++j) { const int n = (lane >> 3) + 8 * j; const LAS float* s = scr + (8 * c) * 33 + n;
        v4u o; o.x = pk2(s[0 * 33], s[1 * 33]); o.y = pk2(s[2 * 33], s[3 * 33]); o.z = pk2(s[4 * 33], s[5 * 33]); o.w = pk2(s[6 * 33], s[7 * 33]);
        *(GAS v4u*)(WT + (size_t)(dst_n0 + n) * K + k0 + 8 * c) = o; }
    LDS_WAIT(); asm volatile("" ::: "memory");
}
__device__ __forceinline__ void conv_plain(const float* W, int K, int N, bf16* WT, LAS float* scr, int gw, int NGW, int lane) {
    const int nblk = N / 32, nit = (K / 64) * nblk;
    for (int it = gw; it < nit; it += NGW) { const int kb = it / nblk, nb = it % nblk; transpose_item(W, N, K, WT, kb, 32 * nb, 32 * nb, scr, lane); }
}
__device__ __forceinline__ void conv_ffn1(const float* w1, const float* w3, bf16* WT, LAS float* scr, int gw, int NGW, int lane) {
    const int nblk = 5632 / 32, nit = (1024 / 64) * nblk;
    for (int it = gw; it < nit; it += NGW) { const int kb = it / nblk, nb = it % nblk; const int n0 = 32 * nb, pn = n0 >> 8, within = n0 & 255;
        const float* W = within < 128 ? w1 : w3; const int sc = 128 * pn + (within & 127);
        transpose_item(W, FFH, 1024, WT, kb, sc, n0, scr, lane); }
}
__device__ __forceinline__ void conv_abin(const float* W, bf16* WT, LAS float* scr, int gw, int NGW, int lane) {
    const int nblk = 6144 / 32, nit = (1024 / 64) * nblk;
    for (int it = gw; it < nit; it += NGW) { const int kb = it / nblk, nb = it % nblk; const int n0 = 32 * nb;
        transpose_item(W, ABIN, 1024, WT, kb, n0 + (n0 >= 3072 ? 16 : 0), n0, scr, lane); }
}

template <bool WITH_DT>
__device__ __forceinline__ void norm_rows(const float* srcC, const float* srcL, const float* w, const float* mod, int si, bf16* dst, int dst_off, int row_lo, int row_hi,
                                          int gw, int NGW, int lane, const LAS float* wdt, float* dtraw) {
    for (int m = row_lo + gw; m < row_hi; m += NGW) {
        const float* src = m < RL0 ? srcC + (size_t)m * DM : srcL + (size_t)(m - RL0) * DM;
        const float* mv = mod + (size_t)(m < RL0 ? 0 : 1 + ((m - RL0) >> 13)) * 6144 + si * 1024;
        f32x4 v[4]; float ss = 0.f;
#pragma unroll
        for (int j = 0; j < 4; ++j) { v[j] = *(const f32x4*)(src + 4 * lane + 256 * j); ss += (v[j].x * v[j].x + v[j].y * v[j].y) + (v[j].z * v[j].z + v[j].w * v[j].w); }
        const float rstd = 1.0f / sqrtf(wave_sum(ss) * (1.f / DM) + RMS_EPS);
#pragma unroll
        for (int j = 0; j < 4; ++j) { const int c = 4 * lane + 256 * j; const f32x4 wv = *(const f32x4*)(w + c), sh = *(const f32x4*)(mv + c), sc = *(const f32x4*)(mv + 1024 + c);
            v[j] = (v[j] * rstd * wv) * (sc + 1.0f) + sh;
            v2u o; o.x = pk2(v[j].x, v[j].y); o.y = pk2(v[j].z, v[j].w);
            *(v2u*)(dst + (size_t)(m - dst_off) * DM + c) = o; }
        if constexpr (WITH_DT) {
            float d[16];
#pragma unroll
            for (int c = 0; c < 16; ++c) { float a = 0.f;
#pragma unroll
                for (int j = 0; j < 4; ++j) { const f32x4 ww = *(const LAS f32x4*)(wdt + c * 1024 + 4 * lane + 256 * j); a += v[j].x * ww.x + v[j].y * ww.y + v[j].z * ww.z + v[j].w * ww.w; }
                d[c] = a; asm volatile("" ::: "memory"); }
            float mine = 0.f;
#pragma unroll
            for (int c = 0; c < 16; ++c) { const float s = wave_sum(d[c]); if (lane == c) mine = s; }
            if (lane < 16) dtraw[(size_t)m * 16 + lane] = mine;
        }
    }
}


#define MFMA16(a, b, c) __builtin_amdgcn_mfma_f32_16x16x32_bf16(a, b, c, 0, 0, 0)
__device__ __forceinline__ bf16x8 frag_nat(const LAS unsigned char* base, int pitch, int r0, int k0, int lane) {
    return *(const LAS bf16x8*)(base + (r0 + (lane & 15)) * pitch + (k0 + 8 * (lane >> 4)) * 2);
}
__device__ __forceinline__ bf16x8 frag_tr(const LAS unsigned char* base, int pitch, int k0, int i0, int lane) {
    const int g = lane >> 4, q = (lane & 15) >> 2, p = lane & 3;
    const LAS unsigned char* a = base + (k0 + 8 * g + q) * pitch + (i0 + 4 * p) * 2;
    const s16x4 lo = __builtin_bit_cast(s16x4, __builtin_amdgcn_ds_read_tr16_b64_v4i16((LAS s16x4*)a));
    const s16x4 hi = __builtin_bit_cast(s16x4, __builtin_amdgcn_ds_read_tr16_b64_v4i16((LAS s16x4*)(a + 4 * pitch)));
    bf16x8 r; r[0] = lo[0]; r[1] = lo[1]; r[2] = lo[2]; r[3] = lo[3]; r[4] = hi[0]; r[5] = hi[1]; r[6] = hi[2]; r[7] = hi[3]; return r;
}
__device__ __forceinline__ v2u pack4(f32x4 v) { v2u o; o.x = pk2(v.x, v.y); o.y = pk2(v.z, v.w); return o; }
__device__ __forceinline__ f32x4 unpack4(v2u w) { f32x4 r; r.x = bflo(w.x); r.y = bfhi(w.x); r.z = bflo(w.y); r.w = bfhi(w.y); return r; }
__device__ __forceinline__ v4u scale8(v4u x, float s) { v4u o; o.x = pk2(bflo(x.x) * s, bfhi(x.x) * s); o.y = pk2(bflo(x.y) * s, bfhi(x.y) * s); o.z = pk2(bflo(x.z) * s, bfhi(x.z) * s); o.w = pk2(bflo(x.w) * s, bfhi(x.w) * s); return o; }

__device__ __forceinline__ void chunk_rows(int ci, int& base, int& L) { if (ci < 2) { base = 256 * ci; L = 256; } else { base = RL0 + 512 * (ci - 2); L = 512; } }

__device__ __forceinline__ void conv8(const v4u (&x)[5], const float (&cw)[5][8], const float (&cb)[8], v4u& out) {
    float o[8];
#pragma unroll
    for (int c = 0; c < 8; ++c) o[c] = cb[c];
#pragma unroll
    for (int k = 0; k < 5; ++k) { const v4u v = x[k];
        o[0] += cw[k][0] * bflo(v.x); o[1] += cw[k][1] * bfhi(v.x); o[2] += cw[k][2] * bflo(v.y); o[3] += cw[k][3] * bfhi(v.y);
        o[4] += cw[k][4] * bflo(v.z); o[5] += cw[k][5] * bfhi(v.z); o[6] += cw[k][6] * bflo(v.w); o[7] += cw[k][7] * bfhi(v.w); }
#pragma unroll
    for (int c = 0; c < 8; ++c) o[c] = silu_f(o[c]);
    out.x = pk2(o[0], o[1]); out.y = pk2(o[2], o[3]); out.z = pk2(o[4], o[5]); out.w = pk2(o[6], o[7]);
}
__device__ __forceinline__ void phase_l0_prep(const Args& args, unsigned char* ws, LAS unsigned char* lds, int tid, int lane, int wave, int bx, int G, int gw, int NGW) {
    bf16* XBC = (bf16*)(ws + WS_XBC); const bf16* HALO = (const bf16*)(ws + WS_HALO);
    {
        const int cg = tid & 255, c0 = 8 * cg;
        float cw[5][8], cb[8];
#pragma unroll
        for (int k = 0; k < 5; ++k)
#pragma unroll
            for (int c = 0; c < 8; ++c) cw[k][c] = args.in[I_ABCW][k * 2048 + c0 + c];
#pragma unroll
        for (int c = 0; c < 8; ++c) cb[c] = args.in[I_ABCB][c0 + c];
        for (int u = bx; u < 264; u += G) {
            const int blk = 2 * u + (tid >> 8), r0 = 32 * blk;
            int slo, shi; if (r0 < RL0) { slo = r0 & ~255; shi = slo + 256; } else { slo = RL0 + ((r0 - RL0) & ~8191); shi = slo + 8192; }
            const v4u zero = (v4u){0u, 0u, 0u, 0u};
            v4u raw[20];
            raw[0] = r0 > slo ? *(const v4u*)(HALO + ((size_t)(blk - 1) * 4 + 2) * 2048 + c0) : zero;
            raw[1] = r0 > slo ? *(const v4u*)(HALO + ((size_t)(blk - 1) * 4 + 3) * 2048 + c0) : zero;
#pragma unroll
            for (int t = 0; t < 18; ++t) raw[2 + t] = *(const v4u*)(XBC + (size_t)(r0 + t) * 2048 + c0);
#pragma unroll
            for (int t = 0; t < 16; ++t) { v4u x5[5] = {raw[t], raw[t + 1], raw[t + 2], raw[t + 3], raw[t + 4]}; v4u o; conv8(x5, cw, cb, o); *(v4u*)(XBC + (size_t)(r0 + t) * 2048 + c0) = o; }
            raw[0] = raw[16]; raw[1] = raw[17]; raw[2] = raw[18]; raw[3] = raw[19];
#pragma unroll
            for (int t = 0; t < 14; ++t) raw[4 + t] = *(const v4u*)(XBC + (size_t)(r0 + 18 + t) * 2048 + c0);
            raw[18] = r0 + 32 < shi ? *(const v4u*)(HALO + ((size_t)(blk + 1) * 4 + 0) * 2048 + c0) : zero;
            raw[19] = r0 + 32 < shi ? *(const v4u*)(HALO + ((size_t)(blk + 1) * 4 + 1) * 2048 + c0) : zero;
#pragma unroll
            for (int t = 0; t < 16; ++t) { v4u x5[5] = {raw[t], raw[t + 1], raw[t + 2], raw[t + 3], raw[t + 4]}; v4u o; conv8(x5, cw, cb, o); *(v4u*)(XBC + (size_t)(r0 + 16 + t) * 2048 + c0) = o; }
        }
    }
    {
        bf16* QK = (bf16*)(ws + WS_QK);
        const float inv = exp2f(-(float)(lane & 31) * (13.287712379549449f / 32.0f));
        for (int m = gw; m < R; m += NGW) {
            bf16* row = QK + (size_t)m * 1024;
            float cs = 1.f, sn = 0.f;
            if (m >= RL0) { const int t = (m - RL0) & 8191; const float ang = (float)(lane < 32 ? (t >> 6) : (t & 63)) * inv; sincosf(ang, &sn, &cs); }
#pragma unroll
            for (int hh = 0; hh < 8; ++hh) { const float x1 = bf2f(row[128 * hh + lane]), x2 = bf2f(row[128 * hh + 64 + lane]); const float sc = hh >= 4 ? 0.08838834764831845f : 1.0f;
                row[128 * hh + lane] = (bf16)f2bf((x1 * cs - x2 * sn) * sc); row[128 * hh + 64 + lane] = (bf16)f2bf((x1 * sn + x2 * cs) * sc); }
        }
    }
    {
        const float* dtraw = (const float*)(ws + WS_DTRAW); float* DTF = (float*)(ws + WS_DTF); float* DTB = (float*)(ws + WS_DTB); float* CSF = (float*)(ws + WS_CSF); float* RBA = (float*)(ws + WS_RB);
        for (int wu = gw; wu < 34 * 16; wu += NGW) {
            const int ci = wu >> 4, h = wu & 15; int base, L; chunk_rows(ci, base, L);
            const float bf_ = args.in[I_DTBF][h], bb_ = args.in[I_DTBB][h], af = __expf(args.in[I_ALF][h]), ab = __expf(args.in[I_ALB][h]);
            const int per = L >> 6, t0 = lane * per;
            float dtf[8], dtb[8], laf[8], lab[8]; float sf = 0.f, sb = 0.f;
#pragma unroll
            for (int t = 0; t < 8; ++t) if (t < per) { const float rawv = dtraw[(size_t)(base + t0 + t) * 16 + h]; dtf[t] = softplus_f(rawv + bf_); dtb[t] = softplus_f(rawv + bb_); laf[t] = -dtf[t] * af; lab[t] = -dtb[t] * ab; sf += laf[t]; sb += lab[t]; }
            float pf = sf, pb = sb;
#pragma unroll
            for (int o = 1; o < 64; o <<= 1) { const float a = __shfl_up(pf, o), c = __shfl_down(pb, o); if (lane >= o) pf += a; if (lane + o < 64) pb += c; }
            float runf = pf - sf;
#pragma unroll
            for (int t = 0; t < 8; ++t) if (t < per) { runf += laf[t]; const size_t o = (size_t)(base + t0 + t) * 16 + h; CSF[o] = runf; DTF[o] = dtf[t]; DTB[o] = dtb[t]; }
            float runb = pb - sb;
#pragma unroll
            for (int t = 7; t >= 0; --t) if (t < per) { runb += lab[t]; RBA[(size_t)(base + t0 + t) * 16 + h] = runb; }
        }
    }
}

constexpr int SCAN_PITCH = 144;
__device__ __forceinline__ void phase_l0_scan(const Args& args, unsigned char* ws, unsigned char* dob, LAS unsigned char* lds, int tid, int lane, int wave, int bx, int G) {
    LAS unsigned char* Kt = lds; LAS unsigned char* Vt = lds + 128 * SCAN_PITCH; LAS float* TB = (LAS float*)(lds + 256 * SCAN_PITCH);
    const float* DTF = (const float*)(ws + WS_DTF); const float* DTB = (const float*)(ws + WS_DTB); const float* CSF = (const float*)(ws + WS_CSF); const float* RBA = (const float*)(ws + WS_RB);
    for (int u = bx; u < 256; u += G) {
        const bool ssd = u < 128; int b, dir, h; const bf16* Ksrc; const bf16* Vsrc; int ld; bf16* Sout; float lg = 0.f;
        if (ssd) { const int s = u >> 1, nt = u & 1; b = s >> 5; dir = (s >> 4) & 1; h = s & 15; ld = 2048;
            Ksrc = (const bf16*)(ws + WS_XBC) + 1024 + 128 * (h >> 2) + 64 * nt; Vsrc = (const bf16*)(ws + WS_XBC) + 64 * h;
            Sout = (bf16*)(dob + DO_ST_SSD) + (size_t)s * 16 * 8192 + 64 * nt; }
        else { const int v = u - 128, s = v >> 3, t = v & 7, et = t >> 1, dt = t & 1; b = s >> 3; dir = (s >> 2) & 1; h = s & 3; ld = 1024;
            Ksrc = (const bf16*)(ws + WS_QK) + 512 + 128 * h + 64 * dt; Vsrc = (const bf16*)(ws + WS_V) + 256 * h + 64 * et;
            Sout = (bf16*)(dob + DO_ST_RET) + (size_t)s * 16 * 32768 + (size_t)(64 * et) * 128 + 64 * dt;
            lg = logsig_f(args.in[dir ? I_RLB : I_RLF][h]); }
        const size_t kstride = ssd ? 8192 : 32768;
        const int wd = wave & 3, we = wave >> 2;
        __syncthreads();
        if (tid < 17) { const int stp = tid; int base, L; if (stp == 0) { base = 256 * b; L = 256; } else { const int k = dir ? 16 - stp : stp - 1; base = RL0 + 8192 * b + 512 * k; L = 512; }
            float wref = 0.f, A;
            if (ssd) { wref = dir ? RBA[(size_t)base * 16 + h] : CSF[(size_t)(base + L - 1) * 16 + h]; A = __expf(wref); } else A = __expf((float)L * lg);
            TB[stp] = wref; TB[32 + stp] = A; }
        __syncthreads();
        f32x4 acc[2] = {(f32x4){0.f, 0.f, 0.f, 0.f}, (f32x4){0.f, 0.f, 0.f, 0.f}};
        const int srow = tid >> 2, sc16 = tid & 3;
        const bf16* kp = Ksrc + 16 * sc16; const bf16* vp = Vsrc + 16 * sc16;
#define L0S_STP(si) ((si) < 2 ? 0 : 1 + (((si) - 2) >> 2))
#define L0S_LOAD(si, K0, K1, V0, V1, W) do { const int stp_ = L0S_STP(si), t0_ = (si) < 2 ? 128 * (si) : 128 * (((si) - 2) & 3); int r_, L_; \
            if (stp_ == 0) { r_ = 256 * b + t0_ + srow; L_ = 256; } else { const int kq_ = dir ? 16 - stp_ : stp_ - 1; r_ = RL0 + 8192 * b + 512 * kq_ + t0_ + srow; L_ = 512; } \
            const int jl_ = t0_ + srow; \
            if (ssd) W = dir ? __expf(TB[stp_] - RBA[(size_t)r_ * 16 + h]) * DTB[(size_t)r_ * 16 + h] : __expf(TB[stp_] - CSF[(size_t)r_ * 16 + h]) * DTF[(size_t)r_ * 16 + h]; \
            else W = dir ? __expf((float)jl_ * lg) : __expf((float)(L_ - 1 - jl_) * lg); \
            K0 = *(const v4u*)(kp + (size_t)r_ * ld); K1 = *(const v4u*)(kp + (size_t)r_ * ld + 8); V0 = *(const v4u*)(vp + (size_t)r_ * ld); V1 = *(const v4u*)(vp + (size_t)r_ * ld + 8); } while (0)
#define L0S_STORE(kidx) do { _Pragma("unroll") for (int t2 = 0; t2 < 2; ++t2) { const int e = 32 * we + 16 * t2 + (lane & 15), d = 16 * wd + 4 * (lane >> 4); \
            *(v2u*)(Sout + (size_t)(kidx) * kstride + (size_t)e * 128 + d) = pack4(acc[t2]); } } while (0)
#define L0S_STEP(si, K0, K1, V0, V1, W) do { const int stp_ = L0S_STP(si); \
            if ((si) == 0 || ((si) >= 2 && (((si) - 2) & 3) == 0)) { if (stp_ >= 1) L0S_STORE(dir ? 16 - stp_ : stp_ - 1); const float A_ = TB[32 + stp_]; acc[0] = acc[0] * A_; acc[1] = acc[1] * A_; } \
            __syncthreads(); \
            *(LAS v4u*)(Kt + srow * SCAN_PITCH + 32 * sc16) = scale8(K0, W); *(LAS v4u*)(Kt + srow * SCAN_PITCH + 32 * sc16 + 16) = scale8(K1, W); \
            *(LAS v4u*)(Vt + srow * SCAN_PITCH + 32 * sc16) = V0; *(LAS v4u*)(Vt + srow * SCAN_PITCH + 32 * sc16 + 16) = V1; \
            __syncthreads(); \
            if ((si) + 4 < 62) L0S_LOAD((si) + 4, K0, K1, V0, V1, W); \
            _Pragma("unroll") for (int kk = 0; kk < 4; ++kk) { const bf16x8 a = frag_tr(Kt, SCAN_PITCH, 32 * kk, 16 * wd, lane); \
                _Pragma("unroll") for (int t2 = 0; t2 < 2; ++t2) { const bf16x8 bb = frag_tr(Vt, SCAN_PITCH, 32 * kk, 32 * we + 16 * t2, lane); acc[t2] = MFMA16(a, bb, acc[t2]); } } } while (0)
        v4u ka0, ka1, va0, va1, kb0, kb1, vb0, vb1, kc0, kc1, vc0, vc1, kd0, kd1, vd0, vd1; float wa, wb, wc, wd_;
        L0S_LOAD(0, ka0, ka1, va0, va1, wa); L0S_LOAD(1, kb0, kb1, vb0, vb1, wb); L0S_LOAD(2, kc0, kc1, vc0, vc1, wc); L0S_LOAD(3, kd0, kd1, vd0, vd1, wd_);
#pragma unroll 1
        for (int si = 0; si < 60; si += 4) { L0S_STEP(si, ka0, ka1, va0, va1, wa); L0S_STEP(si + 1, kb0, kb1, vb0, vb1, wb); L0S_STEP(si + 2, kc0, kc1, vc0, vc1, wc); L0S_STEP(si + 3, kd0, kd1, vd0, vd1, wd_); }
        L0S_STEP(60, ka0, ka1, va0, va1, wa); L0S_STEP(61, kb0, kb1, vb0, vb1, wb);
        L0S_STORE(dir ? 0 : 15);
#undef L0S_STP
#undef L0S_LOAD
#undef L0S_STORE
#undef L0S_STEP
    }
    __syncthreads();
}


constexpr int Y_KT = 0, Y_VT = 17408, Y_MT = 51200, Y_SC = 69632, Y_ST = 73728;
constexpr int P272 = 272, P528 = 528, P144 = 144;
__device__ __forceinline__ void phase_l0_y(const Args& args, unsigned char* ws, unsigned char* dob, LAS unsigned char* lds, int tid0, int lane0, int wave, int bx, int G, bool dry = false) {
    LAS unsigned char* Kt = lds + Y_KT; LAS unsigned char* Vt = lds + Y_VT; LAS unsigned char* Mt = lds + Y_MT; LAS float* SC = (LAS float*)(lds + Y_SC); LAS unsigned char* St = lds + Y_ST;
    bf16* ZG = (bf16*)(ws + WS_ZG); const bf16* XBC = (const bf16*)(ws + WS_XBC); const bf16* QK = (const bf16*)(ws + WS_QK); const bf16* VV = (const bf16*)(ws + WS_V);
    const float* DTF = (const float*)(ws + WS_DTF); const float* DTB = (const float*)(ws + WS_DTB); const float* CSF = (const float*)(ws + WS_CSF); const float* RBA = (const float*)(ws + WS_RB);
    for (int u = bx; u < 1056; u += G) {
        int tid = tid0, lane = lane0; asm volatile("" : "+v"(tid), "+v"(lane));
        const int fr = lane & 15, fq = lane >> 4;
        bool ssd; int grp, b, rbk;
        if (u < 1024) { ssd = u < 512; const int idx = u & 511; grp = idx & 3; const int br = idx >> 2; b = br >> 6; rbk = 2 + (br & 63); }
        else { const int idx = u - 1024; ssd = idx < 16; const int i2 = idx & 15; grp = i2 & 3; b = (i2 >> 2) & 1; rbk = i2 >> 3; }
        int cb0, L, i0, kchunk = -1;
        if (rbk < 2) { cb0 = 256 * b; L = 256; i0 = 128 * rbk; } else { const int lk = rbk - 2; kchunk = lk >> 2; cb0 = RL0 + 8192 * b + 512 * kchunk; L = 512; i0 = 128 * (lk & 3); }
        const int il = i0 + 16 * wave + fr;
        const int row = cb0 + il;
        const int nkb = L >> 6;
        if (ssd) {
            const int g = grp;
            bf16x8 cf[4];
#pragma unroll
            for (int kk = 0; kk < 4; ++kk) cf[kk] = *(const bf16x8*)(XBC + (size_t)row * 2048 + 1536 + 128 * g + 32 * kk + 8 * fq);
            float csi[4], rbi[4];
#pragma unroll
            for (int hh = 0; hh < 4; ++hh) { csi[hh] = CSF[(size_t)row * 16 + 4 * g + hh]; rbi[hh] = RBA[(size_t)row * 16 + 4 * g + hh]; }
            f32x4 acc[4][4];
#pragma unroll
            for (int hh = 0; hh < 4; ++hh)
#pragma unroll
                for (int pt = 0; pt < 4; ++pt) acc[hh][pt] = (f32x4){0.f, 0.f, 0.f, 0.f};
            const int Rw = (i0 >> 4) + wave;
            v4u pk[2], pv[4];
#define SSD_LOAD(kbv) do { const int krow0_ = cb0 + 64 * (kbv); \
                _Pragma("unroll") for (int c = 0; c < 2; ++c) { const int ch = tid + 512 * c, r = ch >> 4, cc = ch & 15; pk[c] = *(const v4u*)(XBC + (size_t)(krow0_ + r) * 2048 + 1024 + 128 * g + 8 * cc); } \
                _Pragma("unroll") for (int c = 0; c < 4; ++c) { const int ch = tid + 512 * c, r = ch >> 5, cc = ch & 31; pv[c] = *(const v4u*)(XBC + (size_t)(krow0_ + r) * 2048 + 256 * g + 8 * cc); } \
                } while (0)
            SSD_LOAD(0);
            for (int kb = 0; kb < nkb; ++kb) {
                __syncthreads();
#pragma unroll
                for (int c = 0; c < 2; ++c) { const int ch = tid + 512 * c, r = ch >> 4, cc = ch & 15; *(LAS v4u*)(Kt + r * P272 + 16 * cc) = pk[c]; }
#pragma unroll
                for (int c = 0; c < 4; ++c) { const int ch = tid + 512 * c, r = ch >> 5, cc = ch & 31; *(LAS v4u*)(Vt + r * P528 + 16 * cc) = pv[c]; }
                if (tid < 256) { const int r = tid >> 2, hh = tid & 3; const size_t o = (size_t)(cb0 + 64 * kb + r) * 16 + 4 * g + hh; SC[0 * 256 + hh * 64 + r] = CSF[o]; SC[1 * 256 + hh * 64 + r] = RBA[o]; SC[2 * 256 + hh * 64 + r] = DTF[o]; SC[3 * 256 + hh * 64 + r] = DTB[o]; }
                __syncthreads();
                if (kb + 1 < nkb) SSD_LOAD(kb + 1);
                f32x4 Gt[4];
#pragma unroll
                for (int t = 0; t < 4; ++t) { Gt[t] = (f32x4){0.f, 0.f, 0.f, 0.f};
#pragma unroll
                    for (int kk = 0; kk < 4; ++kk) Gt[t] = MFMA16(frag_nat(Kt, P272, 16 * t, 32 * kk, lane), cf[kk], Gt[t]); }
#pragma unroll
                for (int hh = 0; hh < 4; ++hh) {
#pragma unroll
                    for (int t = 0; t < 4; ++t) { f32x4 m; const int T = 4 * kb + t; const int so = hh * 64 + 16 * t + 4 * fq;
                        if (T < Rw) { const f32x4 csj = *(const LAS f32x4*)(SC + so), dtj = *(const LAS f32x4*)(SC + 512 + so);
#pragma unroll
                            for (int r = 0; r < 4; ++r) m[r] = Gt[t][r] * __expf(csi[hh] - csj[r]) * dtj[r]; }
                        else if (T > Rw) { const f32x4 rbj = *(const LAS f32x4*)(SC + 256 + so), dtj = *(const LAS f32x4*)(SC + 768 + so);
#pragma unroll
                            for (int r = 0; r < 4; ++r) m[r] = Gt[t][r] * __expf(rbi[hh] - rbj[r]) * dtj[r]; }
                        else { const f32x4 csj = *(const LAS f32x4*)(SC + so), rbj = *(const LAS f32x4*)(SC + 256 + so), dfj = *(const LAS f32x4*)(SC + 512 + so), dbj = *(const LAS f32x4*)(SC + 768 + so);
#pragma unroll
                            for (int r = 0; r < 4; ++r) { const int jj = 4 * fq + r;
                                const float x = jj < fr ? csi[hh] - csj[r] : (jj > fr ? rbi[hh] - rbj[r] : 0.f);
                                const float sv = jj < fr ? dfj[r] : (jj > fr ? dbj[r] : dfj[r] + dbj[r]);
                                m[r] = Gt[t][r] * __expf(x) * sv; } }
                        *(LAS v2u*)(Mt + (16 * wave + fr) * P144 + (16 * t + 4 * fq) * 2) = pack4(m); }
                    LDS_WAIT();
#pragma unroll
                    for (int kk2 = 0; kk2 < 2; ++kk2) { const bf16x8 mb = frag_nat(Mt, P144, 16 * wave, 32 * kk2, lane);
#pragma unroll
                        for (int pt = 0; pt < 4; ++pt) acc[hh][pt] = MFMA16(frag_tr(Vt, P528, 32 * kk2, 64 * hh + 16 * pt, lane), mb, acc[hh][pt]); }
                }
            }
#undef SSD_LOAD
            if (kchunk >= 0) {
#pragma unroll 1
                for (int hh = 0; hh < 4; ++hh) {
                    const int h = 4 * g + hh;
                    __syncthreads();
#pragma unroll
                    for (int dir = 0; dir < 2; ++dir) { const bf16* S = (const bf16*)(dob + DO_ST_SSD) + ((size_t)(b * 32 + dir * 16 + h) * 16 + kchunk) * 8192;
#pragma unroll
                        for (int c = 0; c < 2; ++c) { const int ch = tid + 512 * c, r = ch >> 4, cc = ch & 15; *(LAS v4u*)(St + dir * 17408 + r * P272 + 16 * cc) = *(const v4u*)(S + r * 128 + 8 * cc); } }
                    __syncthreads();
                    float Ei[2] = {__expf(csi[0]), __expf(rbi[0])};
                    if (hh == 1) { Ei[0] = __expf(csi[1]); Ei[1] = __expf(rbi[1]); } else if (hh == 2) { Ei[0] = __expf(csi[2]); Ei[1] = __expf(rbi[2]); } else if (hh == 3) { Ei[0] = __expf(csi[3]); Ei[1] = __expf(rbi[3]); }
#pragma unroll
                    for (int dir = 0; dir < 2; ++dir)
#pragma unroll
                        for (int pt = 0; pt < 4; ++pt) { f32x4 T = (f32x4){0.f, 0.f, 0.f, 0.f};
#pragma unroll
                            for (int kk = 0; kk < 4; ++kk) T = MFMA16(frag_nat(St + dir * 17408, P272, 16 * pt, 32 * kk, lane), cf[kk], T);
                            const f32x4 add = T * Ei[dir];
                            if (hh == 0) acc[0][pt] += add; else if (hh == 1) acc[1][pt] += add; else if (hh == 2) acc[2][pt] += add; else acc[3][pt] += add; }
                }
            }
            float ssq = 0.f;
#pragma unroll
            for (int hh = 0; hh < 4; ++hh) { const float dsk = args.in[I_SSDD][4 * g + hh];
#pragma unroll
                for (int pt = 0; pt < 4; ++pt) { const int ch = 256 * g + 64 * hh + 16 * pt + 4 * fq;
                    const f32x4 xs = unpack4(*(const v2u*)(XBC + (size_t)row * 2048 + ch)), zz = unpack4(*(const v2u*)(ZG + (size_t)row * 2048 + ch));
                    f32x4 y = acc[hh][pt] + xs * dsk;
                    y.x *= silu_f(zz.x); y.y *= silu_f(zz.y); y.z *= silu_f(zz.z); y.w *= silu_f(zz.w);
                    acc[hh][pt] = y; ssq += (y.x * y.x + y.y * y.y) + (y.z * y.z + y.w * y.w); } }
            ssq += __shfl_xor(ssq, 16); ssq += __shfl_xor(ssq, 32);
            const float rstd = 1.0f / sqrtf(ssq * (1.f / 256.f) + RMS_EPS);
#pragma unroll
            for (int hh = 0; hh < 4; ++hh)
#pragma unroll
                for (int pt = 0; pt < 4; ++pt) { const int ch = 256 * g + 64 * hh + 16 * pt + 4 * fq; const f32x4 nw = *(const f32x4*)(args.in[I_SSDNW] + ch);
                    if (!dry) *(v2u*)(ZG + (size_t)row * 2048 + ch) = pack4(acc[hh][pt] * rstd * nw); }
        } else {
            const int h = grp;
            const float lgf = logsig_f(args.in[I_RLF][h]), lgb = logsig_f(args.in[I_RLB][h]);
            bf16x8 qf[4];
#pragma unroll
            for (int kk = 0; kk < 4; ++kk) qf[kk] = *(const bf16x8*)(QK + (size_t)row * 1024 + 128 * h + 32 * kk + 8 * fq);
            f32x4 acc[16];
#pragma unroll
            for (int et = 0; et < 16; ++et) acc[et] = (f32x4){0.f, 0.f, 0.f, 0.f};
            const int Rw = (i0 >> 4) + wave;
            v4u pk[2], pv[4];
#define RET_LOAD(kbv) do { const int krow0_ = cb0 + 64 * (kbv); \
                _Pragma("unroll") for (int c = 0; c < 2; ++c) { const int ch = tid + 512 * c, r = ch >> 4, cc = ch & 15; pk[c] = *(const v4u*)(QK + (size_t)(krow0_ + r) * 1024 + 512 + 128 * h + 8 * cc); } \
                _Pragma("unroll") for (int c = 0; c < 4; ++c) { const int ch = tid + 512 * c, r = ch >> 5, cc = ch & 31; pv[c] = *(const v4u*)(VV + (size_t)(krow0_ + r) * 1024 + 256 * h + 8 * cc); } } while (0)
            RET_LOAD(0);
            for (int kb = 0; kb < nkb; ++kb) {
                __syncthreads();
#pragma unroll
                for (int c = 0; c < 2; ++c) { const int ch = tid + 512 * c, r = ch >> 4, cc = ch & 15; *(LAS v4u*)(Kt + r * P272 + 16 * cc) = pk[c]; }
#pragma unroll
                for (int c = 0; c < 4; ++c) { const int ch = tid + 512 * c, r = ch >> 5, cc = ch & 31; *(LAS v4u*)(Vt + r * P528 + 16 * cc) = pv[c]; }
                __syncthreads();
                if (kb + 1 < nkb) RET_LOAD(kb + 1);
#pragma unroll
                for (int t = 0; t < 4; ++t) { f32x4 Gt = (f32x4){0.f, 0.f, 0.f, 0.f};
#pragma unroll
                    for (int kk = 0; kk < 4; ++kk) Gt = MFMA16(frag_nat(Kt, P272, 16 * t, 32 * kk, lane), qf[kk], Gt);
                    f32x4 m; const int T = 4 * kb + t;
#pragma unroll
                    for (int r = 0; r < 4; ++r) { const int j = 64 * kb + 16 * t + 4 * fq + r;
                        float f;
                        if (T < Rw) f = __expf((float)(il - j) * lgf); else if (T > Rw) f = __expf((float)(j - il) * lgb);
                        else f = j < il ? __expf((float)(il - j) * lgf) : (j > il ? __expf((float)(j - il) * lgb) : 2.0f);
                        m[r] = Gt[r] * f; }
                    *(LAS v2u*)(Mt + (16 * wave + fr) * P144 + (16 * t + 4 * fq) * 2) = pack4(m); }
                LDS_WAIT();
#pragma unroll
                for (int kk2 = 0; kk2 < 2; ++kk2) { const bf16x8 mb = frag_nat(Mt, P144, 16 * wave, 32 * kk2, lane);
#pragma unroll
                    for (int et = 0; et < 16; ++et) acc[et] = MFMA16(frag_tr(Vt, P528, 32 * kk2, 16 * et, lane), mb, acc[et]); }
            }
#undef RET_LOAD
            if (kchunk >= 0) {
#pragma unroll 1
                for (int dir = 0; dir < 2; ++dir) {
                    const bf16* S = (const bf16*)(dob + DO_ST_RET) + (size_t)__builtin_amdgcn_readfirstlane(((b * 8 + dir * 4 + h) * 16 + kchunk)) * 32768;
                    __syncthreads();
#pragma unroll
                    for (int c = 0; c < 8; ++c) { const int ch = tid + 512 * c, r = ch >> 4, cc = ch & 15; *(LAS v4u*)(St + r * P272 + 16 * cc) = *(const v4u*)(S + r * 128 + 8 * cc); }
                    __syncthreads();
                    const float Ei = dir ? __expf((float)(L - il) * lgb) : __expf((float)(il + 1) * lgf);
#pragma unroll
                    for (int et = 0; et < 16; ++et) { f32x4 T = (f32x4){0.f, 0.f, 0.f, 0.f};
#pragma unroll
                        for (int kk = 0; kk < 4; ++kk) T = MFMA16(frag_nat(St, P272, 16 * et, 32 * kk, lane), qf[kk], T);
                        acc[et] += T * Ei; }
                }
            }
            float sm = 0.f;
#pragma unroll
            for (int et = 0; et < 16; ++et) sm += (acc[et].x + acc[et].y) + (acc[et].z + acc[et].w);
            sm += __shfl_xor(sm, 16); sm += __shfl_xor(sm, 32);
            const float mean = sm * (1.f / 256.f); float sq = 0.f;
#pragma unroll
            for (int et = 0; et < 16; ++et) { acc[et] = acc[et] - mean; sq += (acc[et].x * acc[et].x + acc[et].y * acc[et].y) + (acc[et].z * acc[et].z + acc[et].w * acc[et].w); }
            sq += __shfl_xor(sq, 16); sq += __shfl_xor(sq, 32);
            const float rstd = 1.0f / sqrtf(sq * (1.f / 256.f) + LN_EPS);
#pragma unroll
            for (int et = 0; et < 16; ++et) { const int ch = 1024 + 256 * h + 16 * et + 4 * fq; const f32x4 gg = unpack4(*(const v2u*)(ZG + (size_t)row * 2048 + ch));
                f32x4 y = acc[et] * rstd; y.x *= silu_f(gg.x); y.y *= silu_f(gg.y); y.z *= silu_f(gg.z); y.w *= silu_f(gg.w);
                if (!dry) *(v2u*)(ZG + (size_t)row * 2048 + ch) = pack4(y); }
        }
        __syncthreads();
    }
}


constexpr size_t WS_GWT = 7 * MiB;
constexpr size_t WS_MIN = 7 * MiB + 256 * 1024;
__device__ __forceinline__ int xc_row(int r, int b) { return r < RL0 ? r - 256 * b : 256 + (r - RL0 - 8192 * b); }
__device__ __forceinline__ void bw8(const float (&x)[8], const float* w  , float (&o)[8]) {
#pragma unroll
    for (int bl = 0; bl < 2; ++bl)
#pragma unroll
        for (int e = 0; e < 4; ++e) o[4 * bl + e] = x[4 * bl] * w[16 * bl + e] + x[4 * bl + 1] * w[16 * bl + 4 + e] + x[4 * bl + 2] * w[16 * bl + 8 + e] + x[4 * bl + 3] * w[16 * bl + 12 + e];
}
__device__ __forceinline__ void unpack8(v4u v, float (&o)[8]) { o[0] = bflo(v.x); o[1] = bfhi(v.x); o[2] = bflo(v.y); o[3] = bfhi(v.y); o[4] = bflo(v.z); o[5] = bfhi(v.z); o[6] = bflo(v.w); o[7] = bfhi(v.w); }
__device__ __forceinline__ v4u pack8(const float (&o)[8]) { v4u r; r.x = pk2(o[0], o[1]); r.y = pk2(o[2], o[3]); r.z = pk2(o[4], o[5]); r.w = pk2(o[6], o[7]); return r; }

constexpr size_t WS_GVT = WS_GWT + 65536;
__device__ __forceinline__ void phase_l1_prep(const Args& args, unsigned char* ws, LAS unsigned char* lds, int tid, int lane, int wave, int bx, int G, int b) {
    const bf16* XM = (const bf16*)(ws + WS_XM); bf16* XC = (bf16*)(ws + WS_XC); const bf16* GXT = (const bf16*)(ws + WS_GWT); const bf16* GVT = (const bf16*)(ws + WS_GVT); float* GATE = (float*)(ws + WS_GATE);
    const float* cwp = args.in[I_MLCW]; const float* cbp = args.in[I_MLCB];
    constexpr int PT = 4112;
    LAS float* GL = (LAS float*)(lds + 20 * PT);
    const int fr = lane & 15, fq = lane >> 4;
    for (int u = bx; u < 528; u += G) {
        const int tb = u < 16 ? 256 * b + 16 * u : RL0 + 8192 * b + 16 * (u - 16);
        const int slo = u < 16 ? 256 * b : RL0 + 8192 * b, shi = u < 16 ? slo + 256 : slo + 8192;
        __syncthreads();
#pragma unroll
        for (int c = 0; c < 10; ++c) { const int ch = tid + 512 * c, rr = ch >> 8, cc = ch & 255; const int grow = tb - 2 + rr;
            v4u v = (v4u){0u, 0u, 0u, 0u}; if (grow >= slo && grow < shi) v = *(const v4u*)(XM + (size_t)grow * 2048 + 8 * cc);
            *(LAS v4u*)(lds + rr * PT + 16 * cc) = v; }
        __syncthreads();
        const int r = tb + fr, xr = xc_row(r, b);
        f32x4 gacc = (f32x4){0.f, 0.f, 0.f, 0.f};
#pragma unroll 2
        for (int c32 = 0; c32 < 8; ++c32) {
            const int cb = 256 * wave + 32 * c32 + 8 * fq;
            v4u xw[5];
#pragma unroll
            for (int k = 0; k < 5; ++k) xw[k] = *(const LAS v4u*)(lds + (fr + k) * PT + 2 * cb);
            const bf16x8 gx = *(const bf16x8*)(GXT + (size_t)fr * 2048 + cb), gv = *(const bf16x8*)(GVT + (size_t)fr * 2048 + cb);
            f32x4 a0 = *(const f32x4*)(cbp + cb), a1 = *(const f32x4*)(cbp + cb + 4);
#pragma unroll
            for (int k = 0; k < 5; ++k) { const f32x4 w0 = *(const f32x4*)(cwp + k * 2048 + cb), w1 = *(const f32x4*)(cwp + k * 2048 + cb + 4); const v4u v = xw[k];
                a0.x += w0.x * bflo(v.x); a0.y += w0.y * bfhi(v.x); a0.z += w0.z * bflo(v.y); a0.w += w0.w * bfhi(v.y);
                a1.x += w1.x * bflo(v.z); a1.y += w1.y * bfhi(v.z); a1.z += w1.z * bflo(v.w); a1.w += w1.w * bfhi(v.w); }
            v4u xcp; xcp.x = pk2(silu_f(a0.x), silu_f(a0.y)); xcp.y = pk2(silu_f(a0.z), silu_f(a0.w)); xcp.z = pk2(silu_f(a1.x), silu_f(a1.y)); xcp.w = pk2(silu_f(a1.z), silu_f(a1.w));
            *(v4u*)(XC + (size_t)xr * 2048 + cb) = xcp;
            gacc = MFMA16(gx, __builtin_bit_cast(bf16x8, xcp), gacc); gacc = MFMA16(gv, __builtin_bit_cast(bf16x8, xw[2]), gacc);
        }
#pragma unroll
        for (int rr = 0; rr < 4; ++rr) GL[(wave * 16 + 4 * fq + rr) * 16 + fr] = gacc[rr];
        __syncthreads();
        if (tid < 256) { const int gt = tid >> 4, tk = tid & 15;
            float s = args.in[I_MLGB][gt];
#pragma unroll
            for (int q = 0; q < 8; ++q) s += GL[(q * 16 + gt) * 16 + tk];
            GATE[(size_t)(tb + tk) * 16 + gt] = s; }
    }
    __syncthreads();
}

__device__ __forceinline__ void phase_l1_gatescan(const Args& args, unsigned char* ws, LAS unsigned char* lds, int tid, int lane, int wave, int bx, int G, int gw, int NGW, int b) {
    const float* GATE = (const float*)(ws + WS_GATE); float* BC = (float*)(ws + WS_BC); float* AJ = (float*)(ws + WS_AJ); float* CM = (float*)(ws + WS_CM); float* CH = (float*)(ws + WS_CH);
    for (int wu = gw; wu < 8 * 17; wu += NGW) {
        const int sl = wu / 17, c17 = wu % 17, dir = sl >> 2, h = sl & 3;
        const int base = c17 == 0 ? 256 * b : RL0 + 8192 * b + 512 * (c17 - 1), L = c17 == 0 ? 256 : 512, per = L >> 6, t0 = lane * per;
        float fc[8], ic[8]; float s = 0.f;
#pragma unroll
        for (int t = 0; t < 8; ++t) if (t < per) { const size_t o = (size_t)(base + t0 + t) * 16; fc[t] = logsig_f(GATE[o + (dir ? 12 : 4) + h]); ic[t] = GATE[o + (dir ? 8 : 0) + h]; s += fc[t]; }
        float p = s;
#pragma unroll
        for (int o = 1; o < 64; o <<= 1) { const float up = __shfl_up(p, o), dn = __shfl_down(p, o); if (!dir) { if (lane >= o) p += up; } else { if (lane + o < 64) p += dn; } }
        const float total = dir ? __shfl(p, 0) : __shfl(p, 63);
        float run = p - s, a[8], bcv[8]; float mx = -3.0e38f;
        if (!dir) {
#pragma unroll
            for (int t = 0; t < 8; ++t) if (t < per) { run += fc[t]; bcv[t] = run; a[t] = ic[t] - run; mx = fmaxf(mx, a[t]); }
        } else {
#pragma unroll
            for (int t = 7; t >= 0; --t) if (t < per) { run += fc[t]; bcv[t] = run; a[t] = ic[t] - run; mx = fmaxf(mx, a[t]); }
        }
        float pm = mx;
#pragma unroll
        for (int o = 1; o < 64; o <<= 1) { const float up = __shfl_up(pm, o), dn = __shfl_down(pm, o); if (!dir) { if (lane >= o) pm = fmaxf(pm, up); } else { if (lane + o < 64) pm = fmaxf(pm, dn); } }
        const float cmax = dir ? __shfl(pm, 0) : __shfl(pm, 63);
        float excl = !dir ? __shfl_up(pm, 1) : __shfl_down(pm, 1);
        if ((!dir && lane == 0) || (dir && lane == 63)) excl = -3.0e38f;
        float rm = excl;
        if (!dir) {
#pragma unroll
            for (int t = 0; t < 8; ++t) if (t < per) { rm = fmaxf(rm, a[t]); const size_t o = (size_t)(base + t0 + t) * 8 + sl; BC[o] = bcv[t]; AJ[o] = a[t]; CM[o] = rm; }
        } else {
#pragma unroll
            for (int t = 7; t >= 0; --t) if (t < per) { rm = fmaxf(rm, a[t]); const size_t o = (size_t)(base + t0 + t) * 8 + sl; BC[o] = bcv[t]; AJ[o] = a[t]; CM[o] = rm; }
        }
        if (lane == 0) { CH[((b * 8 + sl) * 17 + c17) * 2] = total; CH[((b * 8 + sl) * 17 + c17) * 2 + 1] = cmax; }
    }
}

__device__ __forceinline__ void m_chain(const float* CH, int b, int sl, LAS float* m_in, LAS float* mul) {
    const int dir = sl >> 2; float m = 0.f;
    for (int step = 0; step < 17; ++step) { const int c17 = step == 0 ? 0 : (dir ? 17 - step : step); const float be = CH[((b * 8 + sl) * 17 + c17) * 2], cx = CH[((b * 8 + sl) * 17 + c17) * 2 + 1];
        const float mu = fmaxf(m, cx); m_in[step] = m; mul[step] = mu; m = be + mu; }
}

__device__ __forceinline__ void phase_l1_scan(const Args& args, unsigned char* ws, LAS unsigned char* lds, int tid, int lane, int wave, int bx, int G, int b) {
    const bf16* XM = (const bf16*)(ws + WS_XM); const bf16* XC = (const bf16*)(ws + WS_XC); const float* AJ = (const float*)(ws + WS_AJ); const float* CH = (const float*)(ws + WS_CH);
    bf16* ST = (bf16*)(ws + WS_ST1); float* NV = (float*)(ws + WS_NV);
    LAS unsigned char* Kt = lds; LAS unsigned char* Vt = lds + 128 * P144; LAS float* MS = (LAS float*)(lds + 128 * P144 + 128 * P272);
    const int fr = lane & 15, fq = lane >> 4, wd = wave & 3, we = wave >> 2;
    const bf16x8 ones = (bf16x8){(short)0x3F80, (short)0x3F80, (short)0x3F80, (short)0x3F80, (short)0x3F80, (short)0x3F80, (short)0x3F80, (short)0x3F80};
    for (int u = bx; u < 256; u += G) {
        const int sl = u >> 5, t = u & 31, et = t >> 3, dt = t & 7, dir = sl >> 2, h = sl & 3;
        __syncthreads();
        if (tid == 0) m_chain(CH, b, sl, MS, MS + 32);
        __syncthreads();
        if (t == 0 && tid < 17) ((float*)(ws + WS_MIN))[(b * 8 + sl) * 17 + tid] = MS[tid];
        f32x4 acc[4]; f32x4 nacc = (f32x4){0.f, 0.f, 0.f, 0.f};
#pragma unroll
        for (int i = 0; i < 4; ++i) acc[i] = (f32x4){0.f, 0.f, 0.f, 0.f};
        const int srow = tid >> 2, q4 = tid & 3;
        const bf16* xcb = XC + 512 * h + 64 * dt + 16 * q4; const bf16* xmb = XM + 512 * h + 128 * et + 32 * q4;
#define L1S_STP(si) ((si) < 2 ? 0 : 1 + (((si) - 2) >> 2))
#define L1S_LOAD(si, K0, K1, VV, W) do { const int stp_ = L1S_STP(si), t0_ = (si) < 2 ? 128 * (si) : 128 * (((si) - 2) & 3); int r_, xr_; \
            if (stp_ == 0) { r_ = 256 * b + t0_ + srow; xr_ = t0_ + srow; } else { const int kq_ = dir ? 16 - stp_ : stp_ - 1; r_ = RL0 + 8192 * b + 512 * kq_ + t0_ + srow; xr_ = 256 + 512 * kq_ + t0_ + srow; } \
            W = __expf(AJ[(size_t)r_ * 8 + sl] - MS[32 + stp_]); K0 = *(const v4u*)(xcb + (size_t)xr_ * 2048); K1 = *(const v4u*)(xcb + (size_t)xr_ * 2048 + 8); \
            _Pragma("unroll") for (int c = 0; c < 4; ++c) VV[c] = *(const v4u*)(xmb + (size_t)r_ * 2048 + 8 * c); } while (0)
#define L1S_STORE(kidx) do { bf16* So = ST + ((size_t)(sl * 16 + (kidx)) * 512) * 512; \
            _Pragma("unroll") for (int t4 = 0; t4 < 4; ++t4) { const int e = 128 * et + 64 * we + 16 * t4 + fr, d = 64 * dt + 16 * wd + 4 * fq; *(v2u*)(So + (size_t)e * 512 + d) = pack4(acc[t4]); } \
            if (et == 0 && we == 0 && fr == 0) *(f32x4*)(NV + (size_t)(sl * 16 + (kidx)) * 512 + 64 * dt + 16 * wd + 4 * fq) = nacc; } while (0)
#define L1S_STEP(si, K0, K1, VV, W) do { const int stp_ = L1S_STP(si); \
            if ((si) == 0 || ((si) >= 2 && (((si) - 2) & 3) == 0)) { if (stp_ >= 1) L1S_STORE(dir ? 16 - stp_ : stp_ - 1); const float wc_ = __expf(MS[stp_] - MS[32 + stp_]); \
                _Pragma("unroll") for (int i = 0; i < 4; ++i) acc[i] = acc[i] * wc_; nacc = nacc * wc_; } \
            __syncthreads(); \
            *(LAS v4u*)(Kt + srow * P144 + 32 * q4) = scale8(K0, W); *(LAS v4u*)(Kt + srow * P144 + 32 * q4 + 16) = scale8(K1, W); \
            _Pragma("unroll") for (int c = 0; c < 4; ++c) *(LAS v4u*)(Vt + srow * P272 + 64 * q4 + 16 * c) = VV[c]; \
            __syncthreads(); \
            if ((si) + 4 < 62) L1S_LOAD((si) + 4, K0, K1, VV, W); \
            _Pragma("unroll") for (int kk = 0; kk < 4; ++kk) { const bf16x8 a = frag_tr(Kt, P144, 32 * kk, 16 * wd, lane); \
                _Pragma("unroll") for (int t4 = 0; t4 < 4; ++t4) acc[t4] = MFMA16(a, frag_tr(Vt, P272, 32 * kk, 64 * we + 16 * t4, lane), acc[t4]); \
                nacc = MFMA16(a, ones, nacc); } } while (0)
        v4u ka0, ka1, va[4], kb0, kb1, vb[4], kc0, kc1, vc[4], kd0, kd1, vd[4]; float wa, wb, wc, wd_;
        L1S_LOAD(0, ka0, ka1, va, wa); L1S_LOAD(1, kb0, kb1, vb, wb); L1S_LOAD(2, kc0, kc1, vc, wc); L1S_LOAD(3, kd0, kd1, vd, wd_);
#pragma unroll 1
        for (int si = 0; si < 60; si += 4) { L1S_STEP(si, ka0, ka1, va, wa); L1S_STEP(si + 1, kb0, kb1, vb, wb); L1S_STEP(si + 2, kc0, kc1, vc, wc); L1S_STEP(si + 3, kd0, kd1, vd, wd_); }
        L1S_STEP(60, ka0, ka1, va, wa); L1S_STEP(61, kb0, kb1, vb, wb);
        L1S_STORE(dir ? 0 : 15);
#undef L1S_STP
#undef L1S_LOAD
#undef L1S_STORE
#undef L1S_STEP
    }
    __syncthreads();
}


constexpr int P1040 = 1040;
constexpr int LY_AJ = 139264;
constexpr int LY_MT = 66560;
__device__ __forceinline__ void qprime8(const bf16* xcrow, const float* WQK, int cb, float (&o)[8]) {
    float x[8]; unpack8(*(const v4u*)(xcrow + cb), x);
    bw8(x, WQK + (cb >> 2) * 16, o);
}
__device__ __forceinline__ void phase_l1_y(const Args& args, unsigned char* ws, LAS unsigned char* lds, int tid0, int lane0, int wave, int bx, int G, int b, bool dry = false) {
    const bf16* XM = (const bf16*)(ws + WS_XM); const bf16* XC = (const bf16*)(ws + WS_XC); bf16* Z = (bf16*)(ws + WS_Z);
    const float* AJ = (const float*)(ws + WS_AJ); const float* BC = (const float*)(ws + WS_BC); const float* CM = (const float*)(ws + WS_CM); const float* CH = (const float*)(ws + WS_CH);
    const bf16* ST = (const bf16*)(ws + WS_ST1); const float* NV = (const float*)(ws + WS_NV); const float* WQK = (const float*)(ws + WS_WQK);
    LAS float* AJL = (LAS float*)(lds + LY_AJ);
    LAS unsigned char* Mf = lds;
    LAS unsigned char* Tt = lds + 66560;
    const int wr = wave >> 1, we = wave & 1;
    for (int u = bx; u < 512; u += G) {
        int tid = tid0, lane = lane0; asm volatile("" : "+v"(tid), "+v"(lane));
        const int fr = lane & 15, fq = lane >> 4;
        const int h = u >> 7, k = (u >> 3) & 15, rb = u & 7;
        const int base = RL0 + 8192 * b + 512 * k, xb = 256 + 512 * k, i0 = 64 * rb;
        const int il = i0 + 16 * wr + fr, row = base + il; const bf16* xcrow = XC + (size_t)(xb + il) * 2048;
        const int Rw = 4 * rb + wr;
        __syncthreads();
        const float m_in_f = ((const float*)(ws + WS_MIN))[(b * 8 + h) * 17 + k + 1], m_in_b = ((const float*)(ws + WS_MIN))[(b * 8 + 4 + h) * 17 + 16 - k];
        const float mu_f = fmaxf(m_in_f, CM[(size_t)row * 8 + h]), mu_b = fmaxf(m_in_b, CM[(size_t)row * 8 + 4 + h]);
        const float bc_f = BC[(size_t)row * 8 + h], bc_b = BC[(size_t)row * 8 + 4 + h];
        for (int i = tid; i < 1024; i += 512) { const int d = i >> 9, j = i & 511; AJL[i] = AJ[(size_t)(base + j) * 8 + 4 * d + h]; }
        f32x4 Gt[4][4];
#pragma unroll
        for (int kb = 0; kb < 4; ++kb)
#pragma unroll
            for (int t = 0; t < 4; ++t) Gt[kb][t] = (f32x4){0.f, 0.f, 0.f, 0.f};
        float qn_f = 0.f, qn_b = 0.f;
        const float* nf = NV + (size_t)(h * 16 + k) * 512; const float* nb = NV + (size_t)((4 + h) * 16 + k) * 512;
        v4u pa[8]; int tA = tid; asm volatile("" : "+v"(tA));
#pragma unroll
        for (int c = 0; c < 8; ++c) { const int ch = tA + 512 * c, r = ch >> 3, cc = ch & 7; pa[c] = *(const v4u*)(XC + (size_t)(xb + r) * 2048 + 512 * h + 8 * cc); }
#pragma unroll 1
        for (int ds = 0; ds < 8; ++ds) {
            __syncthreads();
#pragma unroll
            for (int c = 0; c < 8; ++c) { const int ch = tA + 512 * c, r = ch >> 3, cc = ch & 7; *(LAS v4u*)(lds + r * P144 + 16 * cc) = pa[c]; }
            bf16x8 qf[2];
#pragma unroll
            for (int kk = 0; kk < 2; ++kk) { const int dl = 64 * ds + 32 * kk + 8 * fq; float q8[8]; qprime8(xcrow, WQK, 512 * h + dl, q8);
#pragma unroll
                for (int e = 0; e < 8; ++e) { qn_f += q8[e] * nf[dl + e]; qn_b += q8[e] * nb[dl + e]; }
                qf[kk] = __builtin_bit_cast(bf16x8, pack8(q8)); asm volatile("" ::: "memory"); }
            __syncthreads();
            if (ds < 7) {
                asm volatile("" : "+v"(tA));
#pragma unroll
                for (int c = 0; c < 8; ++c) { const int ch = tA + 512 * c, r = ch >> 3, cc = ch & 7; pa[c] = *(const v4u*)(XC + (size_t)(xb + r) * 2048 + 512 * h + 64 * (ds + 1) + 8 * cc); }
            }
#pragma unroll
            for (int kb = 0; kb < 4; ++kb) {
#pragma unroll
                for (int t = 0; t < 4; ++t) {
#pragma unroll
                    for (int kk = 0; kk < 2; ++kk) Gt[kb][t] = MFMA16(frag_nat(lds, P144, 64 * (4 * we + kb) + 16 * t, 32 * kk, lane), qf[kk], Gt[kb][t]);
                    asm volatile("" ::: "memory"); } }
        }
        qn_f += __shfl_xor(qn_f, 16); qn_f += __shfl_xor(qn_f, 32); qn_b += __shfl_xor(qn_b, 16); qn_b += __shfl_xor(qn_b, 32);
        float rsf = 0.f, rsb = 0.f;
#pragma unroll
        for (int kb = 0; kb < 4; ++kb)
#pragma unroll
            for (int t = 0; t < 4; ++t) { const int T = 4 * (4 * we + kb) + t, j0 = 16 * T + 4 * fq; const f32x4 g = Gt[kb][t];
                if (T < Rw) { rsf += g.x * __expf(AJL[j0] - mu_f) + g.y * __expf(AJL[j0 + 1] - mu_f) + g.z * __expf(AJL[j0 + 2] - mu_f) + g.w * __expf(AJL[j0 + 3] - mu_f); }
                else if (T > Rw) { rsb += g.x * __expf(AJL[512 + j0] - mu_b) + g.y * __expf(AJL[512 + j0 + 1] - mu_b) + g.z * __expf(AJL[512 + j0 + 2] - mu_b) + g.w * __expf(AJL[512 + j0 + 3] - mu_b); }
                else {
#pragma unroll
                    for (int r = 0; r < 4; ++r) { const int jj = 4 * fq + r; const float ef = __expf(AJL[j0 + r] - mu_f), eb = __expf(AJL[512 + j0 + r] - mu_b);
                        rsf += jj <= fr ? g[r] * ef : 0.f; rsb += jj >= fr ? g[r] * eb : 0.f; } }
                asm volatile("" ::: "memory"); }
        rsf += __shfl_xor(rsf, 16); rsf += __shfl_xor(rsf, 32); rsb += __shfl_xor(rsb, 16); rsb += __shfl_xor(rsb, 32);
        __syncthreads();
        { LAS float* RS = (LAS float*)lds; if (fq == 0) { RS[(wave * 16 + fr) * 2] = rsf; RS[(wave * 16 + fr) * 2 + 1] = rsb; }
          __syncthreads();
          rsf += RS[((wave ^ 1) * 16 + fr) * 2]; rsb += RS[((wave ^ 1) * 16 + fr) * 2 + 1]; }
        const float wp_f = __expf(m_in_f - mu_f), wp_b = __expf(m_in_b - mu_b);
        const float dn_f = fmaxf(fabsf(rsf + wp_f * qn_f), __expf(-bc_f - mu_f)), dn_b = fmaxf(fabsf(rsb + wp_b * qn_b), __expf(-bc_b - mu_b));
        const float inv_f = 1.0f / dn_f, inv_b = 1.0f / dn_b, s_f = wp_f * inv_f, s_b = wp_b * inv_b;
        __syncthreads();
#pragma unroll
        for (int kb = 0; kb < 4; ++kb)
#pragma unroll
            for (int t = 0; t < 4; ++t) { const int T = 4 * (4 * we + kb) + t, j0 = 16 * T + 4 * fq; const f32x4 g = Gt[kb][t]; f32x4 m;
                if (T < Rw) { m.x = g.x * __expf(AJL[j0] - mu_f) * inv_f; m.y = g.y * __expf(AJL[j0 + 1] - mu_f) * inv_f; m.z = g.z * __expf(AJL[j0 + 2] - mu_f) * inv_f; m.w = g.w * __expf(AJL[j0 + 3] - mu_f) * inv_f; }
                else if (T > Rw) { m.x = g.x * __expf(AJL[512 + j0] - mu_b) * inv_b; m.y = g.y * __expf(AJL[512 + j0 + 1] - mu_b) * inv_b; m.z = g.z * __expf(AJL[512 + j0 + 2] - mu_b) * inv_b; m.w = g.w * __expf(AJL[512 + j0 + 3] - mu_b) * inv_b; }
                else {
#pragma unroll
                    for (int r = 0; r < 4; ++r) { const int jj = 4 * fq + r; const float ef = __expf(AJL[j0 + r] - mu_f) * inv_f, eb = __expf(AJL[512 + j0 + r] - mu_b) * inv_b;
                        m[r] = g[r] * ((jj <= fr ? ef : 0.f) + (jj >= fr ? eb : 0.f)); } }
                *(LAS v2u*)(Mf + (16 * wr + fr) * P1040 + j0 * 2) = pack4(m); asm volatile("" ::: "memory"); }
        f32x4 acc[16];
#pragma unroll
        for (int et = 0; et < 16; ++et) acc[et] = (f32x4){0.f, 0.f, 0.f, 0.f};
        v4u pre[8]; int tB = tid; asm volatile("" : "+v"(tB));
#pragma unroll
        for (int c = 0; c < 8; ++c) { const int ch = tB + 512 * c, r = ch >> 6, cc = ch & 63; pre[c] = *(const v4u*)(XM + (size_t)(base + r) * 2048 + 512 * h + 8 * cc); }
#pragma unroll 1
        for (int kb = 0; kb < 8; ++kb) {
            __syncthreads();
#pragma unroll
            for (int c = 0; c < 8; ++c) { const int ch = tB + 512 * c, r = ch >> 6, cc = ch & 63; *(LAS v4u*)(Tt + r * P1040 + 16 * cc) = pre[c]; }
            __syncthreads();
            if (kb < 7) {
                asm volatile("" : "+v"(tB));
#pragma unroll
                for (int c = 0; c < 8; ++c) { const int ch = tB + 512 * c, r = ch >> 6, cc = ch & 63; pre[c] = *(const v4u*)(XM + (size_t)(base + 64 * (kb + 1) + r) * 2048 + 512 * h + 8 * cc); }
            }
#pragma unroll
            for (int kk2 = 0; kk2 < 2; ++kk2) { const bf16x8 mb = frag_nat(Mf, P1040, 16 * wr, 64 * kb + 32 * kk2, lane);
#pragma unroll
                for (int et = 0; et < 16; ++et) { acc[et] = MFMA16(frag_tr(Tt, P1040, 32 * kk2, 256 * we + 16 * et, lane), mb, acc[et]); if ((et & 3) == 3) asm volatile("" ::: "memory"); } }
        }
        int tC = tid; asm volatile("" : "+v"(tC));
        { const bf16* S = ST + ((size_t)(h * 16 + k) * 512) * 512;
#pragma unroll
          for (int c = 0; c < 8; ++c) { const int ch = tC + 512 * c, r = ch >> 3, cc = ch & 7; pre[c] = *(const v4u*)(S + (size_t)r * 512 + 8 * cc); } }
#pragma unroll 1
        for (int it = 0; it < 16; ++it) {
            const int dir = it >> 3, dsl = it & 7; const float sc = dir ? s_b : s_f;
            __syncthreads();
#pragma unroll
            for (int c = 0; c < 8; ++c) { const int ch = tC + 512 * c, r = ch >> 3, cc = ch & 7; *(LAS v4u*)(Tt + r * P144 + 16 * cc) = pre[c]; }
            bf16x8 qs[2];
#pragma unroll
            for (int kk = 0; kk < 2; ++kk) { float q8[8]; qprime8(xcrow, WQK, 512 * h + 64 * dsl + 32 * kk + 8 * fq, q8);
#pragma unroll
                for (int e = 0; e < 8; ++e) q8[e] *= sc;
                qs[kk] = __builtin_bit_cast(bf16x8, pack8(q8)); }
            __syncthreads();
            if (it < 15) { asm volatile("" : "+v"(tC)); const int nd = (it + 1) >> 3, ns = (it + 1) & 7; const bf16* S = ST + ((size_t)((nd * 4 + h) * 16 + k) * 512) * 512 + 64 * ns;
#pragma unroll
                for (int c = 0; c < 8; ++c) { const int ch = tC + 512 * c, r = ch >> 3, cc = ch & 7; pre[c] = *(const v4u*)(S + (size_t)r * 512 + 8 * cc); } }
#pragma unroll
            for (int kk = 0; kk < 2; ++kk)
#pragma unroll
                for (int et = 0; et < 16; ++et) { acc[et] = MFMA16(frag_nat(Tt, P144, 256 * we + 16 * et, 32 * kk, lane), qs[kk], acc[et]); if ((et & 3) == 3) asm volatile("" ::: "memory"); }
        }
        float sm = 0.f;
#pragma unroll
        for (int et = 0; et < 16; ++et) { const float* w = args.in[I_MLWV] + (size_t)(128 * h + 64 * we + 4 * et + fq) * 16; const f32x4 a = acc[et]; f32x4 o;
            o.x = a.x * w[0] + a.y * w[4] + a.z * w[8] + a.w * w[12]; o.y = a.x * w[1] + a.y * w[5] + a.z * w[9] + a.w * w[13];
            o.z = a.x * w[2] + a.y * w[6] + a.z * w[10] + a.w * w[14]; o.w = a.x * w[3] + a.y * w[7] + a.z * w[11] + a.w * w[15];
            acc[et] = o; sm += (o.x + o.y) + (o.z + o.w); asm volatile("" ::: "memory"); }
        sm += __shfl_xor(sm, 16); sm += __shfl_xor(sm, 32);
        LAS float* XS = AJL;
        __syncthreads();
        if (fq == 0) XS[wave * 16 + fr] = sm;
        __syncthreads();
        const float mean = (sm + XS[(wave ^ 1) * 16 + fr]) * (1.f / 512.f); float sq = 0.f;
#pragma unroll
        for (int et = 0; et < 16; ++et) { acc[et] = acc[et] - mean; sq += (acc[et].x * acc[et].x + acc[et].y * acc[et].y) + (acc[et].z * acc[et].z + acc[et].w * acc[et].w); }
        sq += __shfl_xor(sq, 16); sq += __shfl_xor(sq, 32);
        if (fq == 0) XS[128 + wave * 16 + fr] = sq;
        __syncthreads();
        const float rstd = 1.0f / sqrtf((sq + XS[128 + (wave ^ 1) * 16 + fr]) * (1.f / 512.f) + LN_EPS);
#pragma unroll
        for (int et = 0; et < 16; ++et) { const int ch = 512 * h + 256 * we + 16 * et + 4 * fq;
            const f32x4 nw = *(const f32x4*)(args.in[I_MLNW] + ch), sk = *(const f32x4*)(args.in[I_MLSKIP] + ch), xcv = unpack4(*(const v2u*)(xcrow + ch)), zz = unpack4(*(const v2u*)(Z + (size_t)row * 2048 + ch));
            f32x4 y = acc[et] * rstd * nw + sk * xcv;
            y.x *= silu_f(zz.x); y.y *= silu_f(zz.y); y.z *= silu_f(zz.z); y.w *= silu_f(zz.w);
            if (!dry) *(v2u*)(Z + (size_t)row * 2048 + ch) = pack4(y); asm volatile("" ::: "memory"); }
    }
    __syncthreads();
}


__device__ __forceinline__ void xcd_barrier2(const XcdBarrier& b) {
    asm volatile("s_waitcnt vmcnt(0)" ::: "memory");
    __syncthreads();
    if (threadIdx.x == 0) {
        unsigned* bar = b.bar;
        __builtin_amdgcn_s_waitcnt(0);
        unsigned nloc = b.st[0], nx = b.st[1];
        if (nloc == 0u) { xcd_barrier_complete(bar, b.x, nloc, nx); b.st[0] = nloc; b.st[1] = nx; }
        const unsigned old = xb_add(&bar[XB_XSUB(b.x)], 1u);
        const unsigned gen = old / nloc;
        if (old + 1u == (gen + 1u) * nloc) {
            __builtin_amdgcn_fence(__ATOMIC_RELEASE, "agent");
            asm volatile("s_waitcnt vmcnt(0)" ::: "memory");
            const unsigned og = xb_add(&bar[XB_TOP], 1u);
            if (og + 1u == (gen + 1u) * nx) xb_add(&bar[XB_TOPGEN], 1u);
        }
        XB_SPIN(xb_ld(&bar[XB_TOPGEN]) == gen, bar);
        __builtin_amdgcn_fence(__ATOMIC_ACQUIRE, "agent");
        asm volatile("s_waitcnt vmcnt(0)" ::: "memory");
    }
    __syncthreads();
}
#ifndef BARRIER_FLAT
#define BARRIER_FLAT 0
#endif
__device__ __forceinline__ void flat_barrier(unsigned* cnt, unsigned* flag, unsigned& gen, unsigned G) {
    asm volatile("s_waitcnt vmcnt(0)" ::: "memory");
    __syncthreads();
    if (threadIdx.x == 0) {
        __builtin_amdgcn_fence(__ATOMIC_RELEASE, "agent");
        asm volatile("s_waitcnt vmcnt(0)" ::: "memory");
        const unsigned target = gen + 1u;
        const unsigned old = __hip_atomic_fetch_add(cnt, 1u, __ATOMIC_RELAXED, __HIP_MEMORY_SCOPE_AGENT);
        if (old + 1u == target * G) __hip_atomic_store(flag, target, __ATOMIC_RELAXED, __HIP_MEMORY_SCOPE_AGENT);
        else { unsigned sp = 0; while (__hip_atomic_load(flag, __ATOMIC_RELAXED, __HIP_MEMORY_SCOPE_AGENT) < target) { __builtin_amdgcn_s_sleep(1); if (++sp > (1u << 22)) break; } }
        __builtin_amdgcn_fence(__ATOMIC_ACQUIRE, "agent");
        asm volatile("s_waitcnt vmcnt(0)" ::: "memory");
    }
    gen += 1u;
    __syncthreads();
}
#ifndef MK_PER_PHASE
#define MK_PER_PHASE 0
#endif
constexpr int N_PHASES = 25;
#ifndef PROBE_MASK
#define PROBE_MASK 0
#endif
#define DUP(k) (((PROBE_MASK) >> (k)) & 1)
#ifndef TPROBE_MASK
#define TPROBE_MASK 0
#endif
#define TPR(k) (((TPROBE_MASK) >> (k)) & 1)
__global__ void __launch_bounds__(NWAVES * 64, 2) mk_fwd(Args args) {
    extern __shared__ __attribute__((aligned(16))) unsigned char lds_raw[];
    LAS unsigned char* lds = (LAS unsigned char*)lds_raw;
    volatile LAS unsigned* MISC = (volatile LAS unsigned*)(lds + MISC_OFF);
    const int tid = threadIdx.x, lane = tid & 63, wave = __builtin_amdgcn_readfirstlane(tid >> 6);
    const int G = gridDim.x, bx = blockIdx.x;
    const int vcu = (G % 8 == 0) ? (bx % 8) * (G / 8) + bx / 8 : bx;
    const int gw = vcu * NWAVES + wave, NGW = G * NWAVES;
    unsigned char* ws = args.ws;
    gu32* ctl = (gu32*)(ws + WS_CTL);
    float* MOD = (float*)(ws + CTL_MOD);
    unsigned char* dob = (unsigned char*)args.out;
    for (int u = tid; u < (LDS_BYTES - LDSCTL_OFF) / 4; u += NWAVES * 64) ((LAS unsigned*)(lds + LDSCTL_OFF))[u] = 0u;
    __syncthreads();
    XcdBarrier bar; bar.bar = (unsigned*)(ctl + CW_BAR); bar.x = 0; bar.st = nullptr;
    if (!MK_PER_PHASE) bar = xcd_barrier_post((unsigned*)(ctl + CW_BAR), MISC + 8);
    const int lo = args.ph_lo, hi = args.ph_hi;
    unsigned long long tacc = 0ull, tmark = 0ull;
#define TBEG(k) do { if (TPR(k)) tmark = __builtin_amdgcn_s_memrealtime(); } while (0)
#define TEND(k) do { if (TPR(k)) tacc += __builtin_amdgcn_s_memrealtime() - tmark; } while (0)
#define IN(k) (lo <= (k) && (k) < hi)
    unsigned fgen = 0u;
#if BARRIER_FLAT
#define GBAR() flat_barrier((unsigned*)(ctl + 8192), (unsigned*)(ctl + 8192 + 64), fgen, (unsigned)G)
#elif defined(BARRIER2)
#define GBAR() xcd_barrier2(bar)
#else
#define GBAR() xcd_barrier(bar)
#endif
#define SEAM(k) do { if (IN(k) && IN((k) + 1)) GBAR(); TEND(k); TBEG((k) + 1); } while (0)

    TBEG(0);
    if (IN(0)) {
        LAS float* scr = (LAS float*)(lds + wave * 16384);
        conv_abin(args.in[I_ABIN], (bf16*)(ws + WS_W_IN), scr, gw, NGW, lane);
        conv_plain(args.in[I_ABOUT], 2048, 1024, (bf16*)(ws + WS_W_OUT), scr, gw, NGW, lane);
        conv_ffn1(args.in[I_W1], args.in[I_W3], (bf16*)(ws + WS_W_F1), scr, gw, NGW, lane);
        conv_plain(args.in[I_W2], FFH, 1024, (bf16*)(ws + WS_W_F2), scr, gw, NGW, lane);
        __syncthreads();
        LAS float* sc = (LAS float*)lds;
        LAS float* part = (LAS float*)(lds + 16384);
        for (int i = tid; i < 3 * 1024; i += 512) { const int v = i >> 10, k = i & 1023; const float cv = v == 0 ? args.in[I_CCTX][k] : args.in[I_C][(v - 1) * DM + k]; sc[i] = silu_f(cv); }
        __syncthreads();
        for (int u = bx; u < 192; u += G) {
            const int layer = u / 96, cb = u % 96, n = cb * 64 + lane;
            const float* W = args.in[I_ADAW] + (size_t)layer * DM * 6144 + (size_t)(wave * 128) * 6144 + n;
            float a0 = 0.f, a1 = 0.f, a2 = 0.f;
#pragma unroll 8
            for (int kk = 0; kk < 128; ++kk) { const float wv = W[(size_t)kk * 6144]; const int k = wave * 128 + kk; a0 += sc[k] * wv; a1 += sc[1024 + k] * wv; a2 += sc[2048 + k] * wv; }
            part[(wave * 3 + 0) * 64 + lane] = a0; part[(wave * 3 + 1) * 64 + lane] = a1; part[(wave * 3 + 2) * 64 + lane] = a2;
            __syncthreads();
            if (tid < 192) { const int v = tid >> 6, l = tid & 63; float s = args.in[I_ADAB][layer * 6144 + cb * 64 + l];
#pragma unroll
                for (int w = 0; w < 8; ++w) s += part[(w * 3 + v) * 64 + l];
                MOD[(size_t)(layer * 3 + v) * 6144 + cb * 64 + l] = s; }
            __syncthreads();
        }
        for (int i = bx * 512 + tid; i < 512 * 16; i += G * 512) { const int blk = i >> 4, d = (i >> 2) & 3, dp = i & 3; const float* q = args.in[I_MLWQ] + blk * 16 + d * 4; const float* k = args.in[I_MLWK] + blk * 16 + dp * 4;
            ((float*)(ws + WS_WQK))[i] = 0.04419417382415922f * (q[0] * k[0] + q[1] * k[1] + q[2] * k[2] + q[3] * k[3]); }
    }
    SEAM(0);
    if (IN(1)) {
        LAS float* wdt = (LAS float*)lds;
        for (int i = tid; i < 1024 * 4; i += 512) { const int k = i >> 2, q = i & 3; const f32x4 w4 = *(const f32x4*)(args.in[I_ABIN] + (size_t)k * ABIN + 3072 + 4 * q);
            wdt[(4 * q) * 1024 + k] = w4.x; wdt[(4 * q + 1) * 1024 + k] = w4.y; wdt[(4 * q + 2) * 1024 + k] = w4.z; wdt[(4 * q + 3) * 1024 + k] = w4.w; }
        __syncthreads();
        norm_rows<true>(args.in[I_CTX], args.in[I_X], args.in[I_NMIX], MOD, 0, (bf16*)(dob + DO_H), 0, 0, R, gw, NGW, lane, wdt, (float*)(ws + WS_DTRAW));
        __syncthreads();
    }
    SEAM(1);
    if (IN(2)) {
        pg8::Gemm g{(const bf16*)(dob + DO_H), (const bf16*)(ws + WS_W_IN), R, 6144, DM}; pg8::StaticOrder S; S.init(R, 6144, G, bx);
        pg8::EpiInProj E{(bf16*)(ws + WS_ZG), (bf16*)(ws + WS_XBC), (bf16*)(ws + WS_QK), (bf16*)(ws + WS_V), (bf16*)(ws + WS_HALO)};
        pg8::gemm_phase<pg8::EpiInProj, pg8::StaticOrder, true, true>(lds, g, S, E);
    }
    SEAM(2);
    if (DUP(20)) { for (int i = 0; i < 10; ++i) GBAR(); }
    if (IN(3)) { phase_l0_prep(args, ws, lds, tid, lane, wave, bx, G, gw, NGW); }
    SEAM(3);
    if (DUP(4) && IN(4)) { phase_l0_scan(args, ws, dob, lds, tid, lane, wave, bx, G); GBAR(); }
    if (IN(4)) { phase_l0_scan(args, ws, dob, lds, tid, lane, wave, bx, G); }
    SEAM(4);
    if (DUP(5) && IN(5)) { phase_l0_y(args, ws, dob, lds, tid, lane, wave, bx, G, lo == 0); GBAR(); }
    if (IN(5)) { phase_l0_y(args, ws, dob, lds, tid, lane, wave, bx, G); }
    SEAM(5);
    if (IN(6)) {
        pg8::Gemm g{(const bf16*)(ws + WS_ZG), (const bf16*)(ws + WS_W_OUT), R, DM, 2048}; pg8::StaticOrder S; S.init(R, DM, G, bx);
        pg8::EpiResid E{args.in[I_CTX], args.in[I_X], (float*)(ws + WS_XCTX), args.out, MOD + 2 * 1024, 0};
        pg8::gemm_phase<pg8::EpiResid, pg8::StaticOrder, true, true>(lds, g, S, E);
    }
    SEAM(6);
    if (IN(7)) { norm_rows<false>((const float*)(ws + WS_XCTX), args.out, args.in[I_NFFN], MOD, 3, (bf16*)(ws + WS_HF0), 0, 0, R, gw, NGW, lane, nullptr, nullptr); }
    SEAM(7);
    if (IN(8)) {
        pg8::Gemm g{(const bf16*)(ws + WS_HF0), (const bf16*)(ws + WS_W_F1), R, 5632, DM}; pg8::StaticOrder S; S.init(R, 5632, G, bx);
        pg8::EpiSwiglu E{(bf16*)(ws + WS_HH0), FFH};
        pg8::gemm_phase<pg8::EpiSwiglu, pg8::StaticOrder, true, true>(lds, g, S, E);
    }
    SEAM(8);
    if (IN(9)) {
        pg8::Gemm g{(const bf16*)(ws + WS_HH0), (const bf16*)(ws + WS_W_F2), R, DM, FFH}; pg8::StaticOrder S; S.init(R, DM, G, bx);
        pg8::EpiResid E{(const float*)(ws + WS_XCTX), args.out, (float*)(ws + WS_XCTX), args.out, MOD + 5 * 1024, 0};
        pg8::gemm_phase<pg8::EpiResid, pg8::StaticOrder, true, true>(lds, g, S, E);
    }
    SEAM(9);
    if (IN(10)) {
        norm_rows<false>((const float*)(ws + WS_XCTX), args.out, args.in[I_NMIX] + DM, MOD + 3 * 6144, 0, (bf16*)(ws + WS_H1), 0, 0, R, gw, NGW, lane, nullptr, nullptr);
        conv_plain(args.in[I_MLUP], DM, 4096, (bf16*)(ws + WS_W_UP), (LAS float*)(lds + wave * 16384), gw, NGW, lane);
        for (int i = bx * 512 + tid; i < 2 * 16 * 2048; i += G * 512) { const int which = i >> 15, gt = (i >> 11) & 15, d = i & 2047, blk = d >> 2, dd = d & 3; const float* gw = args.in[I_MLGW];
            float s = 0.f;
            if (which == 0) { const float* q = args.in[I_MLWQ] + blk * 16 + dd * 4; const float* k = args.in[I_MLWK] + blk * 16 + dd * 4;
#pragma unroll
                for (int c = 0; c < 4; ++c) s += q[c] * gw[(size_t)(4 * blk + c) * 16 + gt] + k[c] * gw[(size_t)(2048 + 4 * blk + c) * 16 + gt]; }
            else { const float* v = args.in[I_MLWV] + blk * 16 + dd * 4;
#pragma unroll
                for (int c = 0; c < 4; ++c) s += v[c] * gw[(size_t)(4096 + 4 * blk + c) * 16 + gt]; }
            ((bf16*)(ws + WS_GWT))[i] = (bf16)f2bf(s); }
    }
    SEAM(10);
    if (IN(11)) {
        pg8::Gemm g{(const bf16*)(ws + WS_H1), (const bf16*)(ws + WS_W_UP), R, 4096, DM}; pg8::StaticOrder S; S.init(R, 4096, G, bx);
        pg8::EpiSplit2 E{(bf16*)(ws + WS_XM), (bf16*)(ws + WS_Z), 2048, 8};
        pg8::gemm_phase<pg8::EpiSplit2, pg8::StaticOrder, true, true>(lds, g, S, E);
    }
    SEAM(11);
    {
        if (IN(12)) {
            phase_l1_prep(args, ws, lds, tid, lane, wave, bx, G, 0);
            if (0 == 1) {
                LAS float* scr = (LAS float*)(lds + wave * 16384);
                __syncthreads();
                conv_plain(args.in[I_MLDOWN], 2048, 1024, (bf16*)(ws + WS_W_DN), scr, gw, NGW, lane);
                conv_ffn1(args.in[I_W1] + (size_t)DM * FFH, args.in[I_W3] + (size_t)DM * FFH, (bf16*)(ws + WS_W_F1B), scr, gw, NGW, lane);
                conv_plain(args.in[I_W2] + (size_t)FFH * DM, FFH, 1024, (bf16*)(ws + WS_W_F2B), scr, gw, NGW, lane);
            }
        }
        SEAM(12);
        if (DUP(13) && IN(13)) { phase_l1_prep(args, ws, lds, tid, lane, wave, bx, G, 0); GBAR(); phase_l1_gatescan(args, ws, lds, tid, lane, wave, bx, G, gw, NGW, 0); GBAR(); }
        if (DUP(21) && IN(13)) { phase_l1_gatescan(args, ws, lds, tid, lane, wave, bx, G, gw, NGW, 0); GBAR(); }
        if (DUP(22) && IN(13)) { phase_l1_prep(args, ws, lds, tid, lane, wave, bx, G, 0); GBAR(); }
        if (IN(13)) { phase_l1_gatescan(args, ws, lds, tid, lane, wave, bx, G, gw, NGW, 0); }
        SEAM(13);
        if (DUP(14) && IN(14)) { phase_l1_scan(args, ws, lds, tid, lane, wave, bx, G, 0); GBAR(); }
        if (IN(14)) { phase_l1_scan(args, ws, lds, tid, lane, wave, bx, G, 0); }
        SEAM(14);
        if (DUP(15) && IN(15)) { phase_l1_y(args, ws, lds, tid, lane, wave, bx, G, 0, lo == 0); GBAR(); }
        if (IN(15)) { phase_l1_y(args, ws, lds, tid, lane, wave, bx, G, 0); }
        SEAM(15);
    }
    {
        if (IN(16)) {
            phase_l1_prep(args, ws, lds, tid, lane, wave, bx, G, 1);
            if (1 == 1) {
                LAS float* scr = (LAS float*)(lds + wave * 16384);
                __syncthreads();
                conv_plain(args.in[I_MLDOWN], 2048, 1024, (bf16*)(ws + WS_W_DN), scr, gw, NGW, lane);
                conv_ffn1(args.in[I_W1] + (size_t)DM * FFH, args.in[I_W3] + (size_t)DM * FFH, (bf16*)(ws + WS_W_F1B), scr, gw, NGW, lane);
                conv_plain(args.in[I_W2] + (size_t)FFH * DM, FFH, 1024, (bf16*)(ws + WS_W_F2B), scr, gw, NGW, lane);
            }
        }
        SEAM(16);
        if (DUP(13) && IN(17)) { phase_l1_prep(args, ws, lds, tid, lane, wave, bx, G, 1); GBAR(); phase_l1_gatescan(args, ws, lds, tid, lane, wave, bx, G, gw, NGW, 1); GBAR(); }
        if (DUP(21) && IN(17)) { phase_l1_gatescan(args, ws, lds, tid, lane, wave, bx, G, gw, NGW, 1); GBAR(); }
        if (DUP(22) && IN(17)) { phase_l1_prep(args, ws, lds, tid, lane, wave, bx, G, 1); GBAR(); }
        if (IN(17)) { phase_l1_gatescan(args, ws, lds, tid, lane, wave, bx, G, gw, NGW, 1); }
        SEAM(17);
        if (DUP(14) && IN(18)) { phase_l1_scan(args, ws, lds, tid, lane, wave, bx, G, 1); GBAR(); }
        if (IN(18)) { phase_l1_scan(args, ws, lds, tid, lane, wave, bx, G, 1); }
        SEAM(18);
        if (DUP(15) && IN(19)) { phase_l1_y(args, ws, lds, tid, lane, wave, bx, G, 1, lo == 0); GBAR(); }
        if (IN(19)) { phase_l1_y(args, ws, lds, tid, lane, wave, bx, G, 1); }
        SEAM(19);
    }
    if (IN(20)) {
        pg8::Gemm g{(const bf16*)(ws + WS_Z) + (size_t)RL0 * 2048, (const bf16*)(ws + WS_W_DN), MLAT, DM, 2048}; pg8::StaticOrder S; S.init(MLAT, DM, G, bx);
        pg8::EpiResid E{(const float*)(ws + WS_XCTX), args.out, (float*)(ws + WS_XCTX), args.out, MOD + 3 * 6144 + 2 * 1024, RL0};
        pg8::gemm_phase<pg8::EpiResid, pg8::StaticOrder, true, true>(lds, g, S, E);
    }
    SEAM(20);
    if (IN(21)) { norm_rows<false>((const float*)(ws + WS_XCTX), args.out, args.in[I_NFFN] + DM, MOD + 3 * 6144, 3, (bf16*)(ws + WS_HF1), RL0, RL0, R, gw, NGW, lane, nullptr, nullptr); }
    SEAM(21);
    if (IN(22)) {
        pg8::Gemm g{(const bf16*)(ws + WS_HF1), (const bf16*)(ws + WS_W_F1B), MLAT, 5632, DM}; pg8::StaticOrder S; S.init(MLAT, 5632, G, bx);
        pg8::EpiSwiglu E{(bf16*)(ws + WS_HH1), FFH};
        pg8::gemm_phase<pg8::EpiSwiglu, pg8::StaticOrder, true, true>(lds, g, S, E);
    }
    SEAM(22);
    if (IN(23)) {
        pg8::Gemm g{(const bf16*)(ws + WS_HH1), (const bf16*)(ws + WS_W_F2B), MLAT, DM, FFH}; pg8::StaticOrder S; S.init(MLAT, DM, G, bx);
        pg8::EpiResid E{(const float*)(ws + WS_XCTX), args.out, (float*)(ws + WS_XCTX), args.out, MOD + 3 * 6144 + 5 * 1024, RL0};
        pg8::gemm_phase<pg8::EpiResid, pg8::StaticOrder, true, true>(lds, g, S, E);
    }
    SEAM(23);
    if (IN(24)) {
        const float* w = args.in[I_FNW];
        for (int m = gw; m < MLAT; m += NGW) {
            float* row = args.out + (size_t)m * DM; f32x4 v[4]; float ss = 0.f;
#pragma unroll
            for (int j = 0; j < 4; ++j) { v[j] = *(const f32x4*)(row + 4 * lane + 256 * j); ss += (v[j].x * v[j].x + v[j].y * v[j].y) + (v[j].z * v[j].z + v[j].w * v[j].w); }
            const float rstd = 1.0f / sqrtf(wave_sum(ss) * (1.f / DM) + RMS_EPS);
#pragma unroll
            for (int j = 0; j < 4; ++j) { const f32x4 wv = *(const f32x4*)(w + 4 * lane + 256 * j); *(f32x4*)(row + 4 * lane + 256 * j) = v[j] * rstd * wv; }
        }
    }
    TEND(24);
    if (TPROBE_MASK) { if (bx == 0) { if (tid == 0) { const unsigned long long t0 = __builtin_amdgcn_s_memrealtime(); while (__builtin_amdgcn_s_memrealtime() - t0 < tacc) __builtin_amdgcn_s_sleep(8); } __syncthreads(); } }
#undef IN
#undef SEAM
}

extern "C" void kernel_launch(void* const* d_in, const int* in_sizes, int n_in, void* d_out, int out_size, void* d_ws, size_t ws_size, hipStream_t stream) {
    static int grid = 0;
    if (grid == 0) {
        if (n_in != 35 || out_size != MLAT * DM || ws_size < WS_END) { fprintf(stderr, "kernel_launch: unexpected problem: n_in %d out %d ws %zu\n", n_in, out_size, ws_size); grid = -1; return; }
        int dev = 0, cus = 0;
        if (hipGetDevice(&dev) != hipSuccess || hipDeviceGetAttribute(&cus, hipDeviceAttributeMultiprocessorCount, dev) != hipSuccess) { grid = -1; return; }
        if (hipFuncSetAttribute((const void*)mk_fwd, hipFuncAttributeMaxDynamicSharedMemorySize, LDS_BYTES) != hipSuccess) { fprintf(stderr, "kernel_launch: hipFuncSetAttribute failed\n"); grid = -1; return; }
        int per_cu = 0;
        if (hipOccupancyMaxActiveBlocksPerMultiprocessor(&per_cu, (const void*)mk_fwd, NWAVES * 64, LDS_BYTES) != hipSuccess || per_cu < 1) fprintf(stderr, "kernel_launch: occupancy query says %d\n", per_cu);
        (void)hipGetLastError();
        grid = cus;
    }
    if (grid < 0) return;
    if (hipMemsetAsync((char*)d_ws + WS_CTL, 0, CTL_ZERO_BYTES, stream) != hipSuccess) return;
    Args a{};
    for (int i = 0; i < 35; ++i) a.in[i] = (const float*)d_in[i];
    a.out = (float*)d_out; a.ws = (unsigned char*)d_ws;
#if MK_PER_PHASE
    for (int p = 0; p < N_PHASES; ++p) { a.ph_lo = p; a.ph_hi = p + 1; hipLaunchKernelGGL(mk_fwd, dim3(grid), dim3(NWAVES * 64), LDS_BYTES, stream, a); }
#else
    a.ph_lo = 0; a.ph_hi = N_PHASES;
    hipLaunchKernelGGL(mk_fwd, dim3(grid), dim3(NWAVES * 64), LDS_BYTES, stream, a);
#endif
}
```

```cpp
#include <hip/hip_runtime.h>
#include <cstdio>
#include <cstdint>
#define BARRIER2 1
namespace pg8 {
#define PG8_LAS __attribute__((address_space(3)))
typedef unsigned short bf16_t;
typedef short bf16x8 __attribute__((ext_vector_type(8)));
typedef float f32x4 __attribute__((ext_vector_type(4)));
typedef unsigned u32x4 __attribute__((ext_vector_type(4)));
constexpr int BM = 256, BK = 64, HALF = 128, HTB = HALF * BK * 2  , STAGE_BYTES = 8 * HTB, NXCD = 8, WGM = 8;

__host__ __device__ __forceinline__ int lds_byte(int r, int c) { const int st = (r >> 4) * 2 + (c >> 5), rr = r & 15, cc = c & 31, ob = rr * 64 + cc * 2; return st * 1024 + (ob ^ (((ob >> 9) & 1) << 5)); }
__host__ __device__ __forceinline__ void stage_rc(int b, int& R, int& C) { const int st = b / 1024, sb = b % 1024, swz = sb ^ (((sb >> 9) & 1) << 5); R = (st >> 1) * 16 + swz / 64; C = (st & 1) * 32 + (swz % 64) / 2; }
__host__ __device__ __forceinline__ int perm32(int rho) { const int n = rho >> 4, i = rho & 15; return 8 * (i >> 2) + 4 * n + (i & 3); }

struct Unit { int pm, pn; };
struct Gemm { const bf16_t* A; const bf16_t* Bt; int M, N, K; };

struct StaticOrder {
    int nM, nN, nwg, G, c;
    __host__ __device__ void init(int M, int N, int G_, int c_) { nM = M / BM; nN = N / BM; nwg = nM * nN; G = G_; c = c_; }
    __host__ __device__ bool next(int i, Unit& u) const {
        const long L = (long)i * G + c; if (L >= nwg) return false;
        int wgid = (int)L; { const int q = nwg / NXCD, r = nwg % NXCD, xcd = wgid % NXCD, off = wgid / NXCD; wgid = (xcd < r ? xcd * (q + 1) : r * (q + 1) + (xcd - r) * q) + off; }
        const int nig = WGM * nN, gid = wgid / nig, fm = gid * WGM, gsz = (nM - fm) < WGM ? (nM - fm) : WGM;
        u.pm = fm + ((wgid % nig) % gsz); u.pn = (wgid % nig) / gsz; return true;
    }
    __device__ __forceinline__ void a_ready(const Unit&) const {}
    __device__ __forceinline__ void done(const Unit&) const {}
};

__device__ __forceinline__ unsigned cvt_pk_bf16(float lo, float hi) { unsigned r; asm volatile("v_cvt_pk_bf16_f32 %0, %1, %2" : "=v"(r) : "v"(lo), "v"(hi)); return r; }
__device__ __forceinline__ float fast_silu(float a) { return a * __builtin_amdgcn_rcpf(1.0f + __expf(-a)); }

struct EpiInProj {
    static constexpr bool PERM = true, AFTER_DRAIN = false;
    bf16_t *ZG, *XBC, *QK, *V, *HALO;
    __device__ __forceinline__ void operator()(const f32x4 (&acc)[2][2][4][2], const Unit& u, int wr, int wc, int fr, int fq) const {
        const int pn = u.pn; bf16_t* base; int ld, c0; bool halo = false;
        if (pn < 4) { base = ZG; ld = 2048; c0 = 256 * pn; }
        else if (pn < 12) { base = XBC; ld = 2048; c0 = 256 * (pn - 4); halo = true; }
        else if (pn < 16) { base = QK; ld = 1024; c0 = 256 * (pn - 12); }
        else if (pn < 20) { base = V; ld = 1024; c0 = 256 * (pn - 16); }
        else { base = ZG; ld = 2048; c0 = 1024 + 256 * (pn - 20); }
        const int row0 = u.pm * BM + wr * 64 + fr, col = c0 + wc * 32 + 8 * fq;
#pragma unroll
        for (int ai = 0; ai < 2; ++ai)
#pragma unroll
            for (int m = 0; m < 4; ++m) { const int r = row0 + ai * HALF + m * 16; bf16_t* rowp = base + (size_t)r * ld + col;
                const int rr = r & 31; const bool hrow = halo && (rr < 2 || rr >= 30);
#pragma unroll
                for (int bj = 0; bj < 2; ++bj) { const f32x4 v0 = acc[ai][bj][m][0], v1 = acc[ai][bj][m][1];
                    u32x4 w; w.x = cvt_pk_bf16(v0[0], v0[1]); w.y = cvt_pk_bf16(v0[2], v0[3]); w.z = cvt_pk_bf16(v1[0], v1[1]); w.w = cvt_pk_bf16(v1[2], v1[3]);
                    *(u32x4*)(rowp + bj * HALF) = w;
                    if (hrow) { const int slot = rr < 2 ? rr : rr - 28; *(u32x4*)(HALO + ((size_t)(r >> 5) * 4 + slot) * 2048 + col + bj * HALF) = w; } } }
    }
};
struct EpiSplit2 {
    static constexpr bool PERM = true, AFTER_DRAIN = false;
    bf16_t *O0, *O1; int ld, split_tiles;
    __device__ __forceinline__ void operator()(const f32x4 (&acc)[2][2][4][2], const Unit& u, int wr, int wc, int fr, int fq) const {
        bf16_t* base = u.pn < split_tiles ? O0 : O1; const int c0 = 256 * (u.pn < split_tiles ? u.pn : u.pn - split_tiles);
        const int row0 = u.pm * BM + wr * 64 + fr, col = c0 + wc * 32 + 8 * fq;
#pragma unroll
        for (int ai = 0; ai < 2; ++ai)
#pragma unroll
            for (int m = 0; m < 4; ++m) { bf16_t* rowp = base + (size_t)(row0 + ai * HALF + m * 16) * ld + col;
#pragma unroll
                for (int bj = 0; bj < 2; ++bj) { const f32x4 v0 = acc[ai][bj][m][0], v1 = acc[ai][bj][m][1];
                    u32x4 w; w.x = cvt_pk_bf16(v0[0], v0[1]); w.y = cvt_pk_bf16(v0[2], v0[3]); w.z = cvt_pk_bf16(v1[0], v1[1]); w.w = cvt_pk_bf16(v1[2], v1[3]);
                    *(u32x4*)(rowp + bj * HALF) = w; } }
    }
};
struct EpiSwiglu {
    static constexpr bool PERM = true, AFTER_DRAIN = false;
    bf16_t* O; int ld;
    __device__ __forceinline__ void operator()(const f32x4 (&acc)[2][2][4][2], const Unit& u, int wr, int wc, int fr, int fq) const {
        const int row0 = u.pm * BM + wr * 64 + fr, col = u.pn * HALF + wc * 32 + 8 * fq;
#pragma unroll
        for (int ai = 0; ai < 2; ++ai)
#pragma unroll
            for (int m = 0; m < 4; ++m) { bf16_t* rowp = O + (size_t)(row0 + ai * HALF + m * 16) * ld + col;
                float h[8];
#pragma unroll
                for (int n = 0; n < 2; ++n)
#pragma unroll
                    for (int j = 0; j < 4; ++j) h[4 * n + j] = fast_silu(acc[ai][0][m][n][j]) * acc[ai][1][m][n][j];
                u32x4 w; w.x = cvt_pk_bf16(h[0], h[1]); w.y = cvt_pk_bf16(h[2], h[3]); w.z = cvt_pk_bf16(h[4], h[5]); w.w = cvt_pk_bf16(h[6], h[7]);
                *(u32x4*)rowp = w; }
    }
};
struct EpiResid {
    static constexpr bool PERM = false, AFTER_DRAIN = false;
    const float *resC, *resL; float *outC, *outL; const float* gate; int row_off;
    __device__ __forceinline__ void operator()(const f32x4 (&acc)[2][2][4][2], const Unit& u, int wr, int wc, int fr, int fq) const {
        const int t0 = u.pm * BM + row_off; const float* res; float* out; const float* g; int rbase;
        if (t0 < 512) { res = resC; out = outC; g = gate; rbase = t0; }
        else { res = resL; out = outL; rbase = t0 - 512; g = gate + (size_t)(1 + (rbase >> 13)) * 6144; }
        const int row0 = rbase + wr * 64 + fr, col0 = u.pn * BM + wc * 32 + 4 * fq;
        f32x4 gv[2][2];
#pragma unroll
        for (int bj = 0; bj < 2; ++bj)
#pragma unroll
            for (int n = 0; n < 2; ++n) gv[bj][n] = *(const f32x4*)(g + col0 + bj * HALF + n * 16);
#pragma unroll
        for (int ai = 0; ai < 2; ++ai)
#pragma unroll
            for (int m = 0; m < 4; ++m) { const size_t off = (size_t)(row0 + ai * HALF + m * 16) * 1024 + col0;
#pragma unroll
                for (int bj = 0; bj < 2; ++bj)
#pragma unroll
                    for (int n = 0; n < 2; ++n) { const f32x4 bs = *(const f32x4*)(res + off + bj * HALF + n * 16);
                        *(f32x4*)(out + off + bj * HALF + n * 16) = bs + gv[bj][n] * acc[ai][bj][m][n]; }
                if (m & 1) asm volatile("" ::: "memory"); }
    }
};


template <class Epi, class Sched, bool ALIGN_EPI = false, bool SP2 = false>
__device__ __forceinline__ void gemm_phase(PG8_LAS unsigned char* lds, const Gemm g, const Sched& S, const Epi& E) {
    const int tid = threadIdx.x, wid = __builtin_amdgcn_readfirstlane(tid >> 6), lane = tid & 63, wr = wid >> 2, wc = wid & 3, fr = lane & 15, fq = lane >> 4;
    const int K = g.K, nt = K / BK;
    unsigned voffA[2], voffB[2];
#pragma unroll
    for (int i = 0; i < 2; ++i) { int R, C; stage_rc(tid * 16 + i * 8192, R, C); const int Rb = Epi::PERM ? ((R & ~31) + perm32(R & 31)) : R;
        voffA[i] = (unsigned)(R * K + C) * 2u; voffB[i] = (unsigned)(Rb * K + C) * 2u; }
    const size_t kstep = (size_t)(BK * 2);
    const size_t hstep = (size_t)HALF * K * 2;
    const size_t tstep = 2 * hstep;
    const unsigned ldsw = (unsigned)wid * 1024u;
    const int aoff = lds_byte(wr * 64 + fr, fq * 8), boff = lds_byte(wc * 32 + fr, fq * 8);
#define PG8_SA(b, h) (((b) * 2 + (h)) * HTB)
#define PG8_SB(b, h) ((4 + (b) * 2 + (h)) * HTB)
#define PG8_STAGE(bufoff, gbase, voff) do { _Pragma("unroll") for (int _i = 0; _i < 2; ++_i) \
        __builtin_amdgcn_global_load_lds((const unsigned*)((const char*)(gbase) + (voff)[_i]), (PG8_LAS unsigned*)(lds + (bufoff) + ldsw + _i * 8192), 16, 0, 0); } while (0)
#define PG8_LDA(dst, b, h) do { _Pragma("unroll") for (int m = 0; m < 4; ++m) _Pragma("unroll") for (int k = 0; k < 2; ++k) dst[m][k] = *(const PG8_LAS bf16x8*)(lds + PG8_SA(b, h) + aoff + m * 2048 + k * 1024); } while (0)
#define PG8_LDB(dst, b, h) do { _Pragma("unroll") for (int n = 0; n < 2; ++n) _Pragma("unroll") for (int k = 0; k < 2; ++k) dst[n][k] = *(const PG8_LAS bf16x8*)(lds + PG8_SB(b, h) + boff + n * 2048 + k * 1024); } while (0)
#define PG8_MMA(ai, bj, At, Bt) do { __builtin_amdgcn_s_setprio(1); _Pragma("unroll") for (int m = 0; m < 4; ++m) _Pragma("unroll") for (int n = 0; n < 2; ++n) _Pragma("unroll") for (int k = 0; k < 2; ++k) \
        acc[ai][bj][m][n] = __builtin_amdgcn_mfma_f32_16x16x32_bf16(Bt[n][k], At[m][k], acc[ai][bj][m][n], 0, 0, 0); __builtin_amdgcn_s_setprio(0); } while (0)
#define PG8_WAIT_V(n) asm volatile("s_waitcnt vmcnt(" #n ")" ::: "memory")
#define PG8_WAIT_L(n) asm volatile("s_waitcnt lgkmcnt(" #n ")" ::: "memory")
#define PG8_BAR __builtin_amdgcn_s_barrier()
#define PG8_SCHED __builtin_amdgcn_sched_barrier(0)
    Unit cur, nxt; int ui = 0;
    if (!S.next(0, cur)) return;
    f32x4 acc[2][2][4][2];
#pragma unroll
    for (int a = 0; a < 2; ++a)
#pragma unroll
        for (int b = 0; b < 2; ++b)
#pragma unroll
            for (int m = 0; m < 4; ++m)
#pragma unroll
                for (int n = 0; n < 2; ++n) acc[a][b][m][n] = (f32x4){0.f, 0.f, 0.f, 0.f};
    bf16x8 At[4][2], B0[2][2], B1[2][2];
    const char* cA = (const char*)g.A + (size_t)cur.pm * tstep; const char* cB = (const char*)g.Bt + (size_t)cur.pn * tstep;
    S.a_ready(cur);
    if constexpr (SP2) {
        PG8_STAGE(PG8_SB(0, 0), cB, voffB); PG8_STAGE(PG8_SB(0, 1), cB + hstep, voffB); PG8_STAGE(PG8_SA(0, 0), cA, voffA); PG8_STAGE(PG8_SA(0, 1), cA + hstep, voffA);
        if (wr == 1) PG8_BAR;
        PG8_WAIT_V(2); PG8_BAR;
        PG8_STAGE(PG8_SB(1, 0), cB + kstep, voffB); PG8_STAGE(PG8_SA(1, 0), cA + kstep, voffA); PG8_STAGE(PG8_SB(1, 1), cB + hstep + kstep, voffB);
        PG8_WAIT_V(6); PG8_BAR;
    } else {
        PG8_STAGE(PG8_SB(0, 0), cB, voffB); PG8_STAGE(PG8_SA(0, 0), cA, voffA); PG8_STAGE(PG8_SB(0, 1), cB + hstep, voffB); PG8_STAGE(PG8_SA(0, 1), cA + hstep, voffA);
        if (wr == 1) PG8_BAR;
        PG8_WAIT_V(4); PG8_BAR;
        PG8_STAGE(PG8_SB(1, 0), cB + kstep, voffB); PG8_STAGE(PG8_SA(1, 0), cA + kstep, voffA); PG8_STAGE(PG8_SB(1, 1), cB + hstep + kstep, voffB);
        PG8_WAIT_V(6); PG8_BAR;
    }
    for (;;) {
        const bool has_next = S.next(ui + 1, nxt);
        const char* nA = has_next ? (const char*)g.A + (size_t)nxt.pm * tstep : cA; const char* nB = has_next ? (const char*)g.Bt + (size_t)nxt.pn * tstep : cB;
        for (int t = 0; t < nt; t += 2) {
            const bool last = (t == nt - 2);
            const char* a1 = cA + (size_t)(t + 1) * kstep;
            const char* a2 = last ? nA : cA + (size_t)(t + 2) * kstep; const char* b2 = last ? nB : cB + (size_t)(t + 2) * kstep;
            const char* a3 = a2 + kstep; const char* b3 = b2 + kstep;
            if (last && has_next) S.a_ready(nxt);
            if constexpr (SP2) {
            PG8_LDB(B0, 0, 0); PG8_LDB(B1, 0, 1); PG8_SCHED; PG8_LDA(At, 0, 0); PG8_STAGE(PG8_SA(1, 1), a1 + hstep, voffA);
            PG8_WAIT_V(8); PG8_WAIT_L(0); PG8_BAR; PG8_MMA(0, 0, At, B0); PG8_MMA(0, 1, At, B1); PG8_BAR; PG8_SCHED;
            PG8_LDA(At, 0, 1); PG8_STAGE(PG8_SB(0, 0), b2, voffB); PG8_STAGE(PG8_SB(0, 1), b2 + hstep, voffB); PG8_STAGE(PG8_SA(0, 0), a2, voffA);
            PG8_WAIT_V(8); PG8_WAIT_L(0); PG8_BAR; PG8_MMA(1, 0, At, B0); PG8_MMA(1, 1, At, B1); PG8_BAR; PG8_SCHED;
            PG8_LDB(B0, 1, 0); PG8_LDB(B1, 1, 1); PG8_SCHED; PG8_LDA(At, 1, 0); PG8_STAGE(PG8_SA(0, 1), a2 + hstep, voffA);
            PG8_WAIT_V(8); PG8_WAIT_L(0); PG8_BAR; PG8_MMA(0, 0, At, B0); PG8_MMA(0, 1, At, B1); PG8_BAR; PG8_SCHED;
            PG8_LDA(At, 1, 1); PG8_STAGE(PG8_SB(1, 0), b3, voffB); PG8_STAGE(PG8_SB(1, 1), b3 + hstep, voffB); PG8_STAGE(PG8_SA(1, 0), a3, voffA);
            PG8_WAIT_V(8); PG8_WAIT_L(0); PG8_BAR; PG8_MMA(1, 0, At, B0); PG8_MMA(1, 1, At, B1); PG8_BAR; PG8_SCHED;
            } else {
            PG8_LDB(B0, 0, 0); PG8_SCHED; PG8_LDA(At, 0, 0); PG8_STAGE(PG8_SA(1, 1), a1 + hstep, voffA);
            PG8_WAIT_L(8); PG8_BAR; PG8_WAIT_L(0); PG8_MMA(0, 0, At, B0); PG8_BAR; PG8_SCHED;
            PG8_LDB(B1, 0, 1); PG8_STAGE(PG8_SB(0, 0), b2, voffB);
            PG8_BAR; PG8_WAIT_L(0); PG8_MMA(0, 1, At, B1); PG8_BAR;
            PG8_LDA(At, 0, 1); PG8_STAGE(PG8_SA(0, 0), a2, voffA);
            PG8_BAR; PG8_WAIT_L(0); PG8_MMA(1, 0, At, B0); PG8_BAR; PG8_SCHED;
            PG8_STAGE(PG8_SB(0, 1), b2 + hstep, voffB);
            PG8_WAIT_V(6); PG8_BAR; PG8_MMA(1, 1, At, B1); PG8_BAR;
            PG8_LDB(B0, 1, 0); PG8_SCHED; PG8_LDA(At, 1, 0); PG8_STAGE(PG8_SA(0, 1), a2 + hstep, voffA);
            PG8_WAIT_L(8); PG8_BAR; PG8_WAIT_L(0); PG8_MMA(0, 0, At, B0); PG8_BAR; PG8_SCHED;
            PG8_LDB(B1, 1, 1); PG8_STAGE(PG8_SB(1, 0), b3, voffB);
            PG8_BAR; PG8_WAIT_L(0); PG8_MMA(0, 1, At, B1); PG8_BAR;
            PG8_LDA(At, 1, 1); PG8_STAGE(PG8_SA(1, 0), a3, voffA);
            PG8_BAR; PG8_WAIT_L(0); PG8_MMA(1, 0, At, B0); PG8_BAR; PG8_SCHED;
            PG8_STAGE(PG8_SB(1, 1), b3 + hstep, voffB);
            PG8_WAIT_V(6); PG8_BAR; PG8_MMA(1, 1, At, B1); PG8_BAR;
            }
        }
        if constexpr (ALIGN_EPI) { if (wr == 0) PG8_BAR; }
        if constexpr (!Epi::AFTER_DRAIN) { E(acc, cur, wr, wc, fr, fq); S.done(cur); }
        if (!has_next) break;
#pragma unroll
        for (int a = 0; a < 2; ++a)
#pragma unroll
            for (int b = 0; b < 2; ++b)
#pragma unroll
                for (int m = 0; m < 4; ++m)
#pragma unroll
                    for (int n = 0; n < 2; ++n) acc[a][b][m][n] = (f32x4){0.f, 0.f, 0.f, 0.f};
        cur = nxt; cA = nA; cB = nB; ++ui;
        if constexpr (ALIGN_EPI) { if (wr == 1) PG8_BAR; }
    }
    PG8_WAIT_V(0);
    if constexpr (!ALIGN_EPI) { if (wr == 0) PG8_BAR; }
    PG8_BAR;
    if constexpr (Epi::AFTER_DRAIN) { E.fused(acc, cur, wr, wc, fr, fq, lds, wid, lane); S.done(cur); }
#undef PG8_SA
#undef PG8_SB
#undef PG8_STAGE
#undef PG8_LDA
#undef PG8_LDB
#undef PG8_MMA
#undef PG8_WAIT_V
#undef PG8_WAIT_L
#undef PG8_BAR
#undef PG8_SCHED
}
}


constexpr int NWAVES = 8;
constexpr int DM = 1024, SEQ = 8192, CTXL = 256, NB = 2;
constexpr int R = NB * (SEQ + CTXL);
constexpr int RL0 = NB * CTXL;
constexpr int MLAT = NB * SEQ;
constexpr int FFH = 2816;
constexpr int ABIN = 6160;
constexpr float RMS_EPS = 1e-6f, LN_EPS = 1e-5f;

constexpr size_t MiB = 1u << 20;
constexpr size_t WS_CTL = 0, CTL_ZERO_BYTES = 1 * MiB;
constexpr size_t CTL_MOD = 256 * 1024;
constexpr size_t WS_XCTX = 1 * MiB;
constexpr size_t WS_DTRAW = 3 * MiB, WS_DTF = WS_DTRAW + 1280 * 1024, WS_DTB = WS_DTF + 1280 * 1024, WS_CSF = WS_DTB + 1280 * 1024, WS_RB = WS_CSF + 1280 * 1024;
constexpr size_t WS_WQK = 9 * MiB + 256 * 1024;
constexpr size_t WS_HALO = 9 * MiB + 512 * 1024;
constexpr size_t WS_W_IN = 18 * MiB, WS_W_OUT = 30 * MiB, WS_W_F1 = 34 * MiB, WS_W_F2 = 45 * MiB;
constexpr size_t WS_ZG = 51 * MiB, WS_XBC = 117 * MiB, WS_QK = 183 * MiB, WS_V = 216 * MiB;
constexpr size_t WS_HF0 = WS_V, WS_HH0 = WS_XBC;
constexpr size_t WS_GATE = 3 * MiB, WS_BC = WS_GATE + 1280 * 1024, WS_AJ = WS_BC + 768 * 1024, WS_CM = WS_AJ + 768 * 1024, WS_CH = WS_CM + 768 * 1024, WS_NV = WS_CH + 256 * 1024;
constexpr size_t WS_W_UP = 10 * MiB, WS_H1 = 18 * MiB, WS_XC = 18 * MiB, WS_XM = 51 * MiB, WS_Z = 117 * MiB, WS_ST1 = 183 * MiB;
constexpr size_t WS_W_DN = 53 * MiB, WS_W_F1B = 57 * MiB, WS_W_F2B = 68 * MiB;
constexpr size_t WS_HF1 = WS_Z, WS_HH1 = 150 * MiB;
constexpr size_t WS_END = 256 * MiB;
constexpr size_t DO_H = 0, DO_ST_SSD = 0, DO_ST_RET = 32 * MiB;
constexpr int CW_TMO = 0, CW_CODE = 1, CW_BAR = 4096;

constexpr int RING_BYTES = 131072;
constexpr int SCR_BYTES = 143360;
constexpr int LDSCTL_OFF = SCR_BYTES, MISC_OFF = LDSCTL_OFF + 320;
constexpr int LDS_BYTES = 147456;

#define GAS __attribute__((address_space(1)))
#define LAS __attribute__((address_space(3)))
typedef unsigned short bf16;
typedef unsigned v4u __attribute__((ext_vector_type(4)));
typedef unsigned v2u __attribute__((ext_vector_type(2)));
typedef float f32x4 __attribute__((ext_vector_type(4)));
typedef short bf16x8 __attribute__((ext_vector_type(8)));
typedef short s16x4 __attribute__((ext_vector_type(4)));
typedef GAS unsigned gu32;
#define RLX_AGENT __ATOMIC_RELAXED, __HIP_MEMORY_SCOPE_AGENT
#define LDS_WAIT() asm volatile("s_waitcnt lgkmcnt(0)" ::: "memory")
#define VM_WAIT() asm volatile("s_waitcnt vmcnt(0)" ::: "memory")
__device__ __forceinline__ unsigned f2bf(float f) { unsigned u = __builtin_bit_cast(unsigned, f); return (u + 0x7fffu + ((u >> 16) & 1u)) >> 16; }
typedef float f32x2_t __attribute__((ext_vector_type(2)));
typedef __bf16 bf16x2_t __attribute__((ext_vector_type(2)));
__device__ __forceinline__ unsigned pk2(float lo, float hi) { f32x2_t v = {lo, hi}; bf16x2_t b = __builtin_convertvector(v, bf16x2_t); return __builtin_bit_cast(unsigned, b); }
__device__ __forceinline__ float bf2f(unsigned short h) { return __builtin_bit_cast(float, (unsigned)h << 16); }
__device__ __forceinline__ float bflo(unsigned w) { return __builtin_bit_cast(float, w << 16); }
__device__ __forceinline__ float bfhi(unsigned w) { return __builtin_bit_cast(float, w & 0xffff0000u); }
__device__ __forceinline__ float silu_f(float a) { return a * __builtin_amdgcn_rcpf(1.0f + __expf(-a)); }
__device__ __forceinline__ float softplus_f(float x) { return x > 20.f ? x : log1pf(__expf(x)); }
__device__ __forceinline__ float logsig_f(float x) { return x >= 0.f ? -log1pf(__expf(-x)) : x - log1pf(__expf(x)); }
__device__ __forceinline__ float wave_sum(float v) {
#pragma unroll
    for (int o = 1; o < 64; o <<= 1) v += __shfl_xor(v, o);
    return v;
}
__device__ __forceinline__ float wave_max(float v) {
#pragma unroll
    for (int o = 1; o < 64; o <<= 1) v = fmaxf(v, __shfl_xor(v, o));
    return v;
}

#define XB_TMO      128
#define XB_XCNT(j)  (256  + 64 * (j))
#define XB_XSUB(j)  (1280 + 64 * (j))
#define XB_XGEN(j)  (2304 + 64 * (j))
#define XB_TOP      3328
#define XB_TOPGEN   3392
#define XCD_BAR_WORDS 3456
#define XB_SPIN_CAP (1u << 18)

__device__ __forceinline__ unsigned xb_ld(unsigned* p)              { return __hip_atomic_load(p, __ATOMIC_RELAXED, __HIP_MEMORY_SCOPE_AGENT); }
__device__ __forceinline__ unsigned xb_add(unsigned* p, unsigned v) { return __hip_atomic_fetch_add(p, v, __ATOMIC_RELAXED, __HIP_MEMORY_SCOPE_AGENT); }
__device__ __forceinline__ unsigned xb_xcc_id() { return (unsigned)__builtin_amdgcn_s_getreg((3 << 11) | 20) & 0xFu; }
#define XB_SPIN(cond, bar) do { unsigned _sp = 0; while (cond) { __builtin_amdgcn_s_sleep(1); \
    if ((++_sp & 255u) == 0u) { if (xb_ld(&(bar)[XB_TMO])) break; if (_sp > XB_SPIN_CAP) { atomicAdd(&(bar)[XB_TMO], 1u); break; } } } } while (0)

struct XcdBarrier {
    unsigned* bar; unsigned x;
    volatile LAS unsigned* st;
};

__device__ __forceinline__ XcdBarrier xcd_barrier_post(unsigned* bar, volatile LAS unsigned* st) {
    XcdBarrier b; b.bar = bar; b.x = xb_xcc_id(); b.st = st;
    if (threadIdx.x == 0) (void)xb_add(&bar[XB_XCNT(b.x)], 1u);
    return b;
}
__device__ __forceinline__ void xcd_barrier_complete(unsigned* bar, unsigned x, unsigned& nloc, unsigned& nx) {
    const unsigned G = gridDim.x * gridDim.y * gridDim.z;
    unsigned sum, cnt, mine, sp = 0u;
    for (;;) {
        sum = 0u; cnt = 0u; mine = 0u;
#pragma unroll
        for (unsigned j = 0; j < 16; ++j) { const unsigned c = xb_ld(&bar[XB_XCNT(j)]); sum += c; cnt += (c > 0u) ? 1u : 0u; mine = (j == x) ? c : mine; }
        if (sum == G) break;
        __builtin_amdgcn_s_sleep(1);
        if ((++sp & 255u) == 0u) { if (xb_ld(&bar[XB_TMO])) break; if (sp > XB_SPIN_CAP) { atomicAdd(&bar[XB_TMO], 1u); break; } }
    }
    nloc = mine > 0u ? mine : 1u; nx = cnt > 0u ? cnt : 1u;
}

__device__ __forceinline__ void xcd_barrier(const XcdBarrier& b) {
    asm volatile("s_waitcnt vmcnt(0)" ::: "memory");
    __syncthreads();
    if (threadIdx.x == 0) {
        unsigned* bar = b.bar;
        __builtin_amdgcn_s_waitcnt(0);
        unsigned nloc = b.st[0], nx = b.st[1];
        if (nloc == 0u) { xcd_barrier_complete(bar, b.x, nloc, nx); b.st[0] = nloc; b.st[1] = nx; }
        const unsigned old = xb_add(&bar[XB_XSUB(b.x)], 1u);
        const unsigned gen = old / nloc;
        if (old + 1u == (gen + 1u) * nloc) {
            __builtin_amdgcn_fence(__ATOMIC_RELEASE, "agent");
            asm volatile("s_waitcnt vmcnt(0)" ::: "memory");
            const unsigned og = xb_add(&bar[XB_TOP], 1u);
            const unsigned tg = og / nx;
            if (og + 1u == (tg + 1u) * nx) xb_add(&bar[XB_TOPGEN], 1u);
            else XB_SPIN(xb_ld(&bar[XB_TOPGEN]) == tg, bar);
            __builtin_amdgcn_fence(__ATOMIC_ACQUIRE, "agent");
            xb_add(&bar[XB_XGEN(b.x)], 1u);
            asm volatile("s_waitcnt vmcnt(0)" ::: "memory");
        } else {
            XB_SPIN(xb_ld(&bar[XB_XGEN(b.x)]) == gen, bar);
            __builtin_amdgcn_fence(__ATOMIC_ACQUIRE, "agent");
            asm volatile("s_waitcnt vmcnt(0)" ::: "memory");
        }
    }
    __syncthreads();
}


struct Args { const float* in[35]; float* out; unsigned char* ws; int ph_lo, ph_hi; };
enum { I_X = 0, I_C, I_CTX, I_CCTX, I_ADAW, I_ADAB, I_NMIX, I_NFFN, I_W1, I_W3, I_W2, I_ABIN, I_ABCW, I_ABCB, I_DTBF, I_DTBB, I_ALF, I_ALB, I_SSDD, I_SSDNW,
       I_RLF, I_RLB, I_ABOUT, I_MLUP, I_MLCW, I_MLCB, I_MLWQ, I_MLWK, I_MLWV, I_MLGW, I_MLGB, I_MLNW, I_MLSKIP, I_MLDOWN, I_FNW };

__device__ __forceinline__ void transpose_item(const float* W, int ldw, int K, bf16* WT, int kb, int src_n0, int dst_n0, LAS float* scr, int lane) {
    const int k0 = 64 * kb;
#pragma unroll 8
    for (int i = 0; i < 32; ++i) { const int kk = 2 * i + (lane >> 5); scr[kk * 33 + (lane & 31)] = W[(size_t)(k0 + kk) * ldw + src_n0 + (lane & 31)]; }
    LDS_WAIT(); asm volatile("" ::: "memory");
    const int c = lane & 7;
#pragma unroll
    for (int j = 0; j < 4; ++j) { const int n = (lane >> 3) + 8 * j; const LAS float* s = scr + (8 * c) * 33 + n;
        v4u o; o.x = pk2(s[0 * 33], s[1 * 33]); o.y = pk2(s[2 * 33], s[3 * 33]); o.z = pk2(s[4 * 33], s[5 * 33]); o.w = pk2(s[6 * 33], s[7 * 33]);
        *(GAS v4u*)(WT + (size_t)(dst_n0 + n) * K + k0 + 8 * c) = o; }
    LDS_WAIT(); asm volatile("" ::: "memory");
}
__device__ __forceinline__ void conv_plain(const float* W, int K, int N, bf16* WT, LAS float* scr, int gw, int NGW, int lane) {
    const int nblk = N / 32, nit = (K / 64) * nblk;
    for (int it = gw; it < nit; it += NGW) { const int kb = it / nblk, nb = it % nblk; transpose_item(W, N, K, WT, kb, 32 * nb, 32 * nb, scr, lane); }
}
__device__ __forceinline__ void conv_ffn1(const float* w1, const float* w3, bf16* WT, LAS float* scr, int gw, int NGW, int lane) {
    const int nblk = 5632 / 32, nit = (1024 / 64) * nblk;
    for (int it = gw; it < nit; it += NGW) { const int kb = it / nblk, nb = it % nblk; const int n0 = 32 * nb, pn = n0 >> 8, within = n0 & 255;
        const float* W = within < 128 ? w1 : w3; const int sc = 128 * pn + (within & 127);
        transpose_item(W, FFH, 1024, WT, kb, sc, n0, scr, lane); }
}
__device__ __forceinline__ void conv_abin(const float* W, bf16* WT, LAS float* scr, int gw, int NGW, int lane) {
    const int nblk = 6144 / 32, nit = (1024 / 64) * nblk;
    for (int it = gw; it < nit; it += NGW) { const int kb = it / nblk, nb = it % nblk; const int n0 = 32 * nb;
        transpose_item(W, ABIN, 1024, WT, kb, n0 + (n0 >= 3072 ? 16 : 0), n0, scr, lane); }
}

template <bool WITH_DT>
__device__ __forceinline__ void norm_rows(const float* srcC, const float* srcL, const float* w, const float* mod, int si, bf16* dst, int dst_off, int row_lo, int row_hi,
                                          int gw, int NGW, int lane, const LAS float* wdt, float* dtraw) {
    for (int m = row_lo + gw; m < row_hi; m += NGW) {
        const float* src = m < RL0 ? srcC + (size_t)m * DM : srcL + (size_t)(m - RL0) * DM;
        const float* mv = mod + (size_t)(m < RL0 ? 0 : 1 + ((m - RL0) >> 13)) * 6144 + si * 1024;
        f32x4 v[4]; float ss = 0.f;
#pragma unroll
        for (int j = 0; j < 4; ++j) { v[j] = *(const f32x4*)(src + 4 * lane + 256 * j); ss += (v[j].x * v[j].x + v[j].y * v[j].y) + (v[j].z * v[j].z + v[j].w * v[j].w); }
        const float rstd = 1.0f / sqrtf(wave_sum(ss) * (1.f / DM) + RMS_EPS);
#pragma unroll
        for (int j = 0; j < 4; ++j) { const int c = 4 * lane + 256 * j; const f32x4 wv = *(const f32x4*)(w + c), sh = *(const f32x4*)(mv + c), sc = *(const f32x4*)(mv + 1024 + c);
            v[j] = (v[j] * rstd * wv) * (sc + 1.0f) + sh;
            v2u o; o.x = pk2(v[j].x, v[j].y); o.y = pk2(v[j].z, v[j].w);
            *(v2u*)(dst + (size_t)(m - dst_off) * DM + c) = o; }
        if constexpr (WITH_DT) {
            float d[16];
#pragma unroll
            for (int c = 0; c < 16; ++c) { float a = 0.f;
#pragma unroll
                for (int j = 0; j < 4; ++j) { const f32x4 ww = *(const LAS f32x4*)(wdt + c * 1024 + 4 * lane + 256 * j); a += v[j].x * ww.x + v[j].y * ww.y + v[j].z * ww.z + v[j].w * ww.w; }
                d[c] = a; asm volatile("" ::: "memory"); }
            float mine = 0.f;
#pragma unroll
            for (int c = 0; c < 16; ++c) { const float s = wave_sum(d[c]); if (lane == c) mine = s; }
            if (lane < 16) dtraw[(size_t)m * 16 + lane] = mine;
        }
    }
}


#define MFMA16(a, b, c) __builtin_amdgcn_mfma_f32_16x16x32_bf16(a, b, c, 0, 0, 0)
__device__ __forceinline__ bf16x8 frag_nat(const LAS unsigned char* base, int pitch, int r0, int k0, int lane) {
    return *(const LAS bf16x8*)(base + (r0 + (lane & 15)) * pitch + (k0 + 8 * (lane >> 4)) * 2);
}
__device__ __forceinline__ bf16x8 frag_tr(const LAS unsigned char* base, int pitch, int k0, int i0, int lane) {
    const int g = lane >> 4, q = (lane & 15) >> 2, p = lane & 3;
    const LAS unsigned char* a = base + (k0 + 8 * g + q) * pitch + (i0 + 4 * p) * 2;
    const s16x4 lo = __builtin_bit_cast(s16x4, __builtin_amdgcn_ds_read_tr16_b64_v4i16((LAS s16x4*)a));
    const s16x4 hi = __builtin_bit_cast(s16x4, __builtin_amdgcn_ds_read_tr16_b64_v4i16((LAS s16x4*)(a + 4 * pitch)));
    bf16x8 r; r[0] = lo[0]; r[1] = lo[1]; r[2] = lo[2]; r[3] = lo[3]; r[4] = hi[0]; r[5] = hi[1]; r[6] = hi[2]; r[7] = hi[3]; return r;
}
__device__ __forceinline__ v2u pack4(f32x4 v) { v2u o; o.x = pk2(v.x, v.y); o.y = pk2(v.z, v.w); return o; }
__device__ __forceinline__ f32x4 unpack4(v2u w) { f32x4 r; r.x = bflo(w.x); r.y = bfhi(w.x); r.z = bflo(w.y); r.w = bfhi(w.y); return r; }
__device__ __forceinline__ v4u scale8(v4u x, float s) { v4u o; o.x = pk2(bflo(x.x) * s, bfhi(x.x) * s); o.y = pk2(bflo(x.y) * s, bfhi(x.y) * s); o.z = pk2(bflo(x.z) * s, bfhi(x.z) * s); o.w = pk2(bflo(x.w) * s, bfhi(x.w) * s); return o; }

__device__ __forceinline__ void chunk_rows(int ci, int& base, int& L) { L = 256; base = ci < 2 ? 256 * ci : RL0 + 256 * (ci - 2); }

__device__ __forceinline__ void conv8(const v4u (&x)[5], const float (&cw)[5][8], const float (&cb)[8], v4u& out) {
    float o[8];
#pragma unroll
    for (int c = 0; c < 8; ++c) o[c] = cb[c];
#pragma unroll
    for (int k = 0; k < 5; ++k) { const v4u v = x[k];
        o[0] += cw[k][0] * bflo(v.x); o[1] += cw[k][1] * bfhi(v.x); o[2] += cw[k][2] * bflo(v.y); o[3] += cw[k][3] * bfhi(v.y);
        o[4] += cw[k][4] * bflo(v.z); o[5] += cw[k][5] * bfhi(v.z); o[6] += cw[k][6] * bflo(v.w); o[7] += cw[k][7] * bfhi(v.w); }
#pragma unroll
    for (int c = 0; c < 8; ++c) o[c] = silu_f(o[c]);
    out.x = pk2(o[0], o[1]); out.y = pk2(o[2], o[3]); out.z = pk2(o[4], o[5]); out.w = pk2(o[6], o[7]);
}
__device__ __forceinline__ void phase_l0_prep(const Args& args, unsigned char* ws, LAS unsigned char* lds, int tid, int lane, int wave, int bx, int G, int gw, int NGW) {
    bf16* XBC = (bf16*)(ws + WS_XBC); const bf16* HALO = (const bf16*)(ws + WS_HALO);
    {
        const int cg = tid & 255, c0 = 8 * cg;
        float cw[5][8], cb[8];
#pragma unroll
        for (int k = 0; k < 5; ++k)
#pragma unroll
            for (int c = 0; c < 8; ++c) cw[k][c] = args.in[I_ABCW][k * 2048 + c0 + c];
#pragma unroll
        for (int c = 0; c < 8; ++c) cb[c] = args.in[I_ABCB][c0 + c];
        for (int u = bx; u < 264; u += G) {
            const int blk = 2 * u + (tid >> 8), r0 = 32 * blk;
            int slo, shi; if (r0 < RL0) { slo = r0 & ~255; shi = slo + 256; } else { slo = RL0 + ((r0 - RL0) & ~8191); shi = slo + 8192; }
            const v4u zero = (v4u){0u, 0u, 0u, 0u};
            v4u raw[20];
            raw[0] = r0 > slo ? *(const v4u*)(HALO + ((size_t)(blk - 1) * 4 + 2) * 2048 + c0) : zero;
            raw[1] = r0 > slo ? *(const v4u*)(HALO + ((size_t)(blk - 1) * 4 + 3) * 2048 + c0) : zero;
#pragma unroll
            for (int t = 0; t < 18; ++t) raw[2 + t] = *(const v4u*)(XBC + (size_t)(r0 + t) * 2048 + c0);
#pragma unroll
            for (int t = 0; t < 16; ++t) { v4u x5[5] = {raw[t], raw[t + 1], raw[t + 2], raw[t + 3], raw[t + 4]}; v4u o; conv8(x5, cw, cb, o); *(v4u*)(XBC + (size_t)(r0 + t) * 2048 + c0) = o; }
            raw[0] = raw[16]; raw[1] = raw[17]; raw[2] = raw[18]; raw[3] = raw[19];
#pragma unroll
            for (int t = 0; t < 14; ++t) raw[4 + t] = *(const v4u*)(XBC + (size_t)(r0 + 18 + t) * 2048 + c0);
            raw[18] = r0 + 32 < shi ? *(const v4u*)(HALO + ((size_t)(blk + 1) * 4 + 0) * 2048 + c0) : zero;
            raw[19] = r0 + 32 < shi ? *(const v4u*)(HALO + ((size_t)(blk + 1) * 4 + 1) * 2048 + c0) : zero;
#pragma unroll
            for (int t = 0; t < 16; ++t) { v4u x5[5] = {raw[t], raw[t + 1], raw[t + 2], raw[t + 3], raw[t + 4]}; v4u o; conv8(x5, cw, cb, o); *(v4u*)(XBC + (size_t)(r0 + 16 + t) * 2048 + c0) = o; }
        }
    }
    {
        bf16* QK = (bf16*)(ws + WS_QK);
        const float inv = exp2f(-(float)(lane & 31) * (13.287712379549449f / 32.0f));
        for (int m = gw; m < R; m += NGW) {
            bf16* row = QK + (size_t)m * 1024;
            float cs = 1.f, sn = 0.f;
            if (m >= RL0) { const int t = (m - RL0) & 8191; const float ang = (float)(lane < 32 ? (t >> 6) : (t & 63)) * inv; sincosf(ang, &sn, &cs); }
#pragma unroll
            for (int hh = 0; hh < 8; ++hh) { const float x1 = bf2f(row[128 * hh + lane]), x2 = bf2f(row[128 * hh + 64 + lane]); const float sc = hh >= 4 ? 0.08838834764831845f : 1.0f;
                row[128 * hh + lane] = (bf16)f2bf((x1 * cs - x2 * sn) * sc); row[128 * hh + 64 + lane] = (bf16)f2bf((x1 * sn + x2 * cs) * sc); }
        }
    }
    {
        const float* dtraw = (const float*)(ws + WS_DTRAW); float* DTF = (float*)(ws + WS_DTF); float* DTB = (float*)(ws + WS_DTB); float* CSF = (float*)(ws + WS_CSF); float* RBA = (float*)(ws + WS_RB);
        for (int wu = gw; wu < 66 * 16; wu += NGW) {
            const int ci = wu >> 4, h = wu & 15; int base, L; chunk_rows(ci, base, L);
            const float bf_ = args.in[I_DTBF][h], bb_ = args.in[I_DTBB][h], af = __expf(args.in[I_ALF][h]), ab = __expf(args.in[I_ALB][h]);
            const int per = L >> 6, t0 = lane * per;
            float dtf[8], dtb[8], laf[8], lab[8]; float sf = 0.f, sb = 0.f;
#pragma unroll
            for (int t = 0; t < 8; ++t) if (t < per) { const float rawv = dtraw[(size_t)(base + t0 + t) * 16 + h]; dtf[t] = softplus_f(rawv + bf_); dtb[t] = softplus_f(rawv + bb_); laf[t] = -dtf[t] * af; lab[t] = -dtb[t] * ab; sf += laf[t]; sb += lab[t]; }
            float pf = sf, pb = sb;
#pragma unroll
            for (int o = 1; o < 64; o <<= 1) { const float a = __shfl_up(pf, o), c = __shfl_down(pb, o); if (lane >= o) pf += a; if (lane + o < 64) pb += c; }
            float runf = pf - sf;
#pragma unroll
            for (int t = 0; t < 8; ++t) if (t < per) { runf += laf[t]; const size_t o = (size_t)(base + t0 + t) * 16 + h; CSF[o] = runf; DTF[o] = dtf[t]; DTB[o] = dtb[t]; }
            float runb = pb - sb;
#pragma unroll
            for (int t = 7; t >= 0; --t) if (t < per) { runb += lab[t]; RBA[(size_t)(base + t0 + t) * 16 + h] = runb; }
        }
    }
}

constexpr int SCAN_PITCH = 144;
__device__ __forceinline__ void phase_l0_scan(const Args& args, unsigned char* ws, unsigned char* dob, LAS unsigned char* lds, int tid, int lane, int wave, int bx, int G) {
    LAS unsigned char* Kt = lds; LAS unsigned char* Vt = lds + 128 * SCAN_PITCH; LAS float* TB = (LAS float*)(lds + 256 * SCAN_PITCH);
    const float* DTF = (const float*)(ws + WS_DTF); const float* DTB = (const float*)(ws + WS_DTB); const float* CSF = (const float*)(ws + WS_CSF); const float* RBA = (const float*)(ws + WS_RB);
    for (int u = bx; u < 256; u += G) {
        const bool ssd = u < 128; int b, dir, h; const bf16* Ksrc; const bf16* Vsrc; int ld; bf16* Sout; float lg = 0.f;
        if (ssd) { const int s = u >> 1, nt = u & 1; b = s >> 5; dir = (s >> 4) & 1; h = s & 15; ld = 2048;
            Ksrc = (const bf16*)(ws + WS_XBC) + 1024 + 128 * (h >> 2) + 64 * nt; Vsrc = (const bf16*)(ws + WS_XBC) + 64 * h;
            Sout = (bf16*)(dob + DO_ST_SSD) + (size_t)s * 32 * 8192 + 64 * nt; }
        else { const int v = u - 128, s = v >> 3, t = v & 7, et = t >> 1, dt = t & 1; b = s >> 3; dir = (s >> 2) & 1; h = s & 3; ld = 1024;
            Ksrc = (const bf16*)(ws + WS_QK) + 512 + 128 * h + 64 * dt; Vsrc = (const bf16*)(ws + WS_V) + 256 * h + 64 * et;
            Sout = (bf16*)(dob + DO_ST_RET) + (size_t)s * 32 * 32768 + (size_t)(64 * et) * 128 + 64 * dt;
            lg = logsig_f(args.in[dir ? I_RLB : I_RLF][h]); }
        const size_t kstride = ssd ? 8192 : 32768;
        const int wd = wave & 3, we = wave >> 2;
        __syncthreads();
        if (tid < 33) { const int stp = tid; int base; const int L = 256; if (stp == 0) { base = 256 * b; } else { const int k = dir ? 32 - stp : stp - 1; base = RL0 + 8192 * b + 256 * k; }
            float wref = 0.f, A;
            if (ssd) { wref = dir ? RBA[(size_t)base * 16 + h] : CSF[(size_t)(base + L - 1) * 16 + h]; A = __expf(wref); } else A = __expf((float)L * lg);
            TB[stp] = wref; TB[64 + stp] = A; }
        __syncthreads();
        f32x4 acc[2] = {(f32x4){0.f, 0.f, 0.f, 0.f}, (f32x4){0.f, 0.f, 0.f, 0.f}};
        const int srow = tid >> 2, sc16 = tid & 3;
        const bf16* kp = Ksrc + 16 * sc16; const bf16* vp = Vsrc + 16 * sc16;
#define L0S_STP(si) ((si) >> 1)
#define L0S_LOAD(si, K0, K1, V0, V1, W) do { const int stp_ = L0S_STP(si), t0_ = 128 * ((si) & 1); int r_; const int L_ = 256; \
            if (stp_ == 0) { r_ = 256 * b + t0_ + srow; } else { const int kq_ = dir ? 32 - stp_ : stp_ - 1; r_ = RL0 + 8192 * b + 256 * kq_ + t0_ + srow; } \
            const int jl_ = t0_ + srow; \
            if (ssd) W = dir ? __expf(TB[stp_] - RBA[(size_t)r_ * 16 + h]) * DTB[(size_t)r_ * 16 + h] : __expf(TB[stp_] - CSF[(size_t)r_ * 16 + h]) * DTF[(size_t)r_ * 16 + h]; \
            else W = dir ? __expf((float)jl_ * lg) : __expf((float)(L_ - 1 - jl_) * lg); \
            K0 = *(const v4u*)(kp + (size_t)r_ * ld); K1 = *(const v4u*)(kp + (size_t)r_ * ld + 8); V0 = *(const v4u*)(vp + (size_t)r_ * ld); V1 = *(const v4u*)(vp + (size_t)r_ * ld + 8); } while (0)
#define L0S_STORE(kidx) do { _Pragma("unroll") for (int t2 = 0; t2 < 2; ++t2) { const int e = 32 * we + 16 * t2 + (lane & 15), d = 16 * wd + 4 * (lane >> 4); \
            *(v2u*)(Sout + (size_t)(kidx) * kstride + (size_t)e * 128 + d) = pack4(acc[t2]); } } while (0)
#define L0S_STEP(si, K0, K1, V0, V1, W) do { const int stp_ = L0S_STP(si); \
            if (((si) & 1) == 0) { if (stp_ >= 1) L0S_STORE(dir ? 32 - stp_ : stp_ - 1); const float A_ = TB[64 + stp_]; acc[0] = acc[0] * A_; acc[1] = acc[1] * A_; } \
            __syncthreads(); \
            *(LAS v4u*)(Kt + srow * SCAN_PITCH + 32 * sc16) = scale8(K0, W); *(LAS v4u*)(Kt + srow * SCAN_PITCH + 32 * sc16 + 16) = scale8(K1, W); \
            *(LAS v4u*)(Vt + srow * SCAN_PITCH + 32 * sc16) = V0; *(LAS v4u*)(Vt + srow * SCAN_PITCH + 32 * sc16 + 16) = V1; \
            __syncthreads(); \
            if ((si) + 4 < 64) L0S_LOAD((si) + 4, K0, K1, V0, V1, W); \
            _Pragma("unroll") for (int kk = 0; kk < 4; ++kk) { const bf16x8 a = frag_tr(Kt, SCAN_PITCH, 32 * kk, 16 * wd, lane); \
                _Pragma("unroll") for (int t2 = 0; t2 < 2; ++t2) { const bf16x8 bb = frag_tr(Vt, SCAN_PITCH, 32 * kk, 32 * we + 16 * t2, lane); acc[t2] = MFMA16(a, bb, acc[t2]); } } } while (0)
        v4u ka0, ka1, va0, va1, kb0, kb1, vb0, vb1, kc0, kc1, vc0, vc1, kd0, kd1, vd0, vd1; float wa, wb, wc, wd_;
        L0S_LOAD(0, ka0, ka1, va0, va1, wa); L0S_LOAD(1, kb0, kb1, vb0, vb1, wb); L0S_LOAD(2, kc0, kc1, vc0, vc1, wc); L0S_LOAD(3, kd0, kd1, vd0, vd1, wd_);
#pragma unroll 1
        for (int si = 0; si < 64; si += 4) { L0S_STEP(si, ka0, ka1, va0, va1, wa); L0S_STEP(si + 1, kb0, kb1, vb0, vb1, wb); L0S_STEP(si + 2, kc0, kc1, vc0, vc1, wc); L0S_STEP(si + 3, kd0, kd1, vd0, vd1, wd_); }
        L0S_STORE(dir ? 0 : 31);
#undef L0S_STP
#undef L0S_LOAD
#undef L0S_STORE
#undef L0S_STEP
    }
    __syncthreads();
}


constexpr int Y_KT = 0, Y_VT = 17408, Y_MT = 51200, Y_SC = 69632, Y_ST = 73728;
constexpr int P272 = 272, P528 = 528, P144 = 144;
__device__ __forceinline__ void phase_l0_y(const Args& args, unsigned char* ws, unsigned char* dob, LAS unsigned char* lds, int tid0, int lane0, int wave, int bx, int G, unsigned long long& tacc, bool dry = false) {
#ifndef YSEC
#define YSEC -1
#endif
    unsigned long long ytm0 = 0ull; int ycur0 = -1;
#define YT0(n) do { if (YSEC >= 10) { const unsigned long long now_ = __builtin_amdgcn_s_memrealtime(); if (ycur0 == YSEC) tacc += now_ - ytm0; ytm0 = now_; ycur0 = (n); } } while (0)

    LAS unsigned char* Kt = lds + Y_KT; LAS unsigned char* Vt = lds + Y_VT; LAS unsigned char* Mt = lds + Y_MT; LAS float* SC = (LAS float*)(lds + Y_SC); LAS unsigned char* St = lds + Y_ST;
    bf16* ZG = (bf16*)(ws + WS_ZG); const bf16* XBC = (const bf16*)(ws + WS_XBC); const bf16* QK = (const bf16*)(ws + WS_QK); const bf16* VV = (const bf16*)(ws + WS_V);
    const float* DTF = (const float*)(ws + WS_DTF); const float* DTB = (const float*)(ws + WS_DTB); const float* CSF = (const float*)(ws + WS_CSF); const float* RBA = (const float*)(ws + WS_RB);
    for (int u = bx; u < 1056; u += G) {
        int tid = tid0, lane = lane0; asm volatile("" : "+v"(tid), "+v"(lane));
        const int fr = lane & 15, fq = lane >> 4;
        bool ssd; int grp, b, rbk;
        if (u < 1024) { ssd = u < 512; const int idx = u & 511; grp = idx & 3; const int br = idx >> 2; b = br >> 6; rbk = 2 + (br & 63); }
        else { const int idx = u - 1024; ssd = idx < 16; const int i2 = idx & 15; grp = i2 & 3; b = (i2 >> 2) & 1; rbk = i2 >> 3; }
        int cb0, L, i0, kchunk = -1;
        L = 256; if (rbk < 2) { cb0 = 256 * b; i0 = 128 * rbk; } else { const int lk = rbk - 2; kchunk = lk >> 1; cb0 = RL0 + 8192 * b + 256 * kchunk; i0 = 128 * (lk & 1); }
        const int il = i0 + 16 * wave + fr;
        const int row = cb0 + il;
        const int nkb = L >> 6;
        if (ssd) {
            YT0(10);
            const int g = grp;
            bf16x8 cf[4];
#pragma unroll
            for (int kk = 0; kk < 4; ++kk) cf[kk] = *(const bf16x8*)(XBC + (size_t)row * 2048 + 1536 + 128 * g + 32 * kk + 8 * fq);
            float csi[4], rbi[4];
#pragma unroll
            for (int hh = 0; hh < 4; ++hh) { csi[hh] = CSF[(size_t)row * 16 + 4 * g + hh]; rbi[hh] = RBA[(size_t)row * 16 + 4 * g + hh]; }
            f32x4 acc[4][4];
#pragma unroll
            for (int hh = 0; hh < 4; ++hh)
#pragma unroll
                for (int pt = 0; pt < 4; ++pt) acc[hh][pt] = (f32x4){0.f, 0.f, 0.f, 0.f};
            const int Rw = (i0 >> 4) + wave;
            v4u pk[2], pv[4];
#define SSD_LOAD(kbv) do { const int krow0_ = cb0 + 64 * (kbv); \
                _Pragma("unroll") for (int c = 0; c < 2; ++c) { const int ch = tid + 512 * c, r = ch >> 4, cc = ch & 15; pk[c] = *(const v4u*)(XBC + (size_t)(krow0_ + r) * 2048 + 1024 + 128 * g + 8 * cc); } \
                _Pragma("unroll") for (int c = 0; c < 4; ++c) { const int ch = tid + 512 * c, r = ch >> 5, cc = ch & 31; pv[c] = *(const v4u*)(XBC + (size_t)(krow0_ + r) * 2048 + 256 * g + 8 * cc); } \
                } while (0)
            SSD_LOAD(0);
            for (int kb = 0; kb < nkb; ++kb) {
                __syncthreads();
#pragma unroll
                for (int c = 0; c < 2; ++c) { const int ch = tid + 512 * c, r = ch >> 4, cc = ch & 15; *(LAS v4u*)(Kt + r * P272 + 16 * cc) = pk[c]; }
#pragma unroll
                for (int c = 0; c < 4; ++c) { const int ch = tid + 512 * c, r = ch >> 5, cc = ch & 31; *(LAS v4u*)(Vt + r * P528 + 16 * cc) = pv[c]; }
                if (tid < 256) { const int r = tid >> 2, hh = tid & 3; const size_t o = (size_t)(cb0 + 64 * kb + r) * 16 + 4 * g + hh; SC[0 * 256 + hh * 64 + r] = CSF[o]; SC[1 * 256 + hh * 64 + r] = RBA[o]; SC[2 * 256 + hh * 64 + r] = DTF[o]; SC[3 * 256 + hh * 64 + r] = DTB[o]; }
                __syncthreads();
                if (kb + 1 < nkb) SSD_LOAD(kb + 1);
                f32x4 Gt[4];
#pragma unroll
                for (int t = 0; t < 4; ++t) { Gt[t] = (f32x4){0.f, 0.f, 0.f, 0.f};
#pragma unroll
                    for (int kk = 0; kk < 4; ++kk) Gt[t] = MFMA16(frag_nat(Kt, P272, 16 * t, 32 * kk, lane), cf[kk], Gt[t]); }
#pragma unroll
                for (int hh = 0; hh < 4; ++hh) {
#pragma unroll
                    for (int t = 0; t < 4; ++t) { f32x4 m; const int T = 4 * kb + t; const int so = hh * 64 + 16 * t + 4 * fq;
                        if (T < Rw) { const f32x4 csj = *(const LAS f32x4*)(SC + so), dtj = *(const LAS f32x4*)(SC + 512 + so);
#pragma unroll
                            for (int r = 0; r < 4; ++r) m[r] = Gt[t][r] * __expf(csi[hh] - csj[r]) * dtj[r]; }
                        else if (T > Rw) { const f32x4 rbj = *(const LAS f32x4*)(SC + 256 + so), dtj = *(const LAS f32x4*)(SC + 768 + so);
#pragma unroll
                            for (int r = 0; r < 4; ++r) m[r] = Gt[t][r] * __expf(rbi[hh] - rbj[r]) * dtj[r]; }
                        else { const f32x4 csj = *(const LAS f32x4*)(SC + so), rbj = *(const LAS f32x4*)(SC + 256 + so), dfj = *(const LAS f32x4*)(SC + 512 + so), dbj = *(const LAS f32x4*)(SC + 768 + so);
#pragma unroll
                            for (int r = 0; r < 4; ++r) { const int jj = 4 * fq + r;
                                const float x = jj < fr ? csi[hh] - csj[r] : (jj > fr ? rbi[hh] - rbj[r] : 0.f);
                                const float sv = jj < fr ? dfj[r] : (jj > fr ? dbj[r] : dfj[r] + dbj[r]);
                                m[r] = Gt[t][r] * __expf(x) * sv; } }
                        *(LAS v2u*)(Mt + (16 * wave + fr) * P144 + (16 * t + 4 * fq) * 2) = pack4(m); }
                    LDS_WAIT();
#pragma unroll
                    for (int kk2 = 0; kk2 < 2; ++kk2) { const bf16x8 mb = frag_nat(Mt, P144, 16 * wave, 32 * kk2, lane);
#pragma unroll
                        for (int pt = 0; pt < 4; ++pt) acc[hh][pt] = MFMA16(frag_tr(Vt, P528, 32 * kk2, 64 * hh + 16 * pt, lane), mb, acc[hh][pt]); }
                }
            }
#undef SSD_LOAD
            YT0(11);
            if (kchunk >= 0) {
#pragma unroll 1
                for (int hh = 0; hh < 4; ++hh) {
                    const int h = 4 * g + hh;
                    __syncthreads();
#pragma unroll
                    for (int dir = 0; dir < 2; ++dir) { const bf16* S = (const bf16*)(dob + DO_ST_SSD) + ((size_t)(b * 32 + dir * 16 + h) * 32 + kchunk) * 8192;
#pragma unroll
                        for (int c = 0; c < 2; ++c) { const int ch = tid + 512 * c, r = ch >> 4, cc = ch & 15; *(LAS v4u*)(St + dir * 17408 + r * P272 + 16 * cc) = *(const v4u*)(S + r * 128 + 8 * cc); } }
                    __syncthreads();
                    float Ei[2] = {__expf(csi[0]), __expf(rbi[0])};
                    if (hh == 1) { Ei[0] = __expf(csi[1]); Ei[1] = __expf(rbi[1]); } else if (hh == 2) { Ei[0] = __expf(csi[2]); Ei[1] = __expf(rbi[2]); } else if (hh == 3) { Ei[0] = __expf(csi[3]); Ei[1] = __expf(rbi[3]); }
#pragma unroll
                    for (int dir = 0; dir < 2; ++dir)
#pragma unroll
                        for (int pt = 0; pt < 4; ++pt) { f32x4 T = (f32x4){0.f, 0.f, 0.f, 0.f};
#pragma unroll
                            for (int kk = 0; kk < 4; ++kk) T = MFMA16(frag_nat(St + dir * 17408, P272, 16 * pt, 32 * kk, lane), cf[kk], T);
                            const f32x4 add = T * Ei[dir];
                            if (hh == 0) acc[0][pt] += add; else if (hh == 1) acc[1][pt] += add; else if (hh == 2) acc[2][pt] += add; else acc[3][pt] += add; }
                }
            }
            YT0(12);
            float ssq = 0.f;
#pragma unroll
            for (int hh = 0; hh < 4; ++hh) { const float dsk = args.in[I_SSDD][4 * g + hh];
#pragma unroll
                for (int pt = 0; pt < 4; ++pt) { const int ch = 256 * g + 64 * hh + 16 * pt + 4 * fq;
                    const f32x4 xs = unpack4(*(const v2u*)(XBC + (size_t)row * 2048 + ch)), zz = unpack4(*(const v2u*)(ZG + (size_t)row * 2048 + ch));
                    f32x4 y = acc[hh][pt] + xs * dsk;
                    y.x *= silu_f(zz.x); y.y *= silu_f(zz.y); y.z *= silu_f(zz.z); y.w *= silu_f(zz.w);
                    acc[hh][pt] = y; ssq += (y.x * y.x + y.y * y.y) + (y.z * y.z + y.w * y.w); } }
            YT0(17);
            ssq += __shfl_xor(ssq, 16); ssq += __shfl_xor(ssq, 32);
            const float rstd = 1.0f / sqrtf(ssq * (1.f / 256.f) + RMS_EPS);
#pragma unroll
            for (int hh = 0; hh < 4; ++hh)
#pragma unroll
                for (int pt = 0; pt < 4; ++pt) { const int ch = 256 * g + 64 * hh + 16 * pt + 4 * fq; const f32x4 nw = *(const f32x4*)(args.in[I_SSDNW] + ch);
                    if (!dry) *(v2u*)(ZG + (size_t)row * 2048 + ch) = pack4(acc[hh][pt] * rstd * nw); }
            YT0(16);
        } else {
            YT0(13);
            const int h = grp;
            const float lgf = logsig_f(args.in[I_RLF][h]), lgb = logsig_f(args.in[I_RLB][h]);
            bf16x8 qf[4];
#pragma unroll
            for (int kk = 0; kk < 4; ++kk) qf[kk] = *(const bf16x8*)(QK + (size_t)row * 1024 + 128 * h + 32 * kk + 8 * fq);
            f32x4 acc[16];
#pragma unroll
            for (int et = 0; et < 16; ++et) acc[et] = (f32x4){0.f, 0.f, 0.f, 0.f};
            const int Rw = (i0 >> 4) + wave;
            v4u pk[2], pv[4];
#define RET_LOAD(kbv) do { const int krow0_ = cb0 + 64 * (kbv); \
                _Pragma("unroll") for (int c = 0; c < 2; ++c) { const int ch = tid + 512 * c, r = ch >> 4, cc = ch & 15; pk[c] = *(const v4u*)(QK + (size_t)(krow0_ + r) * 1024 + 512 + 128 * h + 8 * cc); } \
                _Pragma("unroll") for (int c = 0; c < 4; ++c) { const int ch = tid + 512 * c, r = ch >> 5, cc = ch & 31; pv[c] = *(const v4u*)(VV + (size_t)(krow0_ + r) * 1024 + 256 * h + 8 * cc); } } while (0)
            RET_LOAD(0);
            for (int kb = 0; kb < nkb; ++kb) {
                __syncthreads();
#pragma unroll
                for (int c = 0; c < 2; ++c) { const int ch = tid + 512 * c, r = ch >> 4, cc = ch & 15; *(LAS v4u*)(Kt + r * P272 + 16 * cc) = pk[c]; }
#pragma unroll
                for (int c = 0; c < 4; ++c) { const int ch = tid + 512 * c, r = ch >> 5, cc = ch & 31; *(LAS v4u*)(Vt + r * P528 + 16 * cc) = pv[c]; }
                __syncthreads();
                if (kb + 1 < nkb) RET_LOAD(kb + 1);
#pragma unroll
                for (int t = 0; t < 4; ++t) { f32x4 Gt = (f32x4){0.f, 0.f, 0.f, 0.f};
#pragma unroll
                    for (int kk = 0; kk < 4; ++kk) Gt = MFMA16(frag_nat(Kt, P272, 16 * t, 32 * kk, lane), qf[kk], Gt);
                    f32x4 m; const int T = 4 * kb + t;
#pragma unroll
                    for (int r = 0; r < 4; ++r) { const int j = 64 * kb + 16 * t + 4 * fq + r;
                        float f;
                        if (T < Rw) f = __expf((float)(il - j) * lgf); else if (T > Rw) f = __expf((float)(j - il) * lgb);
                        else f = j < il ? __expf((float)(il - j) * lgf) : (j > il ? __expf((float)(j - il) * lgb) : 2.0f);
                        m[r] = Gt[r] * f; }
                    *(LAS v2u*)(Mt + (16 * wave + fr) * P144 + (16 * t + 4 * fq) * 2) = pack4(m); }
                LDS_WAIT();
#pragma unroll
                for (int kk2 = 0; kk2 < 2; ++kk2) { const bf16x8 mb = frag_nat(Mt, P144, 16 * wave, 32 * kk2, lane);
#pragma unroll
                    for (int et = 0; et < 16; ++et) acc[et] = MFMA16(frag_tr(Vt, P528, 32 * kk2, 16 * et, lane), mb, acc[et]); }
            }
#undef RET_LOAD
            YT0(14);
            if (kchunk >= 0) {
#pragma unroll 1
                for (int dir = 0; dir < 2; ++dir) {
                    const bf16* S = (const bf16*)(dob + DO_ST_RET) + (size_t)__builtin_amdgcn_readfirstlane(((b * 8 + dir * 4 + h) * 32 + kchunk)) * 32768;
                    __syncthreads();
#pragma unroll
                    for (int c = 0; c < 8; ++c) { const int ch = tid + 512 * c, r = ch >> 4, cc = ch & 15; *(LAS v4u*)(St + r * P272 + 16 * cc) = *(const v4u*)(S + r * 128 + 8 * cc); }
                    __syncthreads();
                    const float Ei = dir ? __expf((float)(L - il) * lgb) : __expf((float)(il + 1) * lgf);
#pragma unroll
                    for (int et = 0; et < 16; ++et) { f32x4 T = (f32x4){0.f, 0.f, 0.f, 0.f};
#pragma unroll
                        for (int kk = 0; kk < 4; ++kk) T = MFMA16(frag_nat(St, P272, 16 * et, 32 * kk, lane), qf[kk], T);
                        acc[et] += T * Ei; }
                }
            }
            YT0(15);
            float sm = 0.f;
#pragma unroll
            for (int et = 0; et < 16; ++et) sm += (acc[et].x + acc[et].y) + (acc[et].z + acc[et].w);
            sm += __shfl_xor(sm, 16); sm += __shfl_xor(sm, 32);
            const float mean = sm * (1.f / 256.f); float sq = 0.f;
#pragma unroll
            for (int et = 0; et < 16; ++et) { acc[et] = acc[et] - mean; sq += (acc[et].x * acc[et].x + acc[et].y * acc[et].y) + (acc[et].z * acc[et].z + acc[et].w * acc[et].w); }
            sq += __shfl_xor(sq, 16); sq += __shfl_xor(sq, 32);
            const float rstd = 1.0f / sqrtf(sq * (1.f / 256.f) + LN_EPS);
#pragma unroll
            for (int et = 0; et < 16; ++et) { const int ch = 1024 + 256 * h + 16 * et + 4 * fq; const f32x4 gg = unpack4(*(const v2u*)(ZG + (size_t)row * 2048 + ch));
                f32x4 y = acc[et] * rstd; y.x *= silu_f(gg.x); y.y *= silu_f(gg.y); y.z *= silu_f(gg.z); y.w *= silu_f(gg.w);
                if (!dry) *(v2u*)(ZG + (size_t)row * 2048 + ch) = pack4(y); }
            YT0(16);
        }
        __syncthreads();
    }
}


constexpr size_t WS_GWT = 7 * MiB;
constexpr size_t WS_MIN = 7 * MiB + 256 * 1024;
__device__ __forceinline__ int xc_row(int r, int b) { return r < RL0 ? r - 256 * b : 256 + (r - RL0 - 8192 * b); }
__device__ __forceinline__ void bw8(const float (&x)[8], const float* w  , float (&o)[8]) {
#pragma unroll
    for (int bl = 0; bl < 2; ++bl)
#pragma unroll
        for (int e = 0; e < 4; ++e) o[4 * bl + e] = x[4 * bl] * w[16 * bl + e] + x[4 * bl + 1] * w[16 * bl + 4 + e] + x[4 * bl + 2] * w[16 * bl + 8 + e] + x[4 * bl + 3] * w[16 * bl + 12 + e];
}
__device__ __forceinline__ void unpack8(v4u v, float (&o)[8]) { o[0] = bflo(v.x); o[1] = bfhi(v.x); o[2] = bflo(v.y); o[3] = bfhi(v.y); o[4] = bflo(v.z); o[5] = bfhi(v.z); o[6] = bflo(v.w); o[7] = bfhi(v.w); }
__device__ __forceinline__ v4u pack8(const float (&o)[8]) { v4u r; r.x = pk2(o[0], o[1]); r.y = pk2(o[2], o[3]); r.z = pk2(o[4], o[5]); r.w = pk2(o[6], o[7]); return r; }

constexpr size_t WS_GVT = WS_GWT + 65536;
__device__ __forceinline__ void phase_l1_prep(const Args& args, unsigned char* ws, LAS unsigned char* lds, int tid, int lane, int wave, int bx, int G, int b) {
    const bf16* XM = (const bf16*)(ws + WS_XM); bf16* XC = (bf16*)(ws + WS_XC); const bf16* GXT = (const bf16*)(ws + WS_GWT); const bf16* GVT = (const bf16*)(ws + WS_GVT); float* GATE = (float*)(ws + WS_GATE);
    const float* cwp = args.in[I_MLCW]; const float* cbp = args.in[I_MLCB];
    constexpr int PT = 4112;
    LAS float* GL = (LAS float*)(lds + 20 * PT);
    const int fr = lane & 15, fq = lane >> 4;
    for (int u = bx; u < 528; u += G) {
        const int tb = u < 16 ? 256 * b + 16 * u : RL0 + 8192 * b + 16 * (u - 16);
        const int slo = u < 16 ? 256 * b : RL0 + 8192 * b, shi = u < 16 ? slo + 256 : slo + 8192;
        __syncthreads();
#pragma unroll
        for (int c = 0; c < 10; ++c) { const int ch = tid + 512 * c, rr = ch >> 8, cc = ch & 255; const int grow = tb - 2 + rr;
            v4u v = (v4u){0u, 0u, 0u, 0u}; if (grow >= slo && grow < shi) v = *(const v4u*)(XM + (size_t)grow * 2048 + 8 * cc);
            *(LAS v4u*)(lds + rr * PT + 16 * cc) = v; }
        __syncthreads();
        const int r = tb + fr, xr = xc_row(r, b);
        f32x4 gacc = (f32x4){0.f, 0.f, 0.f, 0.f};
#pragma unroll 2
        for (int c32 = 0; c32 < 8; ++c32) {
            const int cb = 256 * wave + 32 * c32 + 8 * fq;
            v4u xw[5];
#pragma unroll
            for (int k = 0; k < 5; ++k) xw[k] = *(const LAS v4u*)(lds + (fr + k) * PT + 2 * cb);
            const bf16x8 gx = *(const bf16x8*)(GXT + (size_t)fr * 2048 + cb), gv = *(const bf16x8*)(GVT + (size_t)fr * 2048 + cb);
            f32x4 a0 = *(const f32x4*)(cbp + cb), a1 = *(const f32x4*)(cbp + cb + 4);
#pragma unroll
            for (int k = 0; k < 5; ++k) { const f32x4 w0 = *(const f32x4*)(cwp + k * 2048 + cb), w1 = *(const f32x4*)(cwp + k * 2048 + cb + 4); const v4u v = xw[k];
                a0.x += w0.x * bflo(v.x); a0.y += w0.y * bfhi(v.x); a0.z += w0.z * bflo(v.y); a0.w += w0.w * bfhi(v.y);
                a1.x += w1.x * bflo(v.z); a1.y += w1.y * bfhi(v.z); a1.z += w1.z * bflo(v.w); a1.w += w1.w * bfhi(v.w); }
            v4u xcp; xcp.x = pk2(silu_f(a0.x), silu_f(a0.y)); xcp.y = pk2(silu_f(a0.z), silu_f(a0.w)); xcp.z = pk2(silu_f(a1.x), silu_f(a1.y)); xcp.w = pk2(silu_f(a1.z), silu_f(a1.w));
            *(v4u*)(XC + (size_t)xr * 2048 + cb) = xcp;
            gacc = MFMA16(gx, __builtin_bit_cast(bf16x8, xcp), gacc); gacc = MFMA16(gv, __builtin_bit_cast(bf16x8, xw[2]), gacc);
        }
#pragma unroll
        for (int rr = 0; rr < 4; ++rr) GL[(wave * 16 + 4 * fq + rr) * 16 + fr] = gacc[rr];
        __syncthreads();
        if (tid < 256) { const int gt = tid >> 4, tk = tid & 15;
            float s = args.in[I_MLGB][gt];
#pragma unroll
            for (int q = 0; q < 8; ++q) s += GL[(q * 16 + gt) * 16 + tk];
            GATE[(size_t)(tb + tk) * 16 + gt] = s; }
    }
    __syncthreads();
}

__device__ __forceinline__ void phase_l1_gatescan(const Args& args, unsigned char* ws, LAS unsigned char* lds, int tid, int lane, int wave, int bx, int G, int gw, int NGW, int b) {
    const float* GATE = (const float*)(ws + WS_GATE); float* BC = (float*)(ws + WS_BC); float* AJ = (float*)(ws + WS_AJ); float* CM = (float*)(ws + WS_CM); float* CH = (float*)(ws + WS_CH);
    for (int wu = gw; wu < 8 * 17; wu += NGW) {
        const int sl = wu / 17, c17 = wu % 17, dir = sl >> 2, h = sl & 3;
        const int base = c17 == 0 ? 256 * b : RL0 + 8192 * b + 512 * (c17 - 1), L = c17 == 0 ? 256 : 512, per = L >> 6, t0 = lane * per;
        float fc[8], ic[8]; float s = 0.f;
#pragma unroll
        for (int t = 0; t < 8; ++t) if (t < per) { const size_t o = (size_t)(base + t0 + t) * 16; fc[t] = logsig_f(GATE[o + (dir ? 12 : 4) + h]); ic[t] = GATE[o + (dir ? 8 : 0) + h]; s += fc[t]; }
        float p = s;
#pragma unroll
        for (int o = 1; o < 64; o <<= 1) { const float up = __shfl_up(p, o), dn = __shfl_down(p, o); if (!dir) { if (lane >= o) p += up; } else { if (lane + o < 64) p += dn; } }
        const float total = dir ? __shfl(p, 0) : __shfl(p, 63);
        float run = p - s, a[8], bcv[8]; float mx = -3.0e38f;
        if (!dir) {
#pragma unroll
            for (int t = 0; t < 8; ++t) if (t < per) { run += fc[t]; bcv[t] = run; a[t] = ic[t] - run; mx = fmaxf(mx, a[t]); }
        } else {
#pragma unroll
            for (int t = 7; t >= 0; --t) if (t < per) { run += fc[t]; bcv[t] = run; a[t] = ic[t] - run; mx = fmaxf(mx, a[t]); }
        }
        float pm = mx;
#pragma unroll
        for (int o = 1; o < 64; o <<= 1) { const float up = __shfl_up(pm, o), dn = __shfl_down(pm, o); if (!dir) { if (lane >= o) pm = fmaxf(pm, up); } else { if (lane + o < 64) pm = fmaxf(pm, dn); } }
        const float cmax = dir ? __shfl(pm, 0) : __shfl(pm, 63);
        float excl = !dir ? __shfl_up(pm, 1) : __shfl_down(pm, 1);
        if ((!dir && lane == 0) || (dir && lane == 63)) excl = -3.0e38f;
        float rm = excl;
        if (!dir) {
#pragma unroll
            for (int t = 0; t < 8; ++t) if (t < per) { rm = fmaxf(rm, a[t]); const size_t o = (size_t)(base + t0 + t) * 8 + sl; BC[o] = bcv[t]; AJ[o] = a[t]; CM[o] = rm; }
        } else {
#pragma unroll
            for (int t = 7; t >= 0; --t) if (t < per) { rm = fmaxf(rm, a[t]); const size_t o = (size_t)(base + t0 + t) * 8 + sl; BC[o] = bcv[t]; AJ[o] = a[t]; CM[o] = rm; }
        }
        if (lane == 0) { CH[((b * 8 + sl) * 17 + c17) * 2] = total; CH[((b * 8 + sl) * 17 + c17) * 2 + 1] = cmax; }
    }
}

__device__ __forceinline__ void m_chain(const float* CH, int b, int sl, LAS float* m_in, LAS float* mul) {
    const int dir = sl >> 2; float m = 0.f;
    for (int step = 0; step < 17; ++step) { const int c17 = step == 0 ? 0 : (dir ? 17 - step : step); const float be = CH[((b * 8 + sl) * 17 + c17) * 2], cx = CH[((b * 8 + sl) * 17 + c17) * 2 + 1];
        const float mu = fmaxf(m, cx); m_in[step] = m; mul[step] = mu; m = be + mu; }
}

__device__ __forceinline__ void phase_l1_scan(const Args& args, unsigned char* ws, LAS unsigned char* lds, int tid, int lane, int wave, int bx, int G, int b) {
    const bf16* XM = (const bf16*)(ws + WS_XM); const bf16* XC = (const bf16*)(ws + WS_XC); const float* AJ = (const float*)(ws + WS_AJ); const float* CH = (const float*)(ws + WS_CH);
    bf16* ST = (bf16*)(ws + WS_ST1); float* NV = (float*)(ws + WS_NV);
    LAS unsigned char* Kt = lds; LAS unsigned char* Vt = lds + 128 * P144; LAS float* MS = (LAS float*)(lds + 128 * P144 + 128 * P272);
    const int fr = lane & 15, fq = lane >> 4, wd = wave & 3, we = wave >> 2;
    const bf16x8 ones = (bf16x8){(short)0x3F80, (short)0x3F80, (short)0x3F80, (short)0x3F80, (short)0x3F80, (short)0x3F80, (short)0x3F80, (short)0x3F80};
    for (int u = bx; u < 256; u += G) {
        const int sl = u >> 5, t = u & 31, et = t >> 3, dt = t & 7, dir = sl >> 2, h = sl & 3;
        __syncthreads();
        if (tid == 0) m_chain(CH, b, sl, MS, MS + 32);
        __syncthreads();
        if (t == 0 && tid < 17) ((float*)(ws + WS_MIN))[(b * 8 + sl) * 17 + tid] = MS[tid];
        f32x4 acc[4]; f32x4 nacc = (f32x4){0.f, 0.f, 0.f, 0.f};
#pragma unroll
        for (int i = 0; i < 4; ++i) acc[i] = (f32x4){0.f, 0.f, 0.f, 0.f};
        const int srow = tid >> 2, q4 = tid & 3;
        const bf16* xcb = XC + 512 * h + 64 * dt + 16 * q4; const bf16* xmb = XM + 512 * h + 128 * et + 32 * q4;
#define L1S_STP(si) ((si) < 2 ? 0 : 1 + (((si) - 2) >> 2))
#define L1S_LOAD(si, K0, K1, VV, W) do { const int stp_ = L1S_STP(si), t0_ = (si) < 2 ? 128 * (si) : 128 * (((si) - 2) & 3); int r_, xr_; \
            if (stp_ == 0) { r_ = 256 * b + t0_ + srow; xr_ = t0_ + srow; } else { const int kq_ = dir ? 16 - stp_ : stp_ - 1; r_ = RL0 + 8192 * b + 512 * kq_ + t0_ + srow; xr_ = 256 + 512 * kq_ + t0_ + srow; } \
            W = __expf(AJ[(size_t)r_ * 8 + sl] - MS[32 + stp_]); K0 = *(const v4u*)(xcb + (size_t)xr_ * 2048); K1 = *(const v4u*)(xcb + (size_t)xr_ * 2048 + 8); \
            _Pragma("unroll") for (int c = 0; c < 4; ++c) VV[c] = *(const v4u*)(xmb + (size_t)r_ * 2048 + 8 * c); } while (0)
#define L1S_STORE(kidx) do { bf16* So = ST + ((size_t)(sl * 16 + (kidx)) * 512) * 512; \
            _Pragma("unroll") for (int t4 = 0; t4 < 4; ++t4) { const int e = 128 * et + 64 * we + 16 * t4 + fr, d = 64 * dt + 16 * wd + 4 * fq; *(v2u*)(So + (size_t)e * 512 + d) = pack4(acc[t4]); } \
            if (et == 0 && we == 0 && fr == 0) *(f32x4*)(NV + (size_t)(sl * 16 + (kidx)) * 512 + 64 * dt + 16 * wd + 4 * fq) = nacc; } while (0)
#define L1S_STEP(si, K0, K1, VV, W) do { const int stp_ = L1S_STP(si); \
            if ((si) == 0 || ((si) >= 2 && (((si) - 2) & 3) == 0)) { if (stp_ >= 1) L1S_STORE(dir ? 16 - stp_ : stp_ - 1); const float wc_ = __expf(MS[stp_] - MS[32 + stp_]); \
                _Pragma("unroll") for (int i = 0; i < 4; ++i) acc[i] = acc[i] * wc_; nacc = nacc * wc_; } \
            __syncthreads(); \
            *(LAS v4u*)(Kt + srow * P144 + 32 * q4) = scale8(K0, W); *(LAS v4u*)(Kt + srow * P144 + 32 * q4 + 16) = scale8(K1, W); \
            _Pragma("unroll") for (int c = 0; c < 4; ++c) *(LAS v4u*)(Vt + srow * P272 + 64 * q4 + 16 * c) = VV[c]; \
            __syncthreads(); \
            if ((si) + 4 < 62) L1S_LOAD((si) + 4, K0, K1, VV, W); \
            _Pragma("unroll") for (int kk = 0; kk < 4; ++kk) { const bf16x8 a = frag_tr(Kt, P144, 32 * kk, 16 * wd, lane); \
                _Pragma("unroll") for (int t4 = 0; t4 < 4; ++t4) acc[t4] = MFMA16(a, frag_tr(Vt, P272, 32 * kk, 64 * we + 16 * t4, lane), acc[t4]); \
                nacc = MFMA16(a, ones, nacc); } } while (0)
        v4u ka0, ka1, va[4], kb0, kb1, vb[4], kc0, kc1, vc[4], kd0, kd1, vd[4]; float wa, wb, wc, wd_;
        L1S_LOAD(0, ka0, ka1, va, wa); L1S_LOAD(1, kb0, kb1, vb, wb); L1S_LOAD(2, kc0, kc1, vc, wc); L1S_LOAD(3, kd0, kd1, vd, wd_);
#pragma unroll 1
        for (int si = 0; si < 60; si += 4) { L1S_STEP(si, ka0, ka1, va, wa); L1S_STEP(si + 1, kb0, kb1, vb, wb); L1S_STEP(si + 2, kc0, kc1, vc, wc); L1S_STEP(si + 3, kd0, kd1, vd, wd_); }
        L1S_STEP(60, ka0, ka1, va, wa); L1S_STEP(61, kb0, kb1, vb, wb);
        L1S_STORE(dir ? 0 : 15);
#undef L1S_STP
#undef L1S_LOAD
#undef L1S_STORE
#undef L1S_STEP
    }
    __syncthreads();
}


constexpr int P1040 = 1040;
constexpr int LY_AJ = 139264;
constexpr int LY_MT = 66560;
__device__ __forceinline__ void qprime8(const bf16* xcrow, const float* WQK, int cb, float (&o)[8]) {
    float x[8]; unpack8(*(const v4u*)(xcrow + cb), x);
    bw8(x, WQK + (cb >> 2) * 16, o);
}
constexpr int LY_Q = 73728;
__device__ __forceinline__ LAS unsigned char* qp_addr(LAS unsigned char* lds, int r, int c) { return lds + LY_Q + r * 1024 + ((c ^ (r & 15)) << 4); }
__device__ __forceinline__ void qp_fill(LAS unsigned char* lds, const bf16* xcrow, const float* WQK, int h, int rl, int we, int fq, const float* nf, const float* nb, float& qn_f, float& qn_b, bool with_n) {
#pragma unroll 2
    for (int j = 0; j < 8; ++j) { const int c = 8 * j + 4 * we + fq; float q8[8]; qprime8(xcrow, WQK, 512 * h + 8 * c, q8);
        if (with_n) {
#pragma unroll
            for (int e = 0; e < 8; ++e) { qn_f += q8[e] * nf[8 * c + e]; qn_b += q8[e] * nb[8 * c + e]; } }
        *(LAS v4u*)qp_addr(lds, rl, c) = pack8(q8); }
}
__device__ __forceinline__ void qp_fill_scaled(LAS unsigned char* lds, const bf16* xcrow, const float* WQK, int h, int rl, int we, int fq, float sc) {
#pragma unroll 2
    for (int j = 0; j < 8; ++j) { const int c = 8 * j + 4 * we + fq; float q8[8]; qprime8(xcrow, WQK, 512 * h + 8 * c, q8);
#pragma unroll
        for (int e = 0; e < 8; ++e) q8[e] *= sc;
        *(LAS v4u*)qp_addr(lds, rl, c) = pack8(q8); }
}
__device__ __forceinline__ void phase_l1_y(const Args& args, unsigned char* ws, LAS unsigned char* lds, int tid0, int lane0, int wave, int bx, int G, int b, unsigned long long& tacc, bool dry = false) {
#ifndef YSEC
#define YSEC -1
#endif
    unsigned long long ytm = 0ull; int ycur = -1;
#define YT(n) do { if (YSEC >= 0) { const unsigned long long now_ = __builtin_amdgcn_s_memrealtime(); if (ycur == YSEC) tacc += now_ - ytm; ytm = now_; ycur = (n); } } while (0)

    const bf16* XM = (const bf16*)(ws + WS_XM); const bf16* XC = (const bf16*)(ws + WS_XC); bf16* Z = (bf16*)(ws + WS_Z);
    const float* AJ = (const float*)(ws + WS_AJ); const float* BC = (const float*)(ws + WS_BC); const float* CM = (const float*)(ws + WS_CM); const float* CH = (const float*)(ws + WS_CH);
    const bf16* ST = (const bf16*)(ws + WS_ST1); const float* NV = (const float*)(ws + WS_NV); const float* WQK = (const float*)(ws + WS_WQK);
    LAS float* AJL = (LAS float*)(lds + LY_AJ);
    LAS unsigned char* Mf = lds;
    LAS unsigned char* Tt = lds + 66560;
    const int wr = wave >> 1, we = wave & 1;
    for (int u = bx; u < 512; u += G) {
        int tid = tid0, lane = lane0; asm volatile("" : "+v"(tid), "+v"(lane));
        const int fr = lane & 15, fq = lane >> 4;
        const int h = u >> 7, k = (u >> 3) & 15, rb = u & 7;
        const int base = RL0 + 8192 * b + 512 * k, xb = 256 + 512 * k, i0 = 64 * rb;
        const int il = i0 + 16 * wr + fr, row = base + il; const bf16* xcrow = XC + (size_t)(xb + il) * 2048;
        YT(0);
        const int Rw = 4 * rb + wr;
        __syncthreads();
        const float m_in_f = ((const float*)(ws + WS_MIN))[(b * 8 + h) * 17 + k + 1], m_in_b = ((const float*)(ws + WS_MIN))[(b * 8 + 4 + h) * 17 + 16 - k];
        const float mu_f = fmaxf(m_in_f, CM[(size_t)row * 8 + h]), mu_b = fmaxf(m_in_b, CM[(size_t)row * 8 + 4 + h]);
        const float bc_f = BC[(size_t)row * 8 + h], bc_b = BC[(size_t)row * 8 + 4 + h];
        for (int i = tid; i < 1024; i += 512) { const int d = i >> 9, j = i & 511; AJL[i] = AJ[(size_t)(base + j) * 8 + 4 * d + h]; }
        YT(1);
        f32x4 Gt[4][4];
#pragma unroll
        for (int kb = 0; kb < 4; ++kb)
#pragma unroll
            for (int t = 0; t < 4; ++t) Gt[kb][t] = (f32x4){0.f, 0.f, 0.f, 0.f};
        float qn_f = 0.f, qn_b = 0.f;
        const float* nf = NV + (size_t)(h * 16 + k) * 512; const float* nb = NV + (size_t)((4 + h) * 16 + k) * 512;
        qp_fill(lds, xcrow, WQK, h, 16 * wr + fr, we, fq, nf, nb, qn_f, qn_b, true);
        v4u pa0[8], pa1[8]; int tA = tid; asm volatile("" : "+v"(tA));
#define LYA_LOAD(P, dsv) do { asm volatile("" : "+v"(tA)); _Pragma("unroll") for (int c = 0; c < 8; ++c) { const int ch = tA + 512 * c, r = ch >> 3, cc = ch & 7; P[c] = *(const v4u*)(XC + (size_t)(xb + r) * 2048 + 512 * h + 64 * (dsv) + 8 * cc); } } while (0)
#define LYA_STEP(P, dsv) do { __syncthreads(); \
            _Pragma("unroll") for (int c = 0; c < 8; ++c) { const int ch = tA + 512 * c, r = ch >> 3, cc = ch & 7; *(LAS v4u*)(lds + r * P144 + 16 * cc) = P[c]; } \
            __syncthreads(); \
            if ((dsv) + 2 < 8) LYA_LOAD(P, (dsv) + 2); \
            bf16x8 qf[2]; \
            _Pragma("unroll") for (int kk = 0; kk < 2; ++kk) qf[kk] = *(const LAS bf16x8*)qp_addr(lds, 16 * wr + fr, 8 * (dsv) + 4 * kk + fq); \
            _Pragma("unroll") for (int kb = 0; kb < 4; ++kb) { \
                _Pragma("unroll") for (int t = 0; t < 4; ++t) { \
                    _Pragma("unroll") for (int kk = 0; kk < 2; ++kk) Gt[kb][t] = MFMA16(frag_nat(lds, P144, 64 * (4 * we + kb) + 16 * t, 32 * kk, lane), qf[kk], Gt[kb][t]); \
                    asm volatile("" ::: "memory"); } } } while (0)
        LYA_LOAD(pa0, 0); LYA_LOAD(pa1, 1);
#pragma unroll 1
        for (int ds = 0; ds < 8; ds += 2) { LYA_STEP(pa0, ds); LYA_STEP(pa1, ds + 1); }
#undef LYA_LOAD
#undef LYA_STEP
        YT(2);
        qn_f += __shfl_xor(qn_f, 16); qn_f += __shfl_xor(qn_f, 32); qn_b += __shfl_xor(qn_b, 16); qn_b += __shfl_xor(qn_b, 32);
        float rsf = 0.f, rsb = 0.f;
#pragma unroll
        for (int kb = 0; kb < 4; ++kb)
#pragma unroll
            for (int t = 0; t < 4; ++t) { const int T = 4 * (4 * we + kb) + t, j0 = 16 * T + 4 * fq; const f32x4 g = Gt[kb][t];
                if (T < Rw) { rsf += g.x * __expf(AJL[j0] - mu_f) + g.y * __expf(AJL[j0 + 1] - mu_f) + g.z * __expf(AJL[j0 + 2] - mu_f) + g.w * __expf(AJL[j0 + 3] - mu_f); }
                else if (T > Rw) { rsb += g.x * __expf(AJL[512 + j0] - mu_b) + g.y * __expf(AJL[512 + j0 + 1] - mu_b) + g.z * __expf(AJL[512 + j0 + 2] - mu_b) + g.w * __expf(AJL[512 + j0 + 3] - mu_b); }
                else {
#pragma unroll
                    for (int r = 0; r < 4; ++r) { const int jj = 4 * fq + r; const float ef = __expf(AJL[j0 + r] - mu_f), eb = __expf(AJL[512 + j0 + r] - mu_b);
                        rsf += jj <= fr ? g[r] * ef : 0.f; rsb += jj >= fr ? g[r] * eb : 0.f; } }
                asm volatile("" ::: "memory"); }
        rsf += __shfl_xor(rsf, 16); rsf += __shfl_xor(rsf, 32); rsb += __shfl_xor(rsb, 16); rsb += __shfl_xor(rsb, 32);
        __syncthreads();
        { LAS float* RS = (LAS float*)lds; if (fq == 0) { RS[(wave * 16 + fr) * 4] = rsf; RS[(wave * 16 + fr) * 4 + 1] = rsb; RS[(wave * 16 + fr) * 4 + 2] = qn_f; RS[(wave * 16 + fr) * 4 + 3] = qn_b; }
          __syncthreads();
          rsf += RS[((wave ^ 1) * 16 + fr) * 4]; rsb += RS[((wave ^ 1) * 16 + fr) * 4 + 1]; qn_f += RS[((wave ^ 1) * 16 + fr) * 4 + 2]; qn_b += RS[((wave ^ 1) * 16 + fr) * 4 + 3]; }
        const float wp_f = __expf(m_in_f - mu_f), wp_b = __expf(m_in_b - mu_b);
        const float dn_f = fmaxf(fabsf(rsf + wp_f * qn_f), __expf(-bc_f - mu_f)), dn_b = fmaxf(fabsf(rsb + wp_b * qn_b), __expf(-bc_b - mu_b));
        const float inv_f = 1.0f / dn_f, inv_b = 1.0f / dn_b, s_f = wp_f * inv_f, s_b = wp_b * inv_b;
        __syncthreads();
#pragma unroll
        for (int kb = 0; kb < 4; ++kb)
#pragma unroll
            for (int t = 0; t < 4; ++t) { const int T = 4 * (4 * we + kb) + t, j0 = 16 * T + 4 * fq; const f32x4 g = Gt[kb][t]; f32x4 m;
                if (T < Rw) { m.x = g.x * __expf(AJL[j0] - mu_f) * inv_f; m.y = g.y * __expf(AJL[j0 + 1] - mu_f) * inv_f; m.z = g.z * __expf(AJL[j0 + 2] - mu_f) * inv_f; m.w = g.w * __expf(AJL[j0 + 3] - mu_f) * inv_f; }
                else if (T > Rw) { m.x = g.x * __expf(AJL[512 + j0] - mu_b) * inv_b; m.y = g.y * __expf(AJL[512 + j0 + 1] - mu_b) * inv_b; m.z = g.z * __expf(AJL[512 + j0 + 2] - mu_b) * inv_b; m.w = g.w * __expf(AJL[512 + j0 + 3] - mu_b) * inv_b; }
                else {
#pragma unroll
                    for (int r = 0; r < 4; ++r) { const int jj = 4 * fq + r; const float ef = __expf(AJL[j0 + r] - mu_f) * inv_f, eb = __expf(AJL[512 + j0 + r] - mu_b) * inv_b;
                        m[r] = g[r] * ((jj <= fr ? ef : 0.f) + (jj >= fr ? eb : 0.f)); } }
                *(LAS v2u*)(Mf + (16 * wr + fr) * P1040 + j0 * 2) = pack4(m); asm volatile("" ::: "memory"); }
        YT(3);
        f32x4 acc[16];
#pragma unroll
        for (int et = 0; et < 16; ++et) acc[et] = (f32x4){0.f, 0.f, 0.f, 0.f};
        v4u pre[8], pre1[8]; int tB = tid; asm volatile("" : "+v"(tB));
#define LYB_LOAD(P, kbv) do { asm volatile("" : "+v"(tB)); _Pragma("unroll") for (int c = 0; c < 8; ++c) { const int ch = tB + 512 * c, r = ch >> 6, cc = ch & 63; P[c] = *(const v4u*)(XM + (size_t)(base + 64 * (kbv) + r) * 2048 + 512 * h + 8 * cc); } } while (0)
#define LYB_STEP(P, kbv) do { __syncthreads(); \
            _Pragma("unroll") for (int c = 0; c < 8; ++c) { const int ch = tB + 512 * c, r = ch >> 6, cc = ch & 63; *(LAS v4u*)(Tt + r * P1040 + 16 * cc) = P[c]; } \
            __syncthreads(); \
            if ((kbv) + 2 < 8) LYB_LOAD(P, (kbv) + 2); \
            _Pragma("unroll") for (int kk2 = 0; kk2 < 2; ++kk2) { const bf16x8 mb = frag_nat(Mf, P1040, 16 * wr, 64 * (kbv) + 32 * kk2, lane); \
                _Pragma("unroll") for (int et = 0; et < 16; ++et) { acc[et] = MFMA16(frag_tr(Tt, P1040, 32 * kk2, 256 * we + 16 * et, lane), mb, acc[et]); if ((et & 3) == 3) asm volatile("" ::: "memory"); } } } while (0)
        LYB_LOAD(pre, 0); LYB_LOAD(pre1, 1);
#pragma unroll 1
        for (int kb = 0; kb < 8; kb += 2) { LYB_STEP(pre, kb); LYB_STEP(pre1, kb + 1); }
#undef LYB_LOAD
#undef LYB_STEP
        YT(4);
        int tC = tid; asm volatile("" : "+v"(tC));
#define LYC_LOAD(P, itv) do { asm volatile("" : "+v"(tC)); const bf16* S_ = ST + ((size_t)((((itv) >> 3) * 4 + h) * 16 + k) * 512) * 512 + 64 * ((itv) & 7); \
            _Pragma("unroll") for (int c = 0; c < 8; ++c) { const int ch = tC + 512 * c, r = ch >> 3, cc = ch & 7; P[c] = *(const v4u*)(S_ + (size_t)r * 512 + 8 * cc); } } while (0)
#define LYC_STEP(P, itv) do { __syncthreads(); \
            _Pragma("unroll") for (int c = 0; c < 8; ++c) { const int ch = tC + 512 * c, r = ch >> 3, cc = ch & 7; *(LAS v4u*)(lds + r * P144 + 16 * cc) = P[c]; } \
            __syncthreads(); \
            if ((itv) + 2 < 16) LYC_LOAD(P, (itv) + 2); \
            bf16x8 qs[2]; \
            _Pragma("unroll") for (int kk = 0; kk < 2; ++kk) qs[kk] = *(const LAS bf16x8*)qp_addr(lds, 16 * wr + fr, 8 * ((itv) & 7) + 4 * kk + fq); \
            _Pragma("unroll") for (int kk = 0; kk < 2; ++kk) \
                _Pragma("unroll") for (int et = 0; et < 16; ++et) { acc[et] = MFMA16(frag_nat(lds, P144, 256 * we + 16 * et, 32 * kk, lane), qs[kk], acc[et]); if ((et & 3) == 3) asm volatile("" ::: "memory"); } } while (0)
        LYC_LOAD(pre, 0); LYC_LOAD(pre1, 1);
#pragma unroll 1
        for (int dir = 0; dir < 2; ++dir) {
            __syncthreads();
            qp_fill_scaled(lds, xcrow, WQK, h, 16 * wr + fr, we, fq, dir ? s_b : s_f);
#pragma unroll 1
            for (int it = 8 * dir; it < 8 * dir + 8; it += 2) { LYC_STEP(pre, it); LYC_STEP(pre1, it + 1); }
        }
#undef LYC_LOAD
#undef LYC_STEP
        YT(5);
        float sm = 0.f;
#pragma unroll
        for (int et = 0; et < 16; ++et) { const float* w = args.in[I_MLWV] + (size_t)(128 * h + 64 * we + 4 * et + fq) * 16; const f32x4 a = acc[et]; f32x4 o;
            o.x = a.x * w[0] + a.y * w[4] + a.z * w[8] + a.w * w[12]; o.y = a.x * w[1] + a.y * w[5] + a.z * w[9] + a.w * w[13];
            o.z = a.x * w[2] + a.y * w[6] + a.z * w[10] + a.w * w[14]; o.w = a.x * w[3] + a.y * w[7] + a.z * w[11] + a.w * w[15];
            acc[et] = o; sm += (o.x + o.y) + (o.z + o.w); asm volatile("" ::: "memory"); }
        sm += __shfl_xor(sm, 16); sm += __shfl_xor(sm, 32);
        LAS float* XS = AJL;
        __syncthreads();
        if (fq == 0) XS[wave * 16 + fr] = sm;
        __syncthreads();
        const float mean = (sm + XS[(wave ^ 1) * 16 + fr]) * (1.f / 512.f); float sq = 0.f;
#pragma unroll
        for (int et = 0; et < 16; ++et) { acc[et] = acc[et] - mean; sq += (acc[et].x * acc[et].x + acc[et].y * acc[et].y) + (acc[et].z * acc[et].z + acc[et].w * acc[et].w); }
        sq += __shfl_xor(sq, 16); sq += __shfl_xor(sq, 32);
        if (fq == 0) XS[128 + wave * 16 + fr] = sq;
        __syncthreads();
        const float rstd = 1.0f / sqrtf((sq + XS[128 + (wave ^ 1) * 16 + fr]) * (1.f / 512.f) + LN_EPS);
#pragma unroll
        for (int et = 0; et < 16; ++et) { const int ch = 512 * h + 256 * we + 16 * et + 4 * fq;
            const f32x4 nw = *(const f32x4*)(args.in[I_MLNW] + ch), sk = *(const f32x4*)(args.in[I_MLSKIP] + ch), xcv = unpack4(*(const v2u*)(xcrow + ch)), zz = unpack4(*(const v2u*)(Z + (size_t)row * 2048 + ch));
            f32x4 y = acc[et] * rstd * nw + sk * xcv;
            y.x *= silu_f(zz.x); y.y *= silu_f(zz.y); y.z *= silu_f(zz.z); y.w *= silu_f(zz.w);
            if (!dry) *(v2u*)(Z + (size_t)row * 2048 + ch) = pack4(y); asm volatile("" ::: "memory"); }
        YT(6);
    }
    __syncthreads();
}


__device__ __forceinline__ void xcd_barrier2(const XcdBarrier& b) {
    asm volatile("s_waitcnt vmcnt(0)" ::: "memory");
    __syncthreads();
    if (threadIdx.x == 0) {
        unsigned* bar = b.bar;
        __builtin_amdgcn_s_waitcnt(0);
        unsigned nloc = b.st[0], nx = b.st[1];
        if (nloc == 0u) { xcd_barrier_complete(bar, b.x, nloc, nx); b.st[0] = nloc; b.st[1] = nx; }
        const unsigned old = xb_add(&bar[XB_XSUB(b.x)], 1u);
        const unsigned gen = old / nloc;
        if (old + 1u == (gen + 1u) * nloc) {
            __builtin_amdgcn_fence(__ATOMIC_RELEASE, "agent");
            asm volatile("s_waitcnt vmcnt(0)" ::: "memory");
            const unsigned og = xb_add(&bar[XB_TOP], 1u);
            if (og + 1u == (gen + 1u) * nx) xb_add(&bar[XB_TOPGEN], 1u);
        }
        XB_SPIN(xb_ld(&bar[XB_TOPGEN]) == gen, bar);
        __builtin_amdgcn_fence(__ATOMIC_ACQUIRE, "agent");
        asm volatile("s_waitcnt vmcnt(0)" ::: "memory");
    }
    __syncthreads();
}
#ifndef BARRIER_FLAT
#define BARRIER_FLAT 0
#endif
__device__ __forceinline__ void flat_barrier(unsigned* cnt, unsigned* flag, unsigned& gen, unsigned G) {
    asm volatile("s_waitcnt vmcnt(0)" ::: "memory");
    __syncthreads();
    if (threadIdx.x == 0) {
        __builtin_amdgcn_fence(__ATOMIC_RELEASE, "agent");
        asm volatile("s_waitcnt vmcnt(0)" ::: "memory");
        const unsigned target = gen + 1u;
        const unsigned old = __hip_atomic_fetch_add(cnt, 1u, __ATOMIC_RELAXED, __HIP_MEMORY_SCOPE_AGENT);
        if (old + 1u == target * G) __hip_atomic_store(flag, target, __ATOMIC_RELAXED, __HIP_MEMORY_SCOPE_AGENT);
        else { unsigned sp = 0; while (__hip_atomic_load(flag, __ATOMIC_RELAXED, __HIP_MEMORY_SCOPE_AGENT) < target) { __builtin_amdgcn_s_sleep(1); if (++sp > (1u << 22)) break; } }
        __builtin_amdgcn_fence(__ATOMIC_ACQUIRE, "agent");
        asm volatile("s_waitcnt vmcnt(0)" ::: "memory");
    }
    gen += 1u;
    __syncthreads();
}
#ifndef MK_PER_PHASE
#define MK_PER_PHASE 0
#endif
constexpr int N_PHASES = 25;
#ifndef PROBE_MASK
#define PROBE_MASK 0
#endif
#define DUP(k) (((PROBE_MASK) >> (k)) & 1)
#ifndef TPROBE_MASK
#define TPROBE_MASK 0
#endif
#define TPR(k) (((TPROBE_MASK) >> (k)) & 1)
__global__ void __launch_bounds__(NWAVES * 64, 2) mk_fwd(Args args) {
    extern __shared__ __attribute__((aligned(16))) unsigned char lds_raw[];
    LAS unsigned char* lds = (LAS unsigned char*)lds_raw;
    volatile LAS unsigned* MISC = (volatile LAS unsigned*)(lds + MISC_OFF);
    const int tid = threadIdx.x, lane = tid & 63, wave = __builtin_amdgcn_readfirstlane(tid >> 6);
    const int G = gridDim.x, bx = blockIdx.x;
    const int vcu = (G % 8 == 0) ? (bx % 8) * (G / 8) + bx / 8 : bx;
    const int gw = vcu * NWAVES + wave, NGW = G * NWAVES;
    unsigned char* ws = args.ws;
    gu32* ctl = (gu32*)(ws + WS_CTL);
    float* MOD = (float*)(ws + CTL_MOD);
    unsigned char* dob = (unsigned char*)args.out;
    for (int u = tid; u < (LDS_BYTES - LDSCTL_OFF) / 4; u += NWAVES * 64) ((LAS unsigned*)(lds + LDSCTL_OFF))[u] = 0u;
    __syncthreads();
    XcdBarrier bar; bar.bar = (unsigned*)(ctl + CW_BAR); bar.x = 0; bar.st = nullptr;
    if (!MK_PER_PHASE) bar = xcd_barrier_post((unsigned*)(ctl + CW_BAR), MISC + 8);
    const int lo = args.ph_lo, hi = args.ph_hi;
    unsigned long long tacc = 0ull, tmark = 0ull;
#define TBEG(k) do { if (TPR(k)) tmark = __builtin_amdgcn_s_memrealtime(); } while (0)
#define TEND(k) do { if (TPR(k)) tacc += __builtin_amdgcn_s_memrealtime() - tmark; } while (0)
#define IN(k) (lo <= (k) && (k) < hi)
    unsigned fgen = 0u;
#if BARRIER_FLAT
#define GBAR() flat_barrier((unsigned*)(ctl + 8192), (unsigned*)(ctl + 8192 + 64), fgen, (unsigned)G)
#elif defined(BARRIER2)
#define GBAR() xcd_barrier2(bar)
#else
#define GBAR() xcd_barrier(bar)
#endif
#define SEAM(k) do { if (IN(k) && IN((k) + 1)) GBAR(); TEND(k); TBEG((k) + 1); } while (0)

    TBEG(0);
    if (IN(0)) {
        LAS float* scr = (LAS float*)(lds + wave * 16384);
        conv_abin(args.in[I_ABIN], (bf16*)(ws + WS_W_IN), scr, gw, NGW, lane);
        conv_plain(args.in[I_ABOUT], 2048, 1024, (bf16*)(ws + WS_W_OUT), scr, gw, NGW, lane);
        conv_ffn1(args.in[I_W1], args.in[I_W3], (bf16*)(ws + WS_W_F1), scr, gw, NGW, lane);
        conv_plain(args.in[I_W2], FFH, 1024, (bf16*)(ws + WS_W_F2), scr, gw, NGW, lane);
        __syncthreads();
        LAS float* sc = (LAS float*)lds;
        LAS float* part = (LAS float*)(lds + 16384);
        for (int i = tid; i < 3 * 1024; i += 512) { const int v = i >> 10, k = i & 1023; const float cv = v == 0 ? args.in[I_CCTX][k] : args.in[I_C][(v - 1) * DM + k]; sc[i] = silu_f(cv); }
        __syncthreads();
        for (int u = bx; u < 192; u += G) {
            const int layer = u / 96, cb = u % 96, n = cb * 64 + lane;
            const float* W = args.in[I_ADAW] + (size_t)layer * DM * 6144 + (size_t)(wave * 128) * 6144 + n;
            float a0 = 0.f, a1 = 0.f, a2 = 0.f;
#pragma unroll 8
            for (int kk = 0; kk < 128; ++kk) { const float wv = W[(size_t)kk * 6144]; const int k = wave * 128 + kk; a0 += sc[k] * wv; a1 += sc[1024 + k] * wv; a2 += sc[2048 + k] * wv; }
            part[(wave * 3 + 0) * 64 + lane] = a0; part[(wave * 3 + 1) * 64 + lane] = a1; part[(wave * 3 + 2) * 64 + lane] = a2;
            __syncthreads();
            if (tid < 192) { const int v = tid >> 6, l = tid & 63; float s = args.in[I_ADAB][layer * 6144 + cb * 64 + l];
#pragma unroll
                for (int w = 0; w < 8; ++w) s += part[(w * 3 + v) * 64 + l];
                MOD[(size_t)(layer * 3 + v) * 6144 + cb * 64 + l] = s; }
            __syncthreads();
        }
        for (int i = bx * 512 + tid; i < 512 * 16; i += G * 512) { const int blk = i >> 4, d = (i >> 2) & 3, dp = i & 3; const float* q = args.in[I_MLWQ] + blk * 16 + d * 4; const float* k = args.in[I_MLWK] + blk * 16 + dp * 4;
            ((float*)(ws + WS_WQK))[i] = 0.04419417382415922f * (q[0] * k[0] + q[1] * k[1] + q[2] * k[2] + q[3] * k[3]); }
    }
    SEAM(0);
    if (IN(1)) {
        LAS float* wdt = (LAS float*)lds;
        for (int i = tid; i < 1024 * 4; i += 512) { const int k = i >> 2, q = i & 3; const f32x4 w4 = *(const f32x4*)(args.in[I_ABIN] + (size_t)k * ABIN + 3072 + 4 * q);
            wdt[(4 * q) * 1024 + k] = w4.x; wdt[(4 * q + 1) * 1024 + k] = w4.y; wdt[(4 * q + 2) * 1024 + k] = w4.z; wdt[(4 * q + 3) * 1024 + k] = w4.w; }
        __syncthreads();
        norm_rows<true>(args.in[I_CTX], args.in[I_X], args.in[I_NMIX], MOD, 0, (bf16*)(dob + DO_H), 0, 0, R, gw, NGW, lane, wdt, (float*)(ws + WS_DTRAW));
        __syncthreads();
    }
    SEAM(1);
    if (IN(2)) {
        pg8::Gemm g{(const bf16*)(dob + DO_H), (const bf16*)(ws + WS_W_IN), R, 6144, DM}; pg8::StaticOrder S; S.init(R, 6144, G, bx);
        pg8::EpiInProj E{(bf16*)(ws + WS_ZG), (bf16*)(ws + WS_XBC), (bf16*)(ws + WS_QK), (bf16*)(ws + WS_V), (bf16*)(ws + WS_HALO)};
        pg8::gemm_phase<pg8::EpiInProj, pg8::StaticOrder, true, true>(lds, g, S, E);
    }
    SEAM(2);
    if (DUP(20)) { for (int i = 0; i < 10; ++i) GBAR(); }
    if (IN(3)) { phase_l0_prep(args, ws, lds, tid, lane, wave, vcu, G, gw, NGW); }
    SEAM(3);
    if (DUP(4) && IN(4)) { phase_l0_scan(args, ws, dob, lds, tid, lane, wave, vcu, G); GBAR(); }
    if (IN(4)) { phase_l0_scan(args, ws, dob, lds, tid, lane, wave, vcu, G); }
    SEAM(4);
    if (DUP(5) && IN(5)) { phase_l0_y(args, ws, dob, lds, tid, lane, wave, vcu, G, tacc, lo == 0); GBAR(); }
    if (IN(5)) { phase_l0_y(args, ws, dob, lds, tid, lane, wave, vcu, G, tacc); }
    SEAM(5);
    if (IN(6)) {
        pg8::Gemm g{(const bf16*)(ws + WS_ZG), (const bf16*)(ws + WS_W_OUT), R, DM, 2048}; pg8::StaticOrder S; S.init(R, DM, G, bx);
        pg8::EpiResid E{args.in[I_CTX], args.in[I_X], (float*)(ws + WS_XCTX), args.out, MOD + 2 * 1024, 0};
        pg8::gemm_phase<pg8::EpiResid, pg8::StaticOrder, true, true>(lds, g, S, E);
    }
    SEAM(6);
    if (IN(7)) { norm_rows<false>((const float*)(ws + WS_XCTX), args.out, args.in[I_NFFN], MOD, 3, (bf16*)(ws + WS_HF0), 0, 0, R, gw, NGW, lane, nullptr, nullptr); }
    SEAM(7);
    if (IN(8)) {
        pg8::Gemm g{(const bf16*)(ws + WS_HF0), (const bf16*)(ws + WS_W_F1), R, 5632, DM}; pg8::StaticOrder S; S.init(R, 5632, G, bx);
        pg8::EpiSwiglu E{(bf16*)(ws + WS_HH0), FFH};
        pg8::gemm_phase<pg8::EpiSwiglu, pg8::StaticOrder, true, true>(lds, g, S, E);
    }
    SEAM(8);
    if (IN(9)) {
        pg8::Gemm g{(const bf16*)(ws + WS_HH0), (const bf16*)(ws + WS_W_F2), R, DM, FFH}; pg8::StaticOrder S; S.init(R, DM, G, bx);
        pg8::EpiResid E{(const float*)(ws + WS_XCTX), args.out, (float*)(ws + WS_XCTX), args.out, MOD + 5 * 1024, 0};
        pg8::gemm_phase<pg8::EpiResid, pg8::StaticOrder, true, true>(lds, g, S, E);
    }
    SEAM(9);
    if (IN(10)) {
        norm_rows<false>((const float*)(ws + WS_XCTX), args.out, args.in[I_NMIX] + DM, MOD + 3 * 6144, 0, (bf16*)(ws + WS_H1), 0, 0, R, gw, NGW, lane, nullptr, nullptr);
        conv_plain(args.in[I_MLUP], DM, 4096, (bf16*)(ws + WS_W_UP), (LAS float*)(lds + wave * 16384), gw, NGW, lane);
        for (int i = bx * 512 + tid; i < 2 * 16 * 2048; i += G * 512) { const int which = i >> 15, gt = (i >> 11) & 15, d = i & 2047, blk = d >> 2, dd = d & 3; const float* gw = args.in[I_MLGW];
            float s = 0.f;
            if (which == 0) { const float* q = args.in[I_MLWQ] + blk * 16 + dd * 4; const float* k = args.in[I_MLWK] + blk * 16 + dd * 4;
#pragma unroll
                for (int c = 0; c < 4; ++c) s += q[c] * gw[(size_t)(4 * blk + c) * 16 + gt] + k[c] * gw[(size_t)(2048 + 4 * blk + c) * 16 + gt]; }
            else { const float* v = args.in[I_MLWV] + blk * 16 + dd * 4;
#pragma unroll
                for (int c = 0; c < 4; ++c) s += v[c] * gw[(size_t)(4096 + 4 * blk + c) * 16 + gt]; }
            ((bf16*)(ws + WS_GWT))[i] = (bf16)f2bf(s); }
    }
    SEAM(10);
    if (IN(11)) {
        pg8::Gemm g{(const bf16*)(ws + WS_H1), (const bf16*)(ws + WS_W_UP), R, 4096, DM}; pg8::StaticOrder S; S.init(R, 4096, G, bx);
        pg8::EpiSplit2 E{(bf16*)(ws + WS_XM), (bf16*)(ws + WS_Z), 2048, 8};
        pg8::gemm_phase<pg8::EpiSplit2, pg8::StaticOrder, true, true>(lds, g, S, E);
    }
    SEAM(11);
    {
        if (IN(12)) {
            phase_l1_prep(args, ws, lds, tid, lane, wave, vcu, G, 0);
            if (0 == 1) {
                LAS float* scr = (LAS float*)(lds + wave * 16384);
                __syncthreads();
                conv_plain(args.in[I_MLDOWN], 2048, 1024, (bf16*)(ws + WS_W_DN), scr, gw, NGW, lane);
                conv_ffn1(args.in[I_W1] + (size_t)DM * FFH, args.in[I_W3] + (size_t)DM * FFH, (bf16*)(ws + WS_W_F1B), scr, gw, NGW, lane);
                conv_plain(args.in[I_W2] + (size_t)FFH * DM, FFH, 1024, (bf16*)(ws + WS_W_F2B), scr, gw, NGW, lane);
            }
        }
        SEAM(12);
        if (DUP(13) && IN(13)) { phase_l1_prep(args, ws, lds, tid, lane, wave, vcu, G, 0); GBAR(); phase_l1_gatescan(args, ws, lds, tid, lane, wave, bx, G, gw, NGW, 0); GBAR(); }
        if (DUP(21) && IN(13)) { phase_l1_gatescan(args, ws, lds, tid, lane, wave, bx, G, gw, NGW, 0); GBAR(); }
        if (DUP(22) && IN(13)) { phase_l1_prep(args, ws, lds, tid, lane, wave, vcu, G, 0); GBAR(); }
        if (IN(13)) { phase_l1_gatescan(args, ws, lds, tid, lane, wave, bx, G, gw, NGW, 0); }
        SEAM(13);
        if (DUP(14) && IN(14)) { phase_l1_scan(args, ws, lds, tid, lane, wave, vcu, G, 0); GBAR(); }
        if (IN(14)) { phase_l1_scan(args, ws, lds, tid, lane, wave, vcu, G, 0); }
        SEAM(14);
        if (DUP(15) && IN(15)) { phase_l1_y(args, ws, lds, tid, lane, wave, vcu, G, 0, tacc, lo == 0); GBAR(); }
        if (IN(15)) { phase_l1_y(args, ws, lds, tid, lane, wave, vcu, G, 0, tacc); }
        SEAM(15);
    }
    {
        if (IN(16)) {
            phase_l1_prep(args, ws, lds, tid, lane, wave, vcu, G, 1);
            if (1 == 1) {
                LAS float* scr = (LAS float*)(lds + wave * 16384);
                __syncthreads();
                conv_plain(args.in[I_MLDOWN], 2048, 1024, (bf16*)(ws + WS_W_DN), scr, gw, NGW, lane);
                conv_ffn1(args.in[I_W1] + (size_t)DM * FFH, args.in[I_W3] + (size_t)DM * FFH, (bf16*)(ws + WS_W_F1B), scr, gw, NGW, lane);
                conv_plain(args.in[I_W2] + (size_t)FFH * DM, FFH, 1024, (bf16*)(ws + WS_W_F2B), scr, gw, NGW, lane);
            }
        }
        SEAM(16);
        if (DUP(13) && IN(17)) { phase_l1_prep(args, ws, lds, tid, lane, wave, vcu, G, 1); GBAR(); phase_l1_gatescan(args, ws, lds, tid, lane, wave, bx, G, gw, NGW, 1); GBAR(); }
        if (DUP(21) && IN(17)) { phase_l1_gatescan(args, ws, lds, tid, lane, wave, bx, G, gw, NGW, 1); GBAR(); }
        if (DUP(22) && IN(17)) { phase_l1_prep(args, ws, lds, tid, lane, wave, vcu, G, 1); GBAR(); }
        if (IN(17)) { phase_l1_gatescan(args, ws, lds, tid, lane, wave, bx, G, gw, NGW, 1); }
        SEAM(17);
        if (DUP(14) && IN(18)) { phase_l1_scan(args, ws, lds, tid, lane, wave, vcu, G, 1); GBAR(); }
        if (IN(18)) { phase_l1_scan(args, ws, lds, tid, lane, wave, vcu, G, 1); }
        SEAM(18);
        if (DUP(15) && IN(19)) { phase_l1_y(args, ws, lds, tid, lane, wave, vcu, G, 1, tacc, lo == 0); GBAR(); }
        if (IN(19)) { phase_l1_y(args, ws, lds, tid, lane, wave, vcu, G, 1, tacc); }
        SEAM(19);
    }
    if (IN(20)) {
        pg8::Gemm g{(const bf16*)(ws + WS_Z) + (size_t)RL0 * 2048, (const bf16*)(ws + WS_W_DN), MLAT, DM, 2048}; pg8::StaticOrder S; S.init(MLAT, DM, G, bx);
        pg8::EpiResid E{(const float*)(ws + WS_XCTX), args.out, (float*)(ws + WS_XCTX), args.out, MOD + 3 * 6144 + 2 * 1024, RL0};
        pg8::gemm_phase<pg8::EpiResid, pg8::StaticOrder, true, true>(lds, g, S, E);
    }
    SEAM(20);
    if (IN(21)) { norm_rows<false>((const float*)(ws + WS_XCTX), args.out, args.in[I_NFFN] + DM, MOD + 3 * 6144, 3, (bf16*)(ws + WS_HF1), RL0, RL0, R, gw, NGW, lane, nullptr, nullptr); }
    SEAM(21);
    if (IN(22)) {
        pg8::Gemm g{(const bf16*)(ws + WS_HF1), (const bf16*)(ws + WS_W_F1B), MLAT, 5632, DM}; pg8::StaticOrder S; S.init(MLAT, 5632, G, bx);
        pg8::EpiSwiglu E{(bf16*)(ws + WS_HH1), FFH};
        pg8::gemm_phase<pg8::EpiSwiglu, pg8::StaticOrder, true, true>(lds, g, S, E);
    }
    SEAM(22);
    if (IN(23)) {
        pg8::Gemm g{(const bf16*)(ws + WS_HH1), (const bf16*)(ws + WS_W_F2B), MLAT, DM, FFH}; pg8::StaticOrder S; S.init(MLAT, DM, G, bx);
        pg8::EpiResid E{(const float*)(ws + WS_XCTX), args.out, (float*)(ws + WS_XCTX), args.out, MOD + 3 * 6144 + 5 * 1024, RL0};
        pg8::gemm_phase<pg8::EpiResid, pg8::StaticOrder, true, true>(lds, g, S, E);
    }
    SEAM(23);
    if (IN(24)) {
        const float* w = args.in[I_FNW];
        for (int m = gw; m < MLAT; m += NGW) {
            float* row = args.out + (size_t)m * DM; f32x4 v[4]; float ss = 0.f;
#pragma unroll
            for (int j = 0; j < 4; ++j) { v[j] = *(const f32x4*)(row + 4 * lane + 256 * j); ss += (v[j].x * v[j].x + v[j].y * v[j].y) + (v[j].z * v[j].z + v[j].w * v[j].w); }
            const float rstd = 1.0f / sqrtf(wave_sum(ss) * (1.f / DM) + RMS_EPS);
#pragma unroll
            for (int j = 0; j < 4; ++j) { const f32x4 wv = *(const f32x4*)(w + 4 * lane + 256 * j); *(f32x4*)(row + 4 * lane + 256 * j) = v[j] * rstd * wv; }
        }
    }
    TEND(24);
    if (TPROBE_MASK || YSEC >= 0) { if (bx == 0) { if (tid == 0) { const unsigned long long t0 = __builtin_amdgcn_s_memrealtime(); while (__builtin_amdgcn_s_memrealtime() - t0 < tacc) __builtin_amdgcn_s_sleep(8); } __syncthreads(); } }
#undef IN
#undef SEAM
}

extern "C" void kernel_launch(void* const* d_in, const int* in_sizes, int n_in, void* d_out, int out_size, void* d_ws, size_t ws_size, hipStream_t stream) {
    static int grid = 0;
    if (grid == 0) {
        if (n_in != 35 || out_size != MLAT * DM || ws_size < WS_END) { fprintf(stderr, "kernel_launch: unexpected problem: n_in %d out %d ws %zu\n", n_in, out_size, ws_size); grid = -1; return; }
        int dev = 0, cus = 0;
        if (hipGetDevice(&dev) != hipSuccess || hipDeviceGetAttribute(&cus, hipDeviceAttributeMultiprocessorCount, dev) != hipSuccess) { grid = -1; return; }
        if (hipFuncSetAttribute((const void*)mk_fwd, hipFuncAttributeMaxDynamicSharedMemorySize, LDS_BYTES) != hipSuccess) { fprintf(stderr, "kernel_launch: hipFuncSetAttribute failed\n"); grid = -1; return; }
        int per_cu = 0;
        if (hipOccupancyMaxActiveBlocksPerMultiprocessor(&per_cu, (const void*)mk_fwd, NWAVES * 64, LDS_BYTES) != hipSuccess || per_cu < 1) fprintf(stderr, "kernel_launch: occupancy query says %d\n", per_cu);
        (void)hipGetLastError();
        grid = cus;
    }
    if (grid < 0) return;
    if (hipMemsetAsync((char*)d_ws + WS_CTL, 0, CTL_ZERO_BYTES, stream) != hipSuccess) return;
    Args a{};
    for (int i = 0; i < 35; ++i) a.in[i] = (const float*)d_in[i];
    a.out = (float*)d_out; a.ws = (unsigned char*)d_ws;
#if MK_PER_PHASE
    for (int p = 0; p < N_PHASES; ++p) { a.ph_lo = p; a.ph_hi = p + 1; hipLaunchKernelGGL(mk_fwd, dim3(grid), dim3(NWAVES * 64), LDS_BYTES, stream, a); }
#else
    a.ph_lo = 0; a.ph_hi = N_PHASES;
    hipLaunchKernelGGL(mk_fwd, dim3(grid), dim3(NWAVES * 64), LDS_BYTES, stream, a);
#endif
}
```

```cpp
#include <hip/hip_runtime.h>
#include <cstdio>
#include <cstdint>
#define BARRIER2 1
namespace pg8 {
#define PG8_LAS __attribute__((address_space(3)))
typedef unsigned short bf16_t;
typedef short bf16x8 __attribute__((ext_vector_type(8)));
typedef float f32x4 __attribute__((ext_vector_type(4)));
typedef unsigned u32x4 __attribute__((ext_vector_type(4)));
constexpr int BM = 256, BK = 64, HALF = 128, HTB = HALF * BK * 2  , STAGE_BYTES = 8 * HTB, NXCD = 8, WGM = 8;

__host__ __device__ __forceinline__ int lds_byte(int r, int c) { const int st = (r >> 4) * 2 + (c >> 5), rr = r & 15, cc = c & 31, ob = rr * 64 + cc * 2; return st * 1024 + (ob ^ (((ob >> 9) & 1) << 5)); }
__host__ __device__ __forceinline__ void stage_rc(int b, int& R, int& C) { const int st = b / 1024, sb = b % 1024, swz = sb ^ (((sb >> 9) & 1) << 5); R = (st >> 1) * 16 + swz / 64; C = (st & 1) * 32 + (swz % 64) / 2; }
__host__ __device__ __forceinline__ int perm32(int rho) { const int n = rho >> 4, i = rho & 15; return 8 * (i >> 2) + 4 * n + (i & 3); }

struct Unit { int pm, pn; int ko = 0, nt = 0; };
struct Gemm { const bf16_t* A; const bf16_t* Bt; int M, N, K; };

struct StaticOrder {
    int nM, nN, nwg, G, c;
    __host__ __device__ void init(int M, int N, int G_, int c_) { nM = M / BM; nN = N / BM; nwg = nM * nN; G = G_; c = c_; }
    __host__ __device__ bool next(int i, Unit& u) const {
        const long L = (long)i * G + c; if (L >= nwg) return false;
        int wgid = (int)L; { const int q = nwg / NXCD, r = nwg % NXCD, xcd = wgid % NXCD, off = wgid / NXCD; wgid = (xcd < r ? xcd * (q + 1) : r * (q + 1) + (xcd - r) * q) + off; }
        const int nig = WGM * nN, gid = wgid / nig, fm = gid * WGM, gsz = (nM - fm) < WGM ? (nM - fm) : WGM;
        u.pm = fm + ((wgid % nig) % gsz); u.pn = (wgid % nig) / gsz; return true;
    }
    __device__ __forceinline__ void a_ready(const Unit&) const {}
    __device__ __forceinline__ void done(const Unit&) const {}
};

__device__ __forceinline__ unsigned cvt_pk_bf16(float lo, float hi) { unsigned r; asm volatile("v_cvt_pk_bf16_f32 %0, %1, %2" : "=v"(r) : "v"(lo), "v"(hi)); return r; }
__device__ __forceinline__ float fast_silu(float a) { return a * __builtin_amdgcn_rcpf(1.0f + __expf(-a)); }

struct EpiInProj {
    static constexpr bool PERM = true, AFTER_DRAIN = false;
    bf16_t *ZG, *XBC, *QK, *V, *HALO;
    __device__ __forceinline__ void operator()(const f32x4 (&acc)[2][2][4][2], const Unit& u, int wr, int wc, int fr, int fq) const {
        const int pn = u.pn; bf16_t* base; int ld, c0; bool halo = false;
        if (pn < 4) { base = ZG; ld = 2048; c0 = 256 * pn; }
        else if (pn < 12) { base = XBC; ld = 2048; c0 = 256 * (pn - 4); halo = true; }
        else if (pn < 16) { base = QK; ld = 1024; c0 = 256 * (pn - 12); }
        else if (pn < 20) { base = V; ld = 1024; c0 = 256 * (pn - 16); }
        else { base = ZG; ld = 2048; c0 = 1024 + 256 * (pn - 20); }
        const int row0 = u.pm * BM + wr * 64 + fr, col = c0 + wc * 32 + 8 * fq;
#pragma unroll
        for (int ai = 0; ai < 2; ++ai)
#pragma unroll
            for (int m = 0; m < 4; ++m) { const int r = row0 + ai * HALF + m * 16; bf16_t* rowp = base + (size_t)r * ld + col;
                const int rr = r & 31; const bool hrow = halo && (rr < 2 || rr >= 30);
#pragma unroll
                for (int bj = 0; bj < 2; ++bj) { const f32x4 v0 = acc[ai][bj][m][0], v1 = acc[ai][bj][m][1];
                    u32x4 w; w.x = cvt_pk_bf16(v0[0], v0[1]); w.y = cvt_pk_bf16(v0[2], v0[3]); w.z = cvt_pk_bf16(v1[0], v1[1]); w.w = cvt_pk_bf16(v1[2], v1[3]);
                    *(u32x4*)(rowp + bj * HALF) = w;
                    if (hrow) { const int slot = rr < 2 ? rr : rr - 28; *(u32x4*)(HALO + ((size_t)(r >> 5) * 4 + slot) * 2048 + col + bj * HALF) = w; } } }
    }
};
struct EpiSplit2 {
    static constexpr bool PERM = true, AFTER_DRAIN = false;
    bf16_t *O0, *O1; int ld, split_tiles;
    __device__ __forceinline__ void operator()(const f32x4 (&acc)[2][2][4][2], const Unit& u, int wr, int wc, int fr, int fq) const {
        bf16_t* base = u.pn < split_tiles ? O0 : O1; const int c0 = 256 * (u.pn < split_tiles ? u.pn : u.pn - split_tiles);
        const int row0 = u.pm * BM + wr * 64 + fr, col = c0 + wc * 32 + 8 * fq;
#pragma unroll
        for (int ai = 0; ai < 2; ++ai)
#pragma unroll
            for (int m = 0; m < 4; ++m) { bf16_t* rowp = base + (size_t)(row0 + ai * HALF + m * 16) * ld + col;
#pragma unroll
                for (int bj = 0; bj < 2; ++bj) { const f32x4 v0 = acc[ai][bj][m][0], v1 = acc[ai][bj][m][1];
                    u32x4 w; w.x = cvt_pk_bf16(v0[0], v0[1]); w.y = cvt_pk_bf16(v0[2], v0[3]); w.z = cvt_pk_bf16(v1[0], v1[1]); w.w = cvt_pk_bf16(v1[2], v1[3]);
                    *(u32x4*)(rowp + bj * HALF) = w; } }
    }
};
struct EpiSwiglu {
    static constexpr bool PERM = true, AFTER_DRAIN = false;
    bf16_t* O; int ld;
    __device__ __forceinline__ void operator()(const f32x4 (&acc)[2][2][4][2], const Unit& u, int wr, int wc, int fr, int fq) const {
        const int row0 = u.pm * BM + wr * 64 + fr, col = u.pn * HALF + wc * 32 + 8 * fq;
#pragma unroll
        for (int ai = 0; ai < 2; ++ai)
#pragma unroll
            for (int m = 0; m < 4; ++m) { bf16_t* rowp = O + (size_t)(row0 + ai * HALF + m * 16) * ld + col;
                float h[8];
#pragma unroll
                for (int n = 0; n < 2; ++n)
#pragma unroll
                    for (int j = 0; j < 4; ++j) h[4 * n + j] = fast_silu(acc[ai][0][m][n][j]) * acc[ai][1][m][n][j];
                u32x4 w; w.x = cvt_pk_bf16(h[0], h[1]); w.y = cvt_pk_bf16(h[2], h[3]); w.z = cvt_pk_bf16(h[4], h[5]); w.w = cvt_pk_bf16(h[6], h[7]);
                *(u32x4*)rowp = w; }
    }
};
struct EpiResid {
    static constexpr bool PERM = false, AFTER_DRAIN = false;
    const float *resC, *resL; float *outC, *outL; const float* gate; int row_off;
    __device__ __forceinline__ void operator()(const f32x4 (&acc)[2][2][4][2], const Unit& u, int wr, int wc, int fr, int fq) const {
        const int t0 = u.pm * BM + row_off; const float* res; float* out; const float* g; int rbase;
        if (t0 < 512) { res = resC; out = outC; g = gate; rbase = t0; }
        else { res = resL; out = outL; rbase = t0 - 512; g = gate + (size_t)(1 + (rbase >> 13)) * 6144; }
        const int row0 = rbase + wr * 64 + fr, col0 = u.pn * BM + wc * 32 + 4 * fq;
        f32x4 gv[2][2];
#pragma unroll
        for (int bj = 0; bj < 2; ++bj)
#pragma unroll
            for (int n = 0; n < 2; ++n) gv[bj][n] = *(const f32x4*)(g + col0 + bj * HALF + n * 16);
#pragma unroll
        for (int ai = 0; ai < 2; ++ai)
#pragma unroll
            for (int m = 0; m < 4; ++m) { const size_t off = (size_t)(row0 + ai * HALF + m * 16) * 1024 + col0;
#pragma unroll
                for (int bj = 0; bj < 2; ++bj)
#pragma unroll
                    for (int n = 0; n < 2; ++n) { const f32x4 bs = *(const f32x4*)(res + off + bj * HALF + n * 16);
                        *(f32x4*)(out + off + bj * HALF + n * 16) = bs + gv[bj][n] * acc[ai][bj][m][n]; }
                if (m & 1) asm volatile("" ::: "memory"); }
    }
};


struct CtxSplitOrder {
    StaticOrder lat; int G, c, nslice;
    __host__ __device__ void init(int G_, int c_, int nslice_) { lat.init(16384, 1024, G_, c_); G = G_; c = c_; nslice = nslice_; }
    __host__ __device__ bool next(int i, Unit& u) const {
        const long L = (long)i * G + c;
        if (L < 256) { const bool ok = lat.next(i, u); u.pm += 2; u.ko = 0; u.nt = 0; return ok; }
        const int l2 = (int)L - 256; if (l2 >= 8 * nslice) return false;
        const int slice = l2 >> 3, tile = l2 & 7; u.pm = tile >> 2; u.pn = tile & 3; u.ko = slice * 256; u.nt = 4; return true;
    }
    __device__ __forceinline__ void a_ready(const Unit&) const {}
    __device__ __forceinline__ void done(const Unit&) const {}
};
struct EpiResidSplit {
    static constexpr bool PERM = false, AFTER_DRAIN = false;
    const float* resL; float* outL; const float* gate; float* part;
    __device__ __forceinline__ void operator()(const f32x4 (&acc)[2][2][4][2], const Unit& u, int wr, int wc, int fr, int fq) const {
        const int col0 = u.pn * BM + wc * 32 + 4 * fq;
        if (u.nt) {
            float* P = part + (size_t)(u.ko >> 8) * 512 * 1024; const int row0 = u.pm * BM + wr * 64 + fr;
#pragma unroll
            for (int ai = 0; ai < 2; ++ai)
#pragma unroll
                for (int m = 0; m < 4; ++m) { const size_t off = (size_t)(row0 + ai * HALF + m * 16) * 1024 + col0;
#pragma unroll
                    for (int bj = 0; bj < 2; ++bj)
#pragma unroll
                        for (int n = 0; n < 2; ++n) *(f32x4*)(P + off + bj * HALF + n * 16) = acc[ai][bj][m][n]; }
            return;
        }
        const int rbase = u.pm * BM - 512; const float* g = gate + (size_t)(1 + (rbase >> 13)) * 6144;
        const int row0 = rbase + wr * 64 + fr;
        f32x4 gv[2][2];
#pragma unroll
        for (int bj = 0; bj < 2; ++bj)
#pragma unroll
            for (int n = 0; n < 2; ++n) gv[bj][n] = *(const f32x4*)(g + col0 + bj * HALF + n * 16);
#pragma unroll
        for (int ai = 0; ai < 2; ++ai)
#pragma unroll
            for (int m = 0; m < 4; ++m) { const size_t off = (size_t)(row0 + ai * HALF + m * 16) * 1024 + col0;
#pragma unroll
                for (int bj = 0; bj < 2; ++bj)
#pragma unroll
                    for (int n = 0; n < 2; ++n) { const f32x4 bs = *(const f32x4*)(resL + off + bj * HALF + n * 16);
                        *(f32x4*)(outL + off + bj * HALF + n * 16) = bs + gv[bj][n] * acc[ai][bj][m][n]; }
                if (m & 1) asm volatile("" ::: "memory"); }
    }
};

template <class Epi, class Sched, bool ALIGN_EPI = false, bool SP2 = false>
__device__ __forceinline__ void gemm_phase(PG8_LAS unsigned char* lds, const Gemm g, const Sched& S, const Epi& E) {
    const int tid = threadIdx.x, wid = __builtin_amdgcn_readfirstlane(tid >> 6), lane = tid & 63, wr = wid >> 2, wc = wid & 3, fr = lane & 15, fq = lane >> 4;
    const int K = g.K;
    unsigned voffA[2], voffB[2];
#pragma unroll
    for (int i = 0; i < 2; ++i) { int R, C; stage_rc(tid * 16 + i * 8192, R, C); const int Rb = Epi::PERM ? ((R & ~31) + perm32(R & 31)) : R;
        voffA[i] = (unsigned)(R * K + C) * 2u; voffB[i] = (unsigned)(Rb * K + C) * 2u; }
    const size_t kstep = (size_t)(BK * 2);
    const size_t hstep = (size_t)HALF * K * 2;
    const size_t tstep = 2 * hstep;
    const unsigned ldsw = (unsigned)wid * 1024u;
    const int aoff = lds_byte(wr * 64 + fr, fq * 8), boff = lds_byte(wc * 32 + fr, fq * 8);
#define PG8_SA(b, h) (((b) * 2 + (h)) * HTB)
#define PG8_SB(b, h) ((4 + (b) * 2 + (h)) * HTB)
#define PG8_STAGE(bufoff, gbase, voff) do { _Pragma("unroll") for (int _i = 0; _i < 2; ++_i) \
        __builtin_amdgcn_global_load_lds((const unsigned*)((const char*)(gbase) + (voff)[_i]), (PG8_LAS unsigned*)(lds + (bufoff) + ldsw + _i * 8192), 16, 0, 0); } while (0)
#define PG8_LDA(dst, b, h) do { _Pragma("unroll") for (int m = 0; m < 4; ++m) _Pragma("unroll") for (int k = 0; k < 2; ++k) dst[m][k] = *(const PG8_LAS bf16x8*)(lds + PG8_SA(b, h) + aoff + m * 2048 + k * 1024); } while (0)
#define PG8_LDB(dst, b, h) do { _Pragma("unroll") for (int n = 0; n < 2; ++n) _Pragma("unroll") for (int k = 0; k < 2; ++k) dst[n][k] = *(const PG8_LAS bf16x8*)(lds + PG8_SB(b, h) + boff + n * 2048 + k * 1024); } while (0)
#define PG8_MMA(ai, bj, At, Bt) do { __builtin_amdgcn_s_setprio(1); _Pragma("unroll") for (int m = 0; m < 4; ++m) _Pragma("unroll") for (int n = 0; n < 2; ++n) _Pragma("unroll") for (int k = 0; k < 2; ++k) \
        acc[ai][bj][m][n] = __builtin_amdgcn_mfma_f32_16x16x32_bf16(Bt[n][k], At[m][k], acc[ai][bj][m][n], 0, 0, 0); __builtin_amdgcn_s_setprio(0); } while (0)
#define PG8_WAIT_V(n) asm volatile("s_waitcnt vmcnt(" #n ")" ::: "memory")
#define PG8_WAIT_L(n) asm volatile("s_waitcnt lgkmcnt(" #n ")" ::: "memory")
#define PG8_BAR __builtin_amdgcn_s_barrier()
#define PG8_SCHED __builtin_amdgcn_sched_barrier(0)
    Unit cur, nxt; int ui = 0;
    if (!S.next(0, cur)) return;
    f32x4 acc[2][2][4][2];
#pragma unroll
    for (int a = 0; a < 2; ++a)
#pragma unroll
        for (int b = 0; b < 2; ++b)
#pragma unroll
            for (int m = 0; m < 4; ++m)
#pragma unroll
                for (int n = 0; n < 2; ++n) acc[a][b][m][n] = (f32x4){0.f, 0.f, 0.f, 0.f};
    bf16x8 At[4][2], B0[2][2], B1[2][2];
    const char* cA = (const char*)g.A + (size_t)cur.pm * tstep + (size_t)cur.ko * 2; const char* cB = (const char*)g.Bt + (size_t)cur.pn * tstep + (size_t)cur.ko * 2;
    S.a_ready(cur);
    if constexpr (SP2) {
        PG8_STAGE(PG8_SB(0, 0), cB, voffB); PG8_STAGE(PG8_SB(0, 1), cB + hstep, voffB); PG8_STAGE(PG8_SA(0, 0), cA, voffA); PG8_STAGE(PG8_SA(0, 1), cA + hstep, voffA);
        if (wr == 1) PG8_BAR;
        PG8_WAIT_V(2); PG8_BAR;
        PG8_STAGE(PG8_SB(1, 0), cB + kstep, voffB); PG8_STAGE(PG8_SA(1, 0), cA + kstep, voffA); PG8_STAGE(PG8_SB(1, 1), cB + hstep + kstep, voffB);
        PG8_WAIT_V(6); PG8_BAR;
    } else {
        PG8_STAGE(PG8_SB(0, 0), cB, voffB); PG8_STAGE(PG8_SA(0, 0), cA, voffA); PG8_STAGE(PG8_SB(0, 1), cB + hstep, voffB); PG8_STAGE(PG8_SA(0, 1), cA + hstep, voffA);
        if (wr == 1) PG8_BAR;
        PG8_WAIT_V(4); PG8_BAR;
        PG8_STAGE(PG8_SB(1, 0), cB + kstep, voffB); PG8_STAGE(PG8_SA(1, 0), cA + kstep, voffA); PG8_STAGE(PG8_SB(1, 1), cB + hstep + kstep, voffB);
        PG8_WAIT_V(6); PG8_BAR;
    }
    for (;;) {
        const bool has_next = S.next(ui + 1, nxt);
        const char* nA = has_next ? (const char*)g.A + (size_t)nxt.pm * tstep + (size_t)nxt.ko * 2 : cA; const char* nB = has_next ? (const char*)g.Bt + (size_t)nxt.pn * tstep + (size_t)nxt.ko * 2 : cB;
        const int nt = cur.nt ? cur.nt : K / BK;
        for (int t = 0; t < nt; t += 2) {
            const bool last = (t == nt - 2);
            const char* a1 = cA + (size_t)(t + 1) * kstep;
            const char* a2 = last ? nA : cA + (size_t)(t + 2) * kstep; const char* b2 = last ? nB : cB + (size_t)(t + 2) * kstep;
            const char* a3 = a2 + kstep; const char* b3 = b2 + kstep;
            if (last && has_next) S.a_ready(nxt);
            if constexpr (SP2) {
            PG8_LDB(B0, 0, 0); PG8_LDB(B1, 0, 1); PG8_SCHED; PG8_LDA(At, 0, 0); PG8_STAGE(PG8_SA(1, 1), a1 + hstep, voffA);
            PG8_WAIT_V(8); PG8_WAIT_L(0); PG8_BAR; PG8_MMA(0, 0, At, B0); PG8_MMA(0, 1, At, B1); PG8_BAR; PG8_SCHED;
            PG8_LDA(At, 0, 1); PG8_STAGE(PG8_SB(0, 0), b2, voffB); PG8_STAGE(PG8_SB(0, 1), b2 + hstep, voffB); PG8_STAGE(PG8_SA(0, 0), a2, voffA);
            PG8_WAIT_V(8); PG8_WAIT_L(0); PG8_BAR; PG8_MMA(1, 0, At, B0); PG8_MMA(1, 1, At, B1); PG8_BAR; PG8_SCHED;
            PG8_LDB(B0, 1, 0); PG8_LDB(B1, 1, 1); PG8_SCHED; PG8_LDA(At, 1, 0); PG8_STAGE(PG8_SA(0, 1), a2 + hstep, voffA);
            PG8_WAIT_V(8); PG8_WAIT_L(0); PG8_BAR; PG8_MMA(0, 0, At, B0); PG8_MMA(0, 1, At, B1); PG8_BAR; PG8_SCHED;
            PG8_LDA(At, 1, 1); PG8_STAGE(PG8_SB(1, 0), b3, voffB); PG8_STAGE(PG8_SB(1, 1), b3 + hstep, voffB); PG8_STAGE(PG8_SA(1, 0), a3, voffA);
            PG8_WAIT_V(8); PG8_WAIT_L(0); PG8_BAR; PG8_MMA(1, 0, At, B0); PG8_MMA(1, 1, At, B1); PG8_BAR; PG8_SCHED;
            } else {
            PG8_LDB(B0, 0, 0); PG8_SCHED; PG8_LDA(At, 0, 0); PG8_STAGE(PG8_SA(1, 1), a1 + hstep, voffA);
            PG8_WAIT_L(8); PG8_BAR; PG8_WAIT_L(0); PG8_MMA(0, 0, At, B0); PG8_BAR; PG8_SCHED;
            PG8_LDB(B1, 0, 1); PG8_STAGE(PG8_SB(0, 0), b2, voffB);
            PG8_BAR; PG8_WAIT_L(0); PG8_MMA(0, 1, At, B1); PG8_BAR;
            PG8_LDA(At, 0, 1); PG8_STAGE(PG8_SA(0, 0), a2, voffA);
            PG8_BAR; PG8_WAIT_L(0); PG8_MMA(1, 0, At, B0); PG8_BAR; PG8_SCHED;
            PG8_STAGE(PG8_SB(0, 1), b2 + hstep, voffB);
            PG8_WAIT_V(6); PG8_BAR; PG8_MMA(1, 1, At, B1); PG8_BAR;
            PG8_LDB(B0, 1, 0); PG8_SCHED; PG8_LDA(At, 1, 0); PG8_STAGE(PG8_SA(0, 1), a2 + hstep, voffA);
            PG8_WAIT_L(8); PG8_BAR; PG8_WAIT_L(0); PG8_MMA(0, 0, At, B0); PG8_BAR; PG8_SCHED;
            PG8_LDB(B1, 1, 1); PG8_STAGE(PG8_SB(1, 0), b3, voffB);
            PG8_BAR; PG8_WAIT_L(0); PG8_MMA(0, 1, At, B1); PG8_BAR;
            PG8_LDA(At, 1, 1); PG8_STAGE(PG8_SA(1, 0), a3, voffA);
            PG8_BAR; PG8_WAIT_L(0); PG8_MMA(1, 0, At, B0); PG8_BAR; PG8_SCHED;
            PG8_STAGE(PG8_SB(1, 1), b3 + hstep, voffB);
            PG8_WAIT_V(6); PG8_BAR; PG8_MMA(1, 1, At, B1); PG8_BAR;
            }
        }
        if constexpr (ALIGN_EPI) { if (wr == 0) PG8_BAR; }
        if constexpr (!Epi::AFTER_DRAIN) { E(acc, cur, wr, wc, fr, fq); S.done(cur); }
        if (!has_next) break;
#pragma unroll
        for (int a = 0; a < 2; ++a)
#pragma unroll
            for (int b = 0; b < 2; ++b)
#pragma unroll
                for (int m = 0; m < 4; ++m)
#pragma unroll
                    for (int n = 0; n < 2; ++n) acc[a][b][m][n] = (f32x4){0.f, 0.f, 0.f, 0.f};
        cur = nxt; cA = nA; cB = nB; ++ui;
        if constexpr (ALIGN_EPI) { if (wr == 1) PG8_BAR; }
    }
    PG8_WAIT_V(0);
    if constexpr (!ALIGN_EPI) { if (wr == 0) PG8_BAR; }
    PG8_BAR;
    if constexpr (Epi::AFTER_DRAIN) { E.fused(acc, cur, wr, wc, fr, fq, lds, wid, lane); S.done(cur); }
#undef PG8_SA
#undef PG8_SB
#undef PG8_STAGE
#undef PG8_LDA
#undef PG8_LDB
#undef PG8_MMA
#undef PG8_WAIT_V
#undef PG8_WAIT_L
#undef PG8_BAR
#undef PG8_SCHED
}
}


constexpr int NWAVES = 8;
constexpr int DM = 1024, SEQ = 8192, CTXL = 256, NB = 2;
constexpr int R = NB * (SEQ + CTXL);
constexpr int RL0 = NB * CTXL;
constexpr int MLAT = NB * SEQ;
constexpr int FFH = 2816;
constexpr int ABIN = 6160;
constexpr float RMS_EPS = 1e-6f, LN_EPS = 1e-5f;

constexpr size_t MiB = 1u << 20;
constexpr size_t WS_CTL = 0, CTL_ZERO_BYTES = 1 * MiB;
constexpr size_t CTL_MOD = 256 * 1024;
constexpr size_t WS_XCTX = 1 * MiB;
constexpr size_t WS_DTRAW = 3 * MiB, WS_DTF = WS_DTRAW + 1280 * 1024, WS_DTB = WS_DTF + 1280 * 1024, WS_CSF = WS_DTB + 1280 * 1024, WS_RB = WS_CSF + 1280 * 1024;
constexpr size_t WS_WQK = 9 * MiB + 256 * 1024;
constexpr size_t WS_HALO = 9 * MiB + 512 * 1024;
constexpr size_t WS_W_IN = 18 * MiB, WS_W_OUT = 30 * MiB, WS_W_F1 = 34 * MiB, WS_W_F2 = 45 * MiB;
constexpr size_t WS_ZG = 51 * MiB, WS_XBC = 117 * MiB, WS_QK = 183 * MiB, WS_V = 216 * MiB;
constexpr size_t WS_HF0 = WS_V, WS_HH0 = WS_XBC;
constexpr size_t WS_GATE = 3 * MiB, WS_BC = WS_GATE + 1280 * 1024, WS_AJ = WS_BC + 768 * 1024, WS_CM = WS_AJ + 768 * 1024, WS_CH = WS_CM + 768 * 1024, WS_NV = WS_CH + 256 * 1024;
constexpr size_t WS_W_UP = 10 * MiB, WS_H1 = 18 * MiB, WS_XC = 18 * MiB, WS_XM = 51 * MiB, WS_Z = 117 * MiB, WS_ST1 = 183 * MiB;
constexpr size_t WS_W_DN = 53 * MiB, WS_W_F1B = 57 * MiB, WS_W_F2B = 68 * MiB;
constexpr size_t WS_HF1 = WS_Z, WS_HH1 = 150 * MiB;
constexpr size_t WS_END = 256 * MiB;
constexpr size_t DO_H = 0, DO_ST_SSD = 0, DO_ST_RET = 32 * MiB;
constexpr int CW_TMO = 0, CW_CODE = 1, CW_BAR = 4096;

constexpr int RING_BYTES = 131072;
constexpr int SCR_BYTES = 143360;
constexpr int LDSCTL_OFF = SCR_BYTES, MISC_OFF = LDSCTL_OFF + 320;
constexpr int LDS_BYTES = 147456;

#define GAS __attribute__((address_space(1)))
#define LAS __attribute__((address_space(3)))
typedef unsigned short bf16;
typedef unsigned v4u __attribute__((ext_vector_type(4)));
typedef unsigned v2u __attribute__((ext_vector_type(2)));
typedef float f32x4 __attribute__((ext_vector_type(4)));
typedef short bf16x8 __attribute__((ext_vector_type(8)));
typedef short s16x4 __attribute__((ext_vector_type(4)));
typedef GAS unsigned gu32;
#define RLX_AGENT __ATOMIC_RELAXED, __HIP_MEMORY_SCOPE_AGENT
#define LDS_WAIT() asm volatile("s_waitcnt lgkmcnt(0)" ::: "memory")
#define VM_WAIT() asm volatile("s_waitcnt vmcnt(0)" ::: "memory")
__device__ __forceinline__ unsigned f2bf(float f) { unsigned u = __builtin_bit_cast(unsigned, f); return (u + 0x7fffu + ((u >> 16) & 1u)) >> 16; }
typedef float f32x2_t __attribute__((ext_vector_type(2)));
typedef __bf16 bf16x2_t __attribute__((ext_vector_type(2)));
__device__ __forceinline__ unsigned pk2(float lo, float hi) { f32x2_t v = {lo, hi}; bf16x2_t b = __builtin_convertvector(v, bf16x2_t); return __builtin_bit_cast(unsigned, b); }
__device__ __forceinline__ float bf2f(unsigned short h) { return __builtin_bit_cast(float, (unsigned)h << 16); }
__device__ __forceinline__ float bflo(unsigned w) { return __builtin_bit_cast(float, w << 16); }
__device__ __forceinline__ float bfhi(unsigned w) { return __builtin_bit_cast(float, w & 0xffff0000u); }
__device__ __forceinline__ float silu_f(float a) { return a * __builtin_amdgcn_rcpf(1.0f + __expf(-a)); }
__device__ __forceinline__ float softplus_f(float x) { return x > 20.f ? x : log1pf(__expf(x)); }
__device__ __forceinline__ float logsig_f(float x) { return x >= 0.f ? -log1pf(__expf(-x)) : x - log1pf(__expf(x)); }
__device__ __forceinline__ float wave_sum(float v) {
#pragma unroll
    for (int o = 1; o < 64; o <<= 1) v += __shfl_xor(v, o);
    return v;
}
__device__ __forceinline__ float wave_max(float v) {
#pragma unroll
    for (int o = 1; o < 64; o <<= 1) v = fmaxf(v, __shfl_xor(v, o));
    return v;
}

#define XB_TMO      128
#define XB_XCNT(j)  (256  + 64 * (j))
#define XB_XSUB(j)  (1280 + 64 * (j))
#define XB_XGEN(j)  (2304 + 64 * (j))
#define XB_TOP      3328
#define XB_TOPGEN   3392
#define XCD_BAR_WORDS 3456
#define XB_SPIN_CAP (1u << 18)

__device__ __forceinline__ unsigned xb_ld(unsigned* p)              { return __hip_atomic_load(p, __ATOMIC_RELAXED, __HIP_MEMORY_SCOPE_AGENT); }
__device__ __forceinline__ unsigned xb_add(unsigned* p, unsigned v) { return __hip_atomic_fetch_add(p, v, __ATOMIC_RELAXED, __HIP_MEMORY_SCOPE_AGENT); }
__device__ __forceinline__ unsigned xb_xcc_id() { return (unsigned)__builtin_amdgcn_s_getreg((3 << 11) | 20) & 0xFu; }
#define XB_SPIN(cond, bar) do { unsigned _sp = 0; while (cond) { __builtin_amdgcn_s_sleep(1); \
    if ((++_sp & 255u) == 0u) { if (xb_ld(&(bar)[XB_TMO])) break; if (_sp > XB_SPIN_CAP) { atomicAdd(&(bar)[XB_TMO], 1u); break; } } } } while (0)

struct XcdBarrier {
    unsigned* bar; unsigned x;
    volatile LAS unsigned* st;
};

__device__ __forceinline__ XcdBarrier xcd_barrier_post(unsigned* bar, volatile LAS unsigned* st) {
    XcdBarrier b; b.bar = bar; b.x = xb_xcc_id(); b.st = st;
    if (threadIdx.x == 0) (void)xb_add(&bar[XB_XCNT(b.x)], 1u);
    return b;
}
__device__ __forceinline__ void xcd_barrier_complete(unsigned* bar, unsigned x, unsigned& nloc, unsigned& nx) {
    const unsigned G = gridDim.x * gridDim.y * gridDim.z;
    unsigned sum, cnt, mine, sp = 0u;
    for (;;) {
        sum = 0u; cnt = 0u; mine = 0u;
#pragma unroll
        for (unsigned j = 0; j < 16; ++j) { const unsigned c = xb_ld(&bar[XB_XCNT(j)]); sum += c; cnt += (c > 0u) ? 1u : 0u; mine = (j == x) ? c : mine; }
        if (sum == G) break;
        __builtin_amdgcn_s_sleep(1);
        if ((++sp & 255u) == 0u) { if (xb_ld(&bar[XB_TMO])) break; if (sp > XB_SPIN_CAP) { atomicAdd(&bar[XB_TMO], 1u); break; } }
    }
    nloc = mine > 0u ? mine : 1u; nx = cnt > 0u ? cnt : 1u;
}

__device__ __forceinline__ void xcd_barrier(const XcdBarrier& b) {
    asm volatile("s_waitcnt vmcnt(0)" ::: "memory");
    __syncthreads();
    if (threadIdx.x == 0) {
        unsigned* bar = b.bar;
        __builtin_amdgcn_s_waitcnt(0);
        unsigned nloc = b.st[0], nx = b.st[1];
        if (nloc == 0u) { xcd_barrier_complete(bar, b.x, nloc, nx); b.st[0] = nloc; b.st[1] = nx; }
        const unsigned old = xb_add(&bar[XB_XSUB(b.x)], 1u);
        const unsigned gen = old / nloc;
        if (old + 1u == (gen + 1u) * nloc) {
            __builtin_amdgcn_fence(__ATOMIC_RELEASE, "agent");
            asm volatile("s_waitcnt vmcnt(0)" ::: "memory");
            const unsigned og = xb_add(&bar[XB_TOP], 1u);
            const unsigned tg = og / nx;
            if (og + 1u == (tg + 1u) * nx) xb_add(&bar[XB_TOPGEN], 1u);
            else XB_SPIN(xb_ld(&bar[XB_TOPGEN]) == tg, bar);
            __builtin_amdgcn_fence(__ATOMIC_ACQUIRE, "agent");
            xb_add(&bar[XB_XGEN(b.x)], 1u);
            asm volatile("s_waitcnt vmcnt(0)" ::: "memory");
        } else {
            XB_SPIN(xb_ld(&bar[XB_XGEN(b.x)]) == gen, bar);
            __builtin_amdgcn_fence(__ATOMIC_ACQUIRE, "agent");
            asm volatile("s_waitcnt vmcnt(0)" ::: "memory");
        }
    }
    __syncthreads();
}


struct Args { const float* in[35]; float* out; unsigned char* ws; int ph_lo, ph_hi; };
enum { I_X = 0, I_C, I_CTX, I_CCTX, I_ADAW, I_ADAB, I_NMIX, I_NFFN, I_W1, I_W3, I_W2, I_ABIN, I_ABCW, I_ABCB, I_DTBF, I_DTBB, I_ALF, I_ALB, I_SSDD, I_SSDNW,
       I_RLF, I_RLB, I_ABOUT, I_MLUP, I_MLCW, I_MLCB, I_MLWQ, I_MLWK, I_MLWV, I_MLGW, I_MLGB, I_MLNW, I_MLSKIP, I_MLDOWN, I_FNW };

__device__ __forceinline__ void transpose_item(const float* W, int ldw, int K, bf16* WT, int kb, int src_n0, int dst_n0, LAS float* scr, int lane) {
    const int k0 = 64 * kb;
#pragma unroll 8
    for (int i = 0; i < 32; ++i) { const int kk = 2 * i + (lane >> 5); scr[kk * 33 + (lane & 31)] = W[(size_t)(k0 + kk) * ldw + src_n0 + (lane & 31)]; }
    LDS_WAIT(); asm volatile("" ::: "memory");
    const int c = lane & 7;
#pragma unroll
    for (int j = 0; j < 4; ++j) { const int n = (lane >> 3) + 8 * j; const LAS float* s = scr + (8 * c) * 33 + n;
        v4u o; o.x = pk2(s[0 * 33], s[1 * 33]); o.y = pk2(s[2 * 33], s[3 * 33]); o.z = pk2(s[4 * 33], s[5 * 33]); o.w = pk2(s[6 * 33], s[7 * 33]);
        *(GAS v4u*)(WT + (size_t)(dst_n0 + n) * K + k0 + 8 * c) = o; }
    LDS_WAIT(); asm volatile("" ::: "memory");
}
__device__ __forceinline__ void conv_plain(const float* W, int K, int N, bf16* WT, LAS float* scr, int gw, int NGW, int lane) {
    const int nblk = N / 32, nit = (K / 64) * nblk;
    for (int it = gw; it < nit; it += NGW) { const int kb = it / nblk, nb = it % nblk; transpose_item(W, N, K, WT, kb, 32 * nb, 32 * nb, scr, lane); }
}
__device__ __forceinline__ void conv_ffn1(const float* w1, const float* w3, bf16* WT, LAS float* scr, int gw, int NGW, int lane) {
    const int nblk = 5632 / 32, nit = (1024 / 64) * nblk;
    for (int it = gw; it < nit; it += NGW) { const int kb = it / nblk, nb = it % nblk; const int n0 = 32 * nb, pn = n0 >> 8, within = n0 & 255;
        const float* W = within < 128 ? w1 : w3; const int sc = 128 * pn + (within & 127);
        transpose_item(W, FFH, 1024, WT, kb, sc, n0, scr, lane); }
}
__device__ __forceinline__ void conv_abin(const float* W, bf16* WT, LAS float* scr, int gw, int NGW, int lane) {
    const int nblk = 6144 / 32, nit = (1024 / 64) * nblk;
    for (int it = gw; it < nit; it += NGW) { const int kb = it / nblk, nb = it % nblk; const int n0 = 32 * nb;
        transpose_item(W, ABIN, 1024, WT, kb, n0 + (n0 >= 3072 ? 16 : 0), n0, scr, lane); }
}

template <bool WITH_DT, int NPART = 0>
__device__ __forceinline__ void norm_rows(const float* srcC, const float* srcL, const float* w, const float* mod, int si, bf16* dst, int dst_off, int row_lo, int row_hi,
                                          int gw, int NGW, int lane, const LAS float* wdt, float* dtraw, const float* part = nullptr, const float* cgate = nullptr, float* xctx = nullptr) {
    for (int m = row_lo + gw; m < row_hi; m += NGW) {
        const float* src = m < RL0 ? srcC + (size_t)m * DM : srcL + (size_t)(m - RL0) * DM;
        const float* mv = mod + (size_t)(m < RL0 ? 0 : 1 + ((m - RL0) >> 13)) * 6144 + si * 1024;
        f32x4 v[4]; float ss = 0.f;
#pragma unroll
        for (int j = 0; j < 4; ++j) { v[j] = *(const f32x4*)(src + 4 * lane + 256 * j);
            if constexpr (NPART > 0) { if (m < RL0) { f32x4 sum = (f32x4){0.f, 0.f, 0.f, 0.f};
#pragma unroll
                for (int sl = 0; sl < NPART; ++sl) sum += *(const f32x4*)(part + ((size_t)sl * 512 + m) * 1024 + 4 * lane + 256 * j);
                v[j] = v[j] + *(const f32x4*)(cgate + 4 * lane + 256 * j) * sum; *(f32x4*)(xctx + (size_t)m * DM + 4 * lane + 256 * j) = v[j]; } }
            ss += (v[j].x * v[j].x + v[j].y * v[j].y) + (v[j].z * v[j].z + v[j].w * v[j].w); }
        const float rstd = 1.0f / sqrtf(wave_sum(ss) * (1.f / DM) + RMS_EPS);
#pragma unroll
        for (int j = 0; j < 4; ++j) { const int c = 4 * lane + 256 * j; const f32x4 wv = *(const f32x4*)(w + c), sh = *(const f32x4*)(mv + c), sc = *(const f32x4*)(mv + 1024 + c);
            v[j] = (v[j] * rstd * wv) * (sc + 1.0f) + sh;
            v2u o; o.x = pk2(v[j].x, v[j].y); o.y = pk2(v[j].z, v[j].w);
            *(v2u*)(dst + (size_t)(m - dst_off) * DM + c) = o; }
        if constexpr (WITH_DT) {
            float d[16];
#pragma unroll
            for (int c = 0; c < 16; ++c) { float a = 0.f;
#pragma unroll
                for (int j = 0; j < 4; ++j) { const f32x4 ww = *(const LAS f32x4*)(wdt + c * 1024 + 4 * lane + 256 * j); a += v[j].x * ww.x + v[j].y * ww.y + v[j].z * ww.z + v[j].w * ww.w; }
                d[c] = a; asm volatile("" ::: "memory"); }
            float mine = 0.f;
#pragma unroll
            for (int c = 0; c < 16; ++c) { const float s = wave_sum(d[c]); if (lane == c) mine = s; }
            if (lane < 16) dtraw[(size_t)m * 16 + lane] = mine;
        }
    }
}


#define MFMA16(a, b, c) __builtin_amdgcn_mfma_f32_16x16x32_bf16(a, b, c, 0, 0, 0)
__device__ __forceinline__ bf16x8 frag_nat(const LAS unsigned char* base, int pitch, int r0, int k0, int lane) {
    return *(const LAS bf16x8*)(base + (r0 + (lane & 15)) * pitch + (k0 + 8 * (lane >> 4)) * 2);
}
__device__ __forceinline__ bf16x8 frag_tr(const LAS unsigned char* base, int pitch, int k0, int i0, int lane) {
    const int g = lane >> 4, q = (lane & 15) >> 2, p = lane & 3;
    const LAS unsigned char* a = base + (k0 + 8 * g + q) * pitch + (i0 + 4 * p) * 2;
    const s16x4 lo = __builtin_bit_cast(s16x4, __builtin_amdgcn_ds_read_tr16_b64_v4i16((LAS s16x4*)a));
    const s16x4 hi = __builtin_bit_cast(s16x4, __builtin_amdgcn_ds_read_tr16_b64_v4i16((LAS s16x4*)(a + 4 * pitch)));
    bf16x8 r; r[0] = lo[0]; r[1] = lo[1]; r[2] = lo[2]; r[3] = lo[3]; r[4] = hi[0]; r[5] = hi[1]; r[6] = hi[2]; r[7] = hi[3]; return r;
}
__device__ __forceinline__ v2u pack4(f32x4 v) { v2u o; o.x = pk2(v.x, v.y); o.y = pk2(v.z, v.w); return o; }
__device__ __forceinline__ f32x4 unpack4(v2u w) { f32x4 r; r.x = bflo(w.x); r.y = bfhi(w.x); r.z = bflo(w.y); r.w = bfhi(w.y); return r; }
__device__ __forceinline__ v4u scale8(v4u x, float s) { v4u o; o.x = pk2(bflo(x.x) * s, bfhi(x.x) * s); o.y = pk2(bflo(x.y) * s, bfhi(x.y) * s); o.z = pk2(bflo(x.z) * s, bfhi(x.z) * s); o.w = pk2(bflo(x.w) * s, bfhi(x.w) * s); return o; }

__device__ __forceinline__ void chunk_rows(int ci, int& base, int& L) { L = 256; base = ci < 2 ? 256 * ci : RL0 + 256 * (ci - 2); }

__device__ __forceinline__ void conv8(const v4u (&x)[5], const float (&cw)[5][8], const float (&cb)[8], v4u& out) {
    float o[8];
#pragma unroll
    for (int c = 0; c < 8; ++c) o[c] = cb[c];
#pragma unroll
    for (int k = 0; k < 5; ++k) { const v4u v = x[k];
        o[0] += cw[k][0] * bflo(v.x); o[1] += cw[k][1] * bfhi(v.x); o[2] += cw[k][2] * bflo(v.y); o[3] += cw[k][3] * bfhi(v.y);
        o[4] += cw[k][4] * bflo(v.z); o[5] += cw[k][5] * bfhi(v.z); o[6] += cw[k][6] * bflo(v.w); o[7] += cw[k][7] * bfhi(v.w); }
#pragma unroll
    for (int c = 0; c < 8; ++c) o[c] = silu_f(o[c]);
    out.x = pk2(o[0], o[1]); out.y = pk2(o[2], o[3]); out.z = pk2(o[4], o[5]); out.w = pk2(o[6], o[7]);
}
__device__ __forceinline__ void phase_l0_prep(const Args& args, unsigned char* ws, LAS unsigned char* lds, int tid, int lane, int wave, int bx, int G, int gw, int NGW) {
    bf16* XBC = (bf16*)(ws + WS_XBC); const bf16* HALO = (const bf16*)(ws + WS_HALO);
    {
        const int cg = tid & 255, c0 = 8 * cg;
        float cw[5][8], cb[8];
#pragma unroll
        for (int k = 0; k < 5; ++k)
#pragma unroll
            for (int c = 0; c < 8; ++c) cw[k][c] = args.in[I_ABCW][k * 2048 + c0 + c];
#pragma unroll
        for (int c = 0; c < 8; ++c) cb[c] = args.in[I_ABCB][c0 + c];
        for (int u = bx; u < 264; u += G) {
            const int blk = 2 * u + (tid >> 8), r0 = 32 * blk;
            int slo, shi; if (r0 < RL0) { slo = r0 & ~255; shi = slo + 256; } else { slo = RL0 + ((r0 - RL0) & ~8191); shi = slo + 8192; }
            const v4u zero = (v4u){0u, 0u, 0u, 0u};
            v4u raw[20];
            raw[0] = r0 > slo ? *(const v4u*)(HALO + ((size_t)(blk - 1) * 4 + 2) * 2048 + c0) : zero;
            raw[1] = r0 > slo ? *(const v4u*)(HALO + ((size_t)(blk - 1) * 4 + 3) * 2048 + c0) : zero;
#pragma unroll
            for (int t = 0; t < 18; ++t) raw[2 + t] = *(const v4u*)(XBC + (size_t)(r0 + t) * 2048 + c0);
#pragma unroll
            for (int t = 0; t < 16; ++t) { v4u x5[5] = {raw[t], raw[t + 1], raw[t + 2], raw[t + 3], raw[t + 4]}; v4u o; conv8(x5, cw, cb, o); *(v4u*)(XBC + (size_t)(r0 + t) * 2048 + c0) = o; }
            raw[0] = raw[16]; raw[1] = raw[17]; raw[2] = raw[18]; raw[3] = raw[19];
#pragma unroll
            for (int t = 0; t < 14; ++t) raw[4 + t] = *(const v4u*)(XBC + (size_t)(r0 + 18 + t) * 2048 + c0);
            raw[18] = r0 + 32 < shi ? *(const v4u*)(HALO + ((size_t)(blk + 1) * 4 + 0) * 2048 + c0) : zero;
            raw[19] = r0 + 32 < shi ? *(const v4u*)(HALO + ((size_t)(blk + 1) * 4 + 1) * 2048 + c0) : zero;
#pragma unroll
            for (int t = 0; t < 16; ++t) { v4u x5[5] = {raw[t], raw[t + 1], raw[t + 2], raw[t + 3], raw[t + 4]}; v4u o; conv8(x5, cw, cb, o); *(v4u*)(XBC + (size_t)(r0 + 16 + t) * 2048 + c0) = o; }
        }
    }
    {
        bf16* QK = (bf16*)(ws + WS_QK);
        const float inv = exp2f(-(float)(lane & 31) * (13.287712379549449f / 32.0f));
        for (int m = gw; m < R; m += NGW) {
            bf16* row = QK + (size_t)m * 1024;
            float cs = 1.f, sn = 0.f;
            if (m >= RL0) { const int t = (m - RL0) & 8191; const float ang = (float)(lane < 32 ? (t >> 6) : (t & 63)) * inv; sincosf(ang, &sn, &cs); }
#pragma unroll
            for (int hh = 0; hh < 8; ++hh) { const float x1 = bf2f(row[128 * hh + lane]), x2 = bf2f(row[128 * hh + 64 + lane]); const float sc = hh >= 4 ? 0.08838834764831845f : 1.0f;
                row[128 * hh + lane] = (bf16)f2bf((x1 * cs - x2 * sn) * sc); row[128 * hh + 64 + lane] = (bf16)f2bf((x1 * sn + x2 * cs) * sc); }
        }
    }
    {
        const float* dtraw = (const float*)(ws + WS_DTRAW); float* DTF = (float*)(ws + WS_DTF); float* DTB = (float*)(ws + WS_DTB); float* CSF = (float*)(ws + WS_CSF); float* RBA = (float*)(ws + WS_RB);
        for (int wu = gw; wu < 66 * 16; wu += NGW) {
            const int ci = wu >> 4, h = wu & 15; int base, L; chunk_rows(ci, base, L);
            const float bf_ = args.in[I_DTBF][h], bb_ = args.in[I_DTBB][h], af = __expf(args.in[I_ALF][h]), ab = __expf(args.in[I_ALB][h]);
            const int per = L >> 6, t0 = lane * per;
            float dtf[8], dtb[8], laf[8], lab[8]; float sf = 0.f, sb = 0.f;
#pragma unroll
            for (int t = 0; t < 8; ++t) if (t < per) { const float rawv = dtraw[(size_t)(base + t0 + t) * 16 + h]; dtf[t] = softplus_f(rawv + bf_); dtb[t] = softplus_f(rawv + bb_); laf[t] = -dtf[t] * af; lab[t] = -dtb[t] * ab; sf += laf[t]; sb += lab[t]; }
            float pf = sf, pb = sb;
#pragma unroll
            for (int o = 1; o < 64; o <<= 1) { const float a = __shfl_up(pf, o), c = __shfl_down(pb, o); if (lane >= o) pf += a; if (lane + o < 64) pb += c; }
            float runf = pf - sf;
#pragma unroll
            for (int t = 0; t < 8; ++t) if (t < per) { runf += laf[t]; const size_t o = (size_t)(base + t0 + t) * 16 + h; CSF[o] = runf; DTF[o] = dtf[t]; DTB[o] = dtb[t]; }
            float runb = pb - sb;
#pragma unroll
            for (int t = 7; t >= 0; --t) if (t < per) { runb += lab[t]; RBA[(size_t)(base + t0 + t) * 16 + h] = runb; }
        }
    }
}

constexpr int SCAN_PITCH = 144;
__device__ __forceinline__ void phase_l0_scan(const Args& args, unsigned char* ws, unsigned char* dob, LAS unsigned char* lds, int tid, int lane, int wave, int bx, int G) {
    LAS unsigned char* Kt = lds; LAS unsigned char* Vt = lds + 128 * SCAN_PITCH; LAS float* TB = (LAS float*)(lds + 256 * SCAN_PITCH);
    const float* DTF = (const float*)(ws + WS_DTF); const float* DTB = (const float*)(ws + WS_DTB); const float* CSF = (const float*)(ws + WS_CSF); const float* RBA = (const float*)(ws + WS_RB);
    for (int u = bx; u < 256; u += G) {
        const bool ssd = u < 128; int b, dir, h; const bf16* Ksrc; const bf16* Vsrc; int ld; bf16* Sout; float lg = 0.f;
        if (ssd) { const int s = u >> 1, nt = u & 1; b = s >> 5; dir = (s >> 4) & 1; h = s & 15; ld = 2048;
            Ksrc = (const bf16*)(ws + WS_XBC) + 1024 + 128 * (h >> 2) + 64 * nt; Vsrc = (const bf16*)(ws + WS_XBC) + 64 * h;
            Sout = (bf16*)(dob + DO_ST_SSD) + (size_t)s * 32 * 8192 + 64 * nt; }
        else { const int v = u - 128, s = v >> 3, t = v & 7, et = t >> 1, dt = t & 1; b = s >> 3; dir = (s >> 2) & 1; h = s & 3; ld = 1024;
            Ksrc = (const bf16*)(ws + WS_QK) + 512 + 128 * h + 64 * dt; Vsrc = (const bf16*)(ws + WS_V) + 256 * h + 64 * et;
            Sout = (bf16*)(dob + DO_ST_RET) + (size_t)s * 32 * 32768 + (size_t)(64 * et) * 128 + 64 * dt;
            lg = logsig_f(args.in[dir ? I_RLB : I_RLF][h]); }
        const size_t kstride = ssd ? 8192 : 32768;
        const int wd = wave & 3, we = wave >> 2;
        __syncthreads();
        if (tid < 33) { const int stp = tid; int base; const int L = 256; if (stp == 0) { base = 256 * b; } else { const int k = dir ? 32 - stp : stp - 1; base = RL0 + 8192 * b + 256 * k; }
            float wref = 0.f, A;
            if (ssd) { wref = dir ? RBA[(size_t)base * 16 + h] : CSF[(size_t)(base + L - 1) * 16 + h]; A = __expf(wref); } else A = __expf((float)L * lg);
            TB[stp] = wref; TB[64 + stp] = A; }
        __syncthreads();
        f32x4 acc[2] = {(f32x4){0.f, 0.f, 0.f, 0.f}, (f32x4){0.f, 0.f, 0.f, 0.f}};
        const int srow = tid >> 2, sc16 = tid & 3;
        const bf16* kp = Ksrc + 16 * sc16; const bf16* vp = Vsrc + 16 * sc16;
#define L0S_STP(si) ((si) >> 1)
#define L0S_LOAD(si, K0, K1, V0, V1, W) do { const int stp_ = L0S_STP(si), t0_ = 128 * ((si) & 1); int r_; const int L_ = 256; \
            if (stp_ == 0) { r_ = 256 * b + t0_ + srow; } else { const int kq_ = dir ? 32 - stp_ : stp_ - 1; r_ = RL0 + 8192 * b + 256 * kq_ + t0_ + srow; } \
            const int jl_ = t0_ + srow; \
            if (ssd) W = dir ? __expf(TB[stp_] - RBA[(size_t)r_ * 16 + h]) * DTB[(size_t)r_ * 16 + h] : __expf(TB[stp_] - CSF[(size_t)r_ * 16 + h]) * DTF[(size_t)r_ * 16 + h]; \
            else W = dir ? __expf((float)jl_ * lg) : __expf((float)(L_ - 1 - jl_) * lg); \
            K0 = *(const v4u*)(kp + (size_t)r_ * ld); K1 = *(const v4u*)(kp + (size_t)r_ * ld + 8); V0 = *(const v4u*)(vp + (size_t)r_ * ld); V1 = *(const v4u*)(vp + (size_t)r_ * ld + 8); } while (0)
#define L0S_STORE(kidx) do { _Pragma("unroll") for (int t2 = 0; t2 < 2; ++t2) { const int e = 32 * we + 16 * t2 + (lane & 15), d = 16 * wd + 4 * (lane >> 4); \
            *(v2u*)(Sout + (size_t)(kidx) * kstride + (size_t)e * 128 + d) = pack4(acc[t2]); } } while (0)
#define L0S_STEP(si, K0, K1, V0, V1, W) do { const int stp_ = L0S_STP(si); \
            if (((si) & 1) == 0) { if (stp_ >= 1) L0S_STORE(dir ? 32 - stp_ : stp_ - 1); const float A_ = TB[64 + stp_]; acc[0] = acc[0] * A_; acc[1] = acc[1] * A_; } \
            __syncthreads(); \
            *(LAS v4u*)(Kt + srow * SCAN_PITCH + 32 * sc16) = scale8(K0, W); *(LAS v4u*)(Kt + srow * SCAN_PITCH + 32 * sc16 + 16) = scale8(K1, W); \
            *(LAS v4u*)(Vt + srow * SCAN_PITCH + 32 * sc16) = V0; *(LAS v4u*)(Vt + srow * SCAN_PITCH + 32 * sc16 + 16) = V1; \
            __syncthreads(); \
            if ((si) + 4 < 64) L0S_LOAD((si) + 4, K0, K1, V0, V1, W); \
            _Pragma("unroll") for (int kk = 0; kk < 4; ++kk) { const bf16x8 a = frag_tr(Kt, SCAN_PITCH, 32 * kk, 16 * wd, lane); \
                _Pragma("unroll") for (int t2 = 0; t2 < 2; ++t2) { const bf16x8 bb = frag_tr(Vt, SCAN_PITCH, 32 * kk, 32 * we + 16 * t2, lane); acc[t2] = MFMA16(a, bb, acc[t2]); } } } while (0)
        v4u ka0, ka1, va0, va1, kb0, kb1, vb0, vb1, kc0, kc1, vc0, vc1, kd0, kd1, vd0, vd1; float wa, wb, wc, wd_;
        L0S_LOAD(0, ka0, ka1, va0, va1, wa); L0S_LOAD(1, kb0, kb1, vb0, vb1, wb); L0S_LOAD(2, kc0, kc1, vc0, vc1, wc); L0S_LOAD(3, kd0, kd1, vd0, vd1, wd_);
#pragma unroll 1
        for (int si = 0; si < 64; si += 4) { L0S_STEP(si, ka0, ka1, va0, va1, wa); L0S_STEP(si + 1, kb0, kb1, vb0, vb1, wb); L0S_STEP(si + 2, kc0, kc1, vc0, vc1, wc); L0S_STEP(si + 3, kd0, kd1, vd0, vd1, wd_); }
        L0S_STORE(dir ? 0 : 31);
#undef L0S_STP
#undef L0S_LOAD
#undef L0S_STORE
#undef L0S_STEP
    }
    __syncthreads();
}


constexpr int Y_KT = 0, Y_VT = 17408, Y_MT = 51200, Y_SC = 69632, Y_ST = 73728;
constexpr int P272 = 272, P528 = 528, P144 = 144;
__device__ __forceinline__ void phase_l0_y(const Args& args, unsigned char* ws, unsigned char* dob, LAS unsigned char* lds, int tid0, int lane0, int wave, int bx, int G, unsigned long long& tacc, bool dry = false) {
#ifndef YSEC
#define YSEC -1
#endif
    unsigned long long ytm0 = 0ull; int ycur0 = -1;
#define YT0(n) do { if (YSEC >= 10) { const unsigned long long now_ = __builtin_amdgcn_s_memrealtime(); if (ycur0 == YSEC) tacc += now_ - ytm0; ytm0 = now_; ycur0 = (n); } } while (0)

    LAS unsigned char* Kt = lds + Y_KT; LAS unsigned char* Vt = lds + Y_VT; LAS unsigned char* Mt = lds + Y_MT; LAS float* SC = (LAS float*)(lds + Y_SC); LAS unsigned char* St = lds + Y_ST;
    bf16* ZG = (bf16*)(ws + WS_ZG); const bf16* XBC = (const bf16*)(ws + WS_XBC); const bf16* QK = (const bf16*)(ws + WS_QK); const bf16* VV = (const bf16*)(ws + WS_V);
    const float* DTF = (const float*)(ws + WS_DTF); const float* DTB = (const float*)(ws + WS_DTB); const float* CSF = (const float*)(ws + WS_CSF); const float* RBA = (const float*)(ws + WS_RB);
    for (int u = bx; u < 1056; u += G) {
        int tid = tid0, lane = lane0; asm volatile("" : "+v"(tid), "+v"(lane));
        const int fr = lane & 15, fq = lane >> 4;
        bool ssd; int grp, b, rbk;
        if (u < 1024) { ssd = u < 512; const int idx = u & 511; grp = idx & 3; const int br = idx >> 2; b = br >> 6; rbk = 2 + (br & 63); }
        else { const int idx = u - 1024; ssd = idx < 16; const int i2 = idx & 15; grp = i2 & 3; b = (i2 >> 2) & 1; rbk = i2 >> 3; }
        int cb0, L, i0, kchunk = -1;
        L = 256; if (rbk < 2) { cb0 = 256 * b; i0 = 128 * rbk; } else { const int lk = rbk - 2; kchunk = lk >> 1; cb0 = RL0 + 8192 * b + 256 * kchunk; i0 = 128 * (lk & 1); }
        const int il = i0 + 16 * wave + fr;
        const int row = cb0 + il;
        const int nkb = L >> 6;
        if (ssd) {
            YT0(10);
            const int g = grp;
            bf16x8 cf[4];
#pragma unroll
            for (int kk = 0; kk < 4; ++kk) cf[kk] = *(const bf16x8*)(XBC + (size_t)row * 2048 + 1536 + 128 * g + 32 * kk + 8 * fq);
            float csi[4], rbi[4];
#pragma unroll
            for (int hh = 0; hh < 4; ++hh) { csi[hh] = CSF[(size_t)row * 16 + 4 * g + hh]; rbi[hh] = RBA[(size_t)row * 16 + 4 * g + hh]; }
            f32x4 acc[4][4];
#pragma unroll
            for (int hh = 0; hh < 4; ++hh)
#pragma unroll
                for (int pt = 0; pt < 4; ++pt) acc[hh][pt] = (f32x4){0.f, 0.f, 0.f, 0.f};
            const int Rw = (i0 >> 4) + wave;
            v4u pk[2], pv[4];
#define SSD_LOAD(kbv) do { const int krow0_ = cb0 + 64 * (kbv); \
                _Pragma("unroll") for (int c = 0; c < 2; ++c) { const int ch = tid + 512 * c, r = ch >> 4, cc = ch & 15; pk[c] = *(const v4u*)(XBC + (size_t)(krow0_ + r) * 2048 + 1024 + 128 * g + 8 * cc); } \
                _Pragma("unroll") for (int c = 0; c < 4; ++c) { const int ch = tid + 512 * c, r = ch >> 5, cc = ch & 31; pv[c] = *(const v4u*)(XBC + (size_t)(krow0_ + r) * 2048 + 256 * g + 8 * cc); } \
                } while (0)
            SSD_LOAD(0);
            for (int kb = 0; kb < nkb; ++kb) {
                __syncthreads();
#pragma unroll
                for (int c = 0; c < 2; ++c) { const int ch = tid + 512 * c, r = ch >> 4, cc = ch & 15; *(LAS v4u*)(Kt + r * P272 + 16 * cc) = pk[c]; }
#pragma unroll
                for (int c = 0; c < 4; ++c) { const int ch = tid + 512 * c, r = ch >> 5, cc = ch & 31; *(LAS v4u*)(Vt + r * P528 + 16 * cc) = pv[c]; }
                if (tid < 256) { const int r = tid >> 2, hh = tid & 3; const size_t o = (size_t)(cb0 + 64 * kb + r) * 16 + 4 * g + hh; SC[0 * 256 + hh * 64 + r] = CSF[o]; SC[1 * 256 + hh * 64 + r] = RBA[o]; SC[2 * 256 + hh * 64 + r] = DTF[o]; SC[3 * 256 + hh * 64 + r] = DTB[o]; }
                __syncthreads();
                if (kb + 1 < nkb) SSD_LOAD(kb + 1);
                f32x4 Gt[4];
#pragma unroll
                for (int t = 0; t < 4; ++t) { Gt[t] = (f32x4){0.f, 0.f, 0.f, 0.f};
#pragma unroll
                    for (int kk = 0; kk < 4; ++kk) Gt[t] = MFMA16(frag_nat(Kt, P272, 16 * t, 32 * kk, lane), cf[kk], Gt[t]); }
#pragma unroll
                for (int hh = 0; hh < 4; ++hh) {
#pragma unroll
                    for (int t = 0; t < 4; ++t) { f32x4 m; const int T = 4 * kb + t; const int so = hh * 64 + 16 * t + 4 * fq;
                        if (T < Rw) { const f32x4 csj = *(const LAS f32x4*)(SC + so), dtj = *(const LAS f32x4*)(SC + 512 + so);
#pragma unroll
                            for (int r = 0; r < 4; ++r) m[r] = Gt[t][r] * __expf(csi[hh] - csj[r]) * dtj[r]; }
                        else if (T > Rw) { const f32x4 rbj = *(const LAS f32x4*)(SC + 256 + so), dtj = *(const LAS f32x4*)(SC + 768 + so);
#pragma unroll
                            for (int r = 0; r < 4; ++r) m[r] = Gt[t][r] * __expf(rbi[hh] - rbj[r]) * dtj[r]; }
                        else { const f32x4 csj = *(const LAS f32x4*)(SC + so), rbj = *(const LAS f32x4*)(SC + 256 + so), dfj = *(const LAS f32x4*)(SC + 512 + so), dbj = *(const LAS f32x4*)(SC + 768 + so);
#pragma unroll
                            for (int r = 0; r < 4; ++r) { const int jj = 4 * fq + r;
                                const float x = jj < fr ? csi[hh] - csj[r] : (jj > fr ? rbi[hh] - rbj[r] : 0.f);
                                const float sv = jj < fr ? dfj[r] : (jj > fr ? dbj[r] : dfj[r] + dbj[r]);
                                m[r] = Gt[t][r] * __expf(x) * sv; } }
                        *(LAS v2u*)(Mt + (16 * wave + fr) * P144 + (16 * t + 4 * fq) * 2) = pack4(m); }
                    LDS_WAIT();
#pragma unroll
                    for (int kk2 = 0; kk2 < 2; ++kk2) { const bf16x8 mb = frag_nat(Mt, P144, 16 * wave, 32 * kk2, lane);
#pragma unroll
                        for (int pt = 0; pt < 4; ++pt) acc[hh][pt] = MFMA16(frag_tr(Vt, P528, 32 * kk2, 64 * hh + 16 * pt, lane), mb, acc[hh][pt]); }
                }
            }
#undef SSD_LOAD
            YT0(11);
            if (kchunk >= 0) {
#pragma unroll 1
                for (int hh = 0; hh < 4; ++hh) {
                    const int h = 4 * g + hh;
                    __syncthreads();
#pragma unroll
                    for (int dir = 0; dir < 2; ++dir) { const bf16* S = (const bf16*)(dob + DO_ST_SSD) + ((size_t)(b * 32 + dir * 16 + h) * 32 + kchunk) * 8192;
#pragma unroll
                        for (int c = 0; c < 2; ++c) { const int ch = tid + 512 * c, r = ch >> 4, cc = ch & 15; *(LAS v4u*)(St + dir * 17408 + r * P272 + 16 * cc) = *(const v4u*)(S + r * 128 + 8 * cc); } }
                    __syncthreads();
                    float Ei[2] = {__expf(csi[0]), __expf(rbi[0])};
                    if (hh == 1) { Ei[0] = __expf(csi[1]); Ei[1] = __expf(rbi[1]); } else if (hh == 2) { Ei[0] = __expf(csi[2]); Ei[1] = __expf(rbi[2]); } else if (hh == 3) { Ei[0] = __expf(csi[3]); Ei[1] = __expf(rbi[3]); }
#pragma unroll
                    for (int dir = 0; dir < 2; ++dir)
#pragma unroll
                        for (int pt = 0; pt < 4; ++pt) { f32x4 T = (f32x4){0.f, 0.f, 0.f, 0.f};
#pragma unroll
                            for (int kk = 0; kk < 4; ++kk) T = MFMA16(frag_nat(St + dir * 17408, P272, 16 * pt, 32 * kk, lane), cf[kk], T);
                            const f32x4 add = T * Ei[dir];
                            if (hh == 0) acc[0][pt] += add; else if (hh == 1) acc[1][pt] += add; else if (hh == 2) acc[2][pt] += add; else acc[3][pt] += add; }
                }
            }
            YT0(12);
            float ssq = 0.f;
#pragma unroll
            for (int hh = 0; hh < 4; ++hh) { const float dsk = args.in[I_SSDD][4 * g + hh];
#pragma unroll
                for (int pt = 0; pt < 4; ++pt) { const int ch = 256 * g + 64 * hh + 16 * pt + 4 * fq;
                    const f32x4 xs = unpack4(*(const v2u*)(XBC + (size_t)row * 2048 + ch)), zz = unpack4(*(const v2u*)(ZG + (size_t)row * 2048 + ch));
                    f32x4 y = acc[hh][pt] + xs * dsk;
                    y.x *= silu_f(zz.x); y.y *= silu_f(zz.y); y.z *= silu_f(zz.z); y.w *= silu_f(zz.w);
                    acc[hh][pt] = y; ssq += (y.x * y.x + y.y * y.y) + (y.z * y.z + y.w * y.w); } }
            YT0(17);
            ssq += __shfl_xor(ssq, 16); ssq += __shfl_xor(ssq, 32);
            const float rstd = 1.0f / sqrtf(ssq * (1.f / 256.f) + RMS_EPS);
#pragma unroll
            for (int hh = 0; hh < 4; ++hh)
#pragma unroll
                for (int pt = 0; pt < 4; ++pt) { const int ch = 256 * g + 64 * hh + 16 * pt + 4 * fq; const f32x4 nw = *(const f32x4*)(args.in[I_SSDNW] + ch);
                    if (!dry) *(v2u*)(ZG + (size_t)row * 2048 + ch) = pack4(acc[hh][pt] * rstd * nw); }
            YT0(16);
        } else {
            YT0(13);
            const int h = grp;
            const float lgf = logsig_f(args.in[I_RLF][h]), lgb = logsig_f(args.in[I_RLB][h]);
            bf16x8 qf[4];
#pragma unroll
            for (int kk = 0; kk < 4; ++kk) qf[kk] = *(const bf16x8*)(QK + (size_t)row * 1024 + 128 * h + 32 * kk + 8 * fq);
            f32x4 acc[16];
#pragma unroll
            for (int et = 0; et < 16; ++et) acc[et] = (f32x4){0.f, 0.f, 0.f, 0.f};
            const int Rw = (i0 >> 4) + wave;
            v4u pk[2], pv[4];
#define RET_LOAD(kbv) do { const int krow0_ = cb0 + 64 * (kbv); \
                _Pragma("unroll") for (int c = 0; c < 2; ++c) { const int ch = tid + 512 * c, r = ch >> 4, cc = ch & 15; pk[c] = *(const v4u*)(QK + (size_t)(krow0_ + r) * 1024 + 512 + 128 * h + 8 * cc); } \
                _Pragma("unroll") for (int c = 0; c < 4; ++c) { const int ch = tid + 512 * c, r = ch >> 5, cc = ch & 31; pv[c] = *(const v4u*)(VV + (size_t)(krow0_ + r) * 1024 + 256 * h + 8 * cc); } } while (0)
            RET_LOAD(0);
            for (int kb = 0; kb < nkb; ++kb) {
                __syncthreads();
#pragma unroll
                for (int c = 0; c < 2; ++c) { const int ch = tid + 512 * c, r = ch >> 4, cc = ch & 15; *(LAS v4u*)(Kt + r * P272 + 16 * cc) = pk[c]; }
#pragma unroll
                for (int c = 0; c < 4; ++c) { const int ch = tid + 512 * c, r = ch >> 5, cc = ch & 31; *(LAS v4u*)(Vt + r * P528 + 16 * cc) = pv[c]; }
                __syncthreads();
                if (kb + 1 < nkb) RET_LOAD(kb + 1);
#pragma unroll
                for (int t = 0; t < 4; ++t) { f32x4 Gt = (f32x4){0.f, 0.f, 0.f, 0.f};
#pragma unroll
                    for (int kk = 0; kk < 4; ++kk) Gt = MFMA16(frag_nat(Kt, P272, 16 * t, 32 * kk, lane), qf[kk], Gt);
                    f32x4 m; const int T = 4 * kb + t;
#pragma unroll
                    for (int r = 0; r < 4; ++r) { const int j = 64 * kb + 16 * t + 4 * fq + r;
                        float f;
                        if (T < Rw) f = __expf((float)(il - j) * lgf); else if (T > Rw) f = __expf((float)(j - il) * lgb);
                        else f = j < il ? __expf((float)(il - j) * lgf) : (j > il ? __expf((float)(j - il) * lgb) : 2.0f);
                        m[r] = Gt[r] * f; }
                    *(LAS v2u*)(Mt + (16 * wave + fr) * P144 + (16 * t + 4 * fq) * 2) = pack4(m); }
                LDS_WAIT();
#pragma unroll
                for (int kk2 = 0; kk2 < 2; ++kk2) { const bf16x8 mb = frag_nat(Mt, P144, 16 * wave, 32 * kk2, lane);
#pragma unroll
                    for (int et = 0; et < 16; ++et) acc[et] = MFMA16(frag_tr(Vt, P528, 32 * kk2, 16 * et, lane), mb, acc[et]); }
            }
#undef RET_LOAD
            YT0(14);
            if (kchunk >= 0) {
#pragma unroll 1
                for (int dir = 0; dir < 2; ++dir) {
                    const bf16* S = (const bf16*)(dob + DO_ST_RET) + (size_t)__builtin_amdgcn_readfirstlane(((b * 8 + dir * 4 + h) * 32 + kchunk)) * 32768;
                    __syncthreads();
#pragma unroll
                    for (int c = 0; c < 8; ++c) { const int ch = tid + 512 * c, r = ch >> 4, cc = ch & 15; *(LAS v4u*)(St + r * P272 + 16 * cc) = *(const v4u*)(S + r * 128 + 8 * cc); }
                    __syncthreads();
                    const float Ei = dir ? __expf((float)(L - il) * lgb) : __expf((float)(il + 1) * lgf);
#pragma unroll
                    for (int et = 0; et < 16; ++et) { f32x4 T = (f32x4){0.f, 0.f, 0.f, 0.f};
#pragma unroll
                        for (int kk = 0; kk < 4; ++kk) T = MFMA16(frag_nat(St, P272, 16 * et, 32 * kk, lane), qf[kk], T);
                        acc[et] += T * Ei; }
                }
            }
            YT0(15);
            float sm = 0.f;
#pragma unroll
            for (int et = 0; et < 16; ++et) sm += (acc[et].x + acc[et].y) + (acc[et].z + acc[et].w);
            sm += __shfl_xor(sm, 16); sm += __shfl_xor(sm, 32);
            const float mean = sm * (1.f / 256.f); float sq = 0.f;
#pragma unroll
            for (int et = 0; et < 16; ++et) { acc[et] = acc[et] - mean; sq += (acc[et].x * acc[et].x + acc[et].y * acc[et].y) + (acc[et].z * acc[et].z + acc[et].w * acc[et].w); }
            sq += __shfl_xor(sq, 16); sq += __shfl_xor(sq, 32);
            const float rstd = 1.0f / sqrtf(sq * (1.f / 256.f) + LN_EPS);
#pragma unroll
            for (int et = 0; et < 16; ++et) { const int ch = 1024 + 256 * h + 16 * et + 4 * fq; const f32x4 gg = unpack4(*(const v2u*)(ZG + (size_t)row * 2048 + ch));
                f32x4 y = acc[et] * rstd; y.x *= silu_f(gg.x); y.y *= silu_f(gg.y); y.z *= silu_f(gg.z); y.w *= silu_f(gg.w);
                if (!dry) *(v2u*)(ZG + (size_t)row * 2048 + ch) = pack4(y); }
            YT0(16);
        }
        __syncthreads();
    }
}


constexpr size_t WS_GWT = 7 * MiB;
constexpr size_t WS_MIN = 7 * MiB + 256 * 1024;
__device__ __forceinline__ int xc_row(int r, int b) { return r < RL0 ? r - 256 * b : 256 + (r - RL0 - 8192 * b); }
__device__ __forceinline__ void bw8(const float (&x)[8], const float* w  , float (&o)[8]) {
#pragma unroll
    for (int bl = 0; bl < 2; ++bl)
#pragma unroll
        for (int e = 0; e < 4; ++e) o[4 * bl + e] = x[4 * bl] * w[16 * bl + e] + x[4 * bl + 1] * w[16 * bl + 4 + e] + x[4 * bl + 2] * w[16 * bl + 8 + e] + x[4 * bl + 3] * w[16 * bl + 12 + e];
}
__device__ __forceinline__ void unpack8(v4u v, float (&o)[8]) { o[0] = bflo(v.x); o[1] = bfhi(v.x); o[2] = bflo(v.y); o[3] = bfhi(v.y); o[4] = bflo(v.z); o[5] = bfhi(v.z); o[6] = bflo(v.w); o[7] = bfhi(v.w); }
__device__ __forceinline__ v4u pack8(const float (&o)[8]) { v4u r; r.x = pk2(o[0], o[1]); r.y = pk2(o[2], o[3]); r.z = pk2(o[4], o[5]); r.w = pk2(o[6], o[7]); return r; }

constexpr size_t WS_GVT = WS_GWT + 65536;
__device__ __forceinline__ void phase_l1_prep(const Args& args, unsigned char* ws, LAS unsigned char* lds, int tid, int lane, int wave, int bx, int G, int b) {
    const bf16* XM = (const bf16*)(ws + WS_XM); bf16* XC = (bf16*)(ws + WS_XC); const bf16* GXT = (const bf16*)(ws + WS_GWT); const bf16* GVT = (const bf16*)(ws + WS_GVT); float* GATE = (float*)(ws + WS_GATE);
    const float* cwp = args.in[I_MLCW]; const float* cbp = args.in[I_MLCB];
    constexpr int PT = 4112;
    LAS float* GL = (LAS float*)(lds + 20 * PT);
    const int fr = lane & 15, fq = lane >> 4;
    for (int u = bx; u < 528; u += G) {
        const int tb = u < 16 ? 256 * b + 16 * u : RL0 + 8192 * b + 16 * (u - 16);
        const int slo = u < 16 ? 256 * b : RL0 + 8192 * b, shi = u < 16 ? slo + 256 : slo + 8192;
        __syncthreads();
#pragma unroll
        for (int c = 0; c < 10; ++c) { const int ch = tid + 512 * c, rr = ch >> 8, cc = ch & 255; const int grow = tb - 2 + rr;
            v4u v = (v4u){0u, 0u, 0u, 0u}; if (grow >= slo && grow < shi) v = *(const v4u*)(XM + (size_t)grow * 2048 + 8 * cc);
            *(LAS v4u*)(lds + rr * PT + 16 * cc) = v; }
        __syncthreads();
        const int r = tb + fr, xr = xc_row(r, b);
        f32x4 gacc = (f32x4){0.f, 0.f, 0.f, 0.f};
#pragma unroll 2
        for (int c32 = 0; c32 < 8; ++c32) {
            const int cb = 256 * wave + 32 * c32 + 8 * fq;
            v4u xw[5];
#pragma unroll
            for (int k = 0; k < 5; ++k) xw[k] = *(const LAS v4u*)(lds + (fr + k) * PT + 2 * cb);
            const bf16x8 gx = *(const bf16x8*)(GXT + (size_t)fr * 2048 + cb), gv = *(const bf16x8*)(GVT + (size_t)fr * 2048 + cb);
            f32x4 a0 = *(const f32x4*)(cbp + cb), a1 = *(const f32x4*)(cbp + cb + 4);
#pragma unroll
            for (int k = 0; k < 5; ++k) { const f32x4 w0 = *(const f32x4*)(cwp + k * 2048 + cb), w1 = *(const f32x4*)(cwp + k * 2048 + cb + 4); const v4u v = xw[k];
                a0.x += w0.x * bflo(v.x); a0.y += w0.y * bfhi(v.x); a0.z += w0.z * bflo(v.y); a0.w += w0.w * bfhi(v.y);
                a1.x += w1.x * bflo(v.z); a1.y += w1.y * bfhi(v.z); a1.z += w1.z * bflo(v.w); a1.w += w1.w * bfhi(v.w); }
            v4u xcp; xcp.x = pk2(silu_f(a0.x), silu_f(a0.y)); xcp.y = pk2(silu_f(a0.z), silu_f(a0.w)); xcp.z = pk2(silu_f(a1.x), silu_f(a1.y)); xcp.w = pk2(silu_f(a1.z), silu_f(a1.w));
            *(v4u*)(XC + (size_t)xr * 2048 + cb) = xcp;
            gacc = MFMA16(gx, __builtin_bit_cast(bf16x8, xcp), gacc); gacc = MFMA16(gv, __builtin_bit_cast(bf16x8, xw[2]), gacc);
        }
#pragma unroll
        for (int rr = 0; rr < 4; ++rr) GL[(wave * 16 + 4 * fq + rr) * 16 + fr] = gacc[rr];
        __syncthreads();
        if (tid < 256) { const int gt = tid >> 4, tk = tid & 15;
            float s = args.in[I_MLGB][gt];
#pragma unroll
            for (int q = 0; q < 8; ++q) s += GL[(q * 16 + gt) * 16 + tk];
            GATE[(size_t)(tb + tk) * 16 + gt] = s; }
    }
    __syncthreads();
}

__device__ __forceinline__ void phase_l1_gatescan(const Args& args, unsigned char* ws, LAS unsigned char* lds, int tid, int lane, int wave, int bx, int G, int gw, int NGW, int b) {
    const float* GATE = (const float*)(ws + WS_GATE); float* BC = (float*)(ws + WS_BC); float* AJ = (float*)(ws + WS_AJ); float* CM = (float*)(ws + WS_CM); float* CH = (float*)(ws + WS_CH);
    for (int wu = gw; wu < 8 * 17; wu += NGW) {
        const int sl = wu / 17, c17 = wu % 17, dir = sl >> 2, h = sl & 3;
        const int base = c17 == 0 ? 256 * b : RL0 + 8192 * b + 512 * (c17 - 1), L = c17 == 0 ? 256 : 512, per = L >> 6, t0 = lane * per;
        float fc[8], ic[8]; float s = 0.f;
#pragma unroll
        for (int t = 0; t < 8; ++t) if (t < per) { const size_t o = (size_t)(base + t0 + t) * 16; fc[t] = logsig_f(GATE[o + (dir ? 12 : 4) + h]); ic[t] = GATE[o + (dir ? 8 : 0) + h]; s += fc[t]; }
        float p = s;
#pragma unroll
        for (int o = 1; o < 64; o <<= 1) { const float up = __shfl_up(p, o), dn = __shfl_down(p, o); if (!dir) { if (lane >= o) p += up; } else { if (lane + o < 64) p += dn; } }
        const float total = dir ? __shfl(p, 0) : __shfl(p, 63);
        float run = p - s, a[8], bcv[8]; float mx = -3.0e38f;
        if (!dir) {
#pragma unroll
            for (int t = 0; t < 8; ++t) if (t < per) { run += fc[t]; bcv[t] = run; a[t] = ic[t] - run; mx = fmaxf(mx, a[t]); }
        } else {
#pragma unroll
            for (int t = 7; t >= 0; --t) if (t < per) { run += fc[t]; bcv[t] = run; a[t] = ic[t] - run; mx = fmaxf(mx, a[t]); }
        }
        float pm = mx;
#pragma unroll
        for (int o = 1; o < 64; o <<= 1) { const float up = __shfl_up(pm, o), dn = __shfl_down(pm, o); if (!dir) { if (lane >= o) pm = fmaxf(pm, up); } else { if (lane + o < 64) pm = fmaxf(pm, dn); } }
        const float cmax = dir ? __shfl(pm, 0) : __shfl(pm, 63);
        float excl = !dir ? __shfl_up(pm, 1) : __shfl_down(pm, 1);
        if ((!dir && lane == 0) || (dir && lane == 63)) excl = -3.0e38f;
        float rm = excl;
        if (!dir) {
#pragma unroll
            for (int t = 0; t < 8; ++t) if (t < per) { rm = fmaxf(rm, a[t]); const size_t o = (size_t)(base + t0 + t) * 8 + sl; BC[o] = bcv[t]; AJ[o] = a[t]; CM[o] = rm; }
        } else {
#pragma unroll
            for (int t = 7; t >= 0; --t) if (t < per) { rm = fmaxf(rm, a[t]); const size_t o = (size_t)(base + t0 + t) * 8 + sl; BC[o] = bcv[t]; AJ[o] = a[t]; CM[o] = rm; }
        }
        if (lane == 0) { CH[((b * 8 + sl) * 17 + c17) * 2] = total; CH[((b * 8 + sl) * 17 + c17) * 2 + 1] = cmax; }
    }
}

__device__ __forceinline__ void m_chain(const float* CH, int b, int sl, LAS float* m_in, LAS float* mul) {
    const int dir = sl >> 2; float m = 0.f;
    for (int step = 0; step < 17; ++step) { const int c17 = step == 0 ? 0 : (dir ? 17 - step : step); const float be = CH[((b * 8 + sl) * 17 + c17) * 2], cx = CH[((b * 8 + sl) * 17 + c17) * 2 + 1];
        const float mu = fmaxf(m, cx); m_in[step] = m; mul[step] = mu; m = be + mu; }
}

__device__ __forceinline__ void phase_l1_scan(const Args& args, unsigned char* ws, LAS unsigned char* lds, int tid, int lane, int wave, int bx, int G, int b) {
    const bf16* XM = (const bf16*)(ws + WS_XM); const bf16* XC = (const bf16*)(ws + WS_XC); const float* AJ = (const float*)(ws + WS_AJ); const float* CH = (const float*)(ws + WS_CH);
    bf16* ST = (bf16*)(ws + WS_ST1); float* NV = (float*)(ws + WS_NV);
    LAS unsigned char* Kt = lds; LAS unsigned char* Vt = lds + 128 * P144; LAS float* MS = (LAS float*)(lds + 128 * P144 + 128 * P272);
    const int fr = lane & 15, fq = lane >> 4, wd = wave & 3, we = wave >> 2;
    const bf16x8 ones = (bf16x8){(short)0x3F80, (short)0x3F80, (short)0x3F80, (short)0x3F80, (short)0x3F80, (short)0x3F80, (short)0x3F80, (short)0x3F80};
    for (int u = bx; u < 256; u += G) {
        const int sl = u >> 5, t = u & 31, et = t >> 3, dt = t & 7, dir = sl >> 2, h = sl & 3;
        __syncthreads();
        if (tid == 0) m_chain(CH, b, sl, MS, MS + 32);
        __syncthreads();
        if (t == 0 && tid < 17) ((float*)(ws + WS_MIN))[(b * 8 + sl) * 17 + tid] = MS[tid];
        f32x4 acc[4]; f32x4 nacc = (f32x4){0.f, 0.f, 0.f, 0.f};
#pragma unroll
        for (int i = 0; i < 4; ++i) acc[i] = (f32x4){0.f, 0.f, 0.f, 0.f};
        const int srow = tid >> 2, q4 = tid & 3;
        const bf16* xcb = XC + 512 * h + 64 * dt + 16 * q4; const bf16* xmb = XM + 512 * h + 128 * et + 32 * q4;
#define L1S_STP(si) ((si) < 2 ? 0 : 1 + (((si) - 2) >> 2))
#define L1S_LOAD(si, K0, K1, VV, W) do { const int stp_ = L1S_STP(si), t0_ = (si) < 2 ? 128 * (si) : 128 * (((si) - 2) & 3); int r_, xr_; \
            if (stp_ == 0) { r_ = 256 * b + t0_ + srow; xr_ = t0_ + srow; } else { const int kq_ = dir ? 16 - stp_ : stp_ - 1; r_ = RL0 + 8192 * b + 512 * kq_ + t0_ + srow; xr_ = 256 + 512 * kq_ + t0_ + srow; } \
            W = __expf(AJ[(size_t)r_ * 8 + sl] - MS[32 + stp_]); K0 = *(const v4u*)(xcb + (size_t)xr_ * 2048); K1 = *(const v4u*)(xcb + (size_t)xr_ * 2048 + 8); \
            _Pragma("unroll") for (int c = 0; c < 4; ++c) VV[c] = *(const v4u*)(xmb + (size_t)r_ * 2048 + 8 * c); } while (0)
#define L1S_STORE(kidx) do { bf16* So = ST + ((size_t)(sl * 16 + (kidx)) * 512) * 512; \
            _Pragma("unroll") for (int t4 = 0; t4 < 4; ++t4) { const int e = 128 * et + 64 * we + 16 * t4 + fr, d = 64 * dt + 16 * wd + 4 * fq; *(v2u*)(So + (size_t)e * 512 + d) = pack4(acc[t4]); } \
            if (et == 0 && we == 0 && fr == 0) *(f32x4*)(NV + (size_t)(sl * 16 + (kidx)) * 512 + 64 * dt + 16 * wd + 4 * fq) = nacc; } while (0)
#define L1S_STEP(si, K0, K1, VV, W) do { const int stp_ = L1S_STP(si); \
            if ((si) == 0 || ((si) >= 2 && (((si) - 2) & 3) == 0)) { if (stp_ >= 1) L1S_STORE(dir ? 16 - stp_ : stp_ - 1); const float wc_ = __expf(MS[stp_] - MS[32 + stp_]); \
                _Pragma("unroll") for (int i = 0; i < 4; ++i) acc[i] = acc[i] * wc_; nacc = nacc * wc_; } \
            __syncthreads(); \
            *(LAS v4u*)(Kt + srow * P144 + 32 * q4) = scale8(K0, W); *(LAS v4u*)(Kt + srow * P144 + 32 * q4 + 16) = scale8(K1, W); \
            _Pragma("unroll") for (int c = 0; c < 4; ++c) *(LAS v4u*)(Vt + srow * P272 + 64 * q4 + 16 * c) = VV[c]; \
            __syncthreads(); \
            if ((si) + 4 < 62) L1S_LOAD((si) + 4, K0, K1, VV, W); \
            _Pragma("unroll") for (int kk = 0; kk < 4; ++kk) { const bf16x8 a = frag_tr(Kt, P144, 32 * kk, 16 * wd, lane); \
                _Pragma("unroll") for (int t4 = 0; t4 < 4; ++t4) acc[t4] = MFMA16(a, frag_tr(Vt, P272, 32 * kk, 64 * we + 16 * t4, lane), acc[t4]); \
                nacc = MFMA16(a, ones, nacc); } } while (0)
        v4u ka0, ka1, va[4], kb0, kb1, vb[4], kc0, kc1, vc[4], kd0, kd1, vd[4]; float wa, wb, wc, wd_;
        L1S_LOAD(0, ka0, ka1, va, wa); L1S_LOAD(1, kb0, kb1, vb, wb); L1S_LOAD(2, kc0, kc1, vc, wc); L1S_LOAD(3, kd0, kd1, vd, wd_);
#pragma unroll 1
        for (int si = 0; si < 60; si += 4) { L1S_STEP(si, ka0, ka1, va, wa); L1S_STEP(si + 1, kb0, kb1, vb, wb); L1S_STEP(si + 2, kc0, kc1, vc, wc); L1S_STEP(si + 3, kd0, kd1, vd, wd_); }
        L1S_STEP(60, ka0, ka1, va, wa); L1S_STEP(61, kb0, kb1, vb, wb);
        L1S_STORE(dir ? 0 : 15);
#undef L1S_STP
#undef L1S_LOAD
#undef L1S_STORE
#undef L1S_STEP
    }
    __syncthreads();
}


constexpr int P1040 = 1040;
constexpr int LY_AJ = 139264;
constexpr int LY_MT = 66560;
__device__ __forceinline__ void qprime8(const bf16* xcrow, const float* WQK, int cb, float (&o)[8]) {
    float x[8]; unpack8(*(const v4u*)(xcrow + cb), x);
    bw8(x, WQK + (cb >> 2) * 16, o);
}
constexpr int LY_Q = 73728;
__device__ __forceinline__ LAS unsigned char* qp_addr(LAS unsigned char* lds, int r, int c) { return lds + LY_Q + r * 1024 + ((c ^ (r & 15)) << 4); }
__device__ __forceinline__ void qp_fill(LAS unsigned char* lds, const bf16* xcrow, const float* WQK, int h, int rl, int we, int fq, const float* nf, const float* nb, float& qn_f, float& qn_b, bool with_n) {
#pragma unroll 2
    for (int j = 0; j < 8; ++j) { const int c = 8 * j + 4 * we + fq; float q8[8]; qprime8(xcrow, WQK, 512 * h + 8 * c, q8);
        if (with_n) {
#pragma unroll
            for (int e = 0; e < 8; ++e) { qn_f += q8[e] * nf[8 * c + e]; qn_b += q8[e] * nb[8 * c + e]; } }
        *(LAS v4u*)qp_addr(lds, rl, c) = pack8(q8); }
}
__device__ __forceinline__ void qp_fill_scaled(LAS unsigned char* lds, const bf16* xcrow, const float* WQK, int h, int rl, int we, int fq, float sc) {
#pragma unroll 2
    for (int j = 0; j < 8; ++j) { const int c = 8 * j + 4 * we + fq; float q8[8]; qprime8(xcrow, WQK, 512 * h + 8 * c, q8);
#pragma unroll
        for (int e = 0; e < 8; ++e) q8[e] *= sc;
        *(LAS v4u*)qp_addr(lds, rl, c) = pack8(q8); }
}
__device__ __forceinline__ void phase_l1_y(const Args& args, unsigned char* ws, LAS unsigned char* lds, int tid0, int lane0, int wave, int bx, int G, int b, unsigned long long& tacc, bool dry = false) {
#ifndef YSEC
#define YSEC -1
#endif
    unsigned long long ytm = 0ull; int ycur = -1;
#define YT(n) do { if (YSEC >= 0) { const unsigned long long now_ = __builtin_amdgcn_s_memrealtime(); if (ycur == YSEC) tacc += now_ - ytm; ytm = now_; ycur = (n); } } while (0)

    const bf16* XM = (const bf16*)(ws + WS_XM); const bf16* XC = (const bf16*)(ws + WS_XC); bf16* Z = (bf16*)(ws + WS_Z);
    const float* AJ = (const float*)(ws + WS_AJ); const float* BC = (const float*)(ws + WS_BC); const float* CM = (const float*)(ws + WS_CM); const float* CH = (const float*)(ws + WS_CH);
    const bf16* ST = (const bf16*)(ws + WS_ST1); const float* NV = (const float*)(ws + WS_NV); const float* WQK = (const float*)(ws + WS_WQK);
    LAS float* AJL = (LAS float*)(lds + LY_AJ);
    LAS unsigned char* Mf = lds;
    LAS unsigned char* Tt = lds + 66560;
    const int wr = wave >> 1, we = wave & 1;
    for (int u = bx; u < 512; u += G) {
        int tid = tid0, lane = lane0; asm volatile("" : "+v"(tid), "+v"(lane));
        const int fr = lane & 15, fq = lane >> 4;
        const int h = u >> 7, k = (u >> 3) & 15, rb = u & 7;
        const int base = RL0 + 8192 * b + 512 * k, xb = 256 + 512 * k, i0 = 64 * rb;
        const int il = i0 + 16 * wr + fr, row = base + il; const bf16* xcrow = XC + (size_t)(xb + il) * 2048;
        YT(0);
        const int Rw = 4 * rb + wr;
        __syncthreads();
        const float m_in_f = ((const float*)(ws + WS_MIN))[(b * 8 + h) * 17 + k + 1], m_in_b = ((const float*)(ws + WS_MIN))[(b * 8 + 4 + h) * 17 + 16 - k];
        const float mu_f = fmaxf(m_in_f, CM[(size_t)row * 8 + h]), mu_b = fmaxf(m_in_b, CM[(size_t)row * 8 + 4 + h]);
        const float bc_f = BC[(size_t)row * 8 + h], bc_b = BC[(size_t)row * 8 + 4 + h];
        for (int i = tid; i < 1024; i += 512) { const int d = i >> 9, j = i & 511; AJL[i] = AJ[(size_t)(base + j) * 8 + 4 * d + h]; }
        YT(1);
        f32x4 Gt[4][4];
#pragma unroll
        for (int kb = 0; kb < 4; ++kb)
#pragma unroll
            for (int t = 0; t < 4; ++t) Gt[kb][t] = (f32x4){0.f, 0.f, 0.f, 0.f};
        float qn_f = 0.f, qn_b = 0.f;
        const float* nf = NV + (size_t)(h * 16 + k) * 512; const float* nb = NV + (size_t)((4 + h) * 16 + k) * 512;
        qp_fill(lds, xcrow, WQK, h, 16 * wr + fr, we, fq, nf, nb, qn_f, qn_b, true);
        v4u pa0[8], pa1[8]; int tA = tid; asm volatile("" : "+v"(tA));
#define LYA_LOAD(P, dsv) do { asm volatile("" : "+v"(tA)); _Pragma("unroll") for (int c = 0; c < 8; ++c) { const int ch = tA + 512 * c, r = ch >> 3, cc = ch & 7; P[c] = *(const v4u*)(XC + (size_t)(xb + r) * 2048 + 512 * h + 64 * (dsv) + 8 * cc); } } while (0)
#define LYA_STEP(P, dsv) do { __syncthreads(); \
            _Pragma("unroll") for (int c = 0; c < 8; ++c) { const int ch = tA + 512 * c, r = ch >> 3, cc = ch & 7; *(LAS v4u*)(lds + r * P144 + 16 * cc) = P[c]; } \
            __syncthreads(); \
            if ((dsv) + 2 < 8) LYA_LOAD(P, (dsv) + 2); \
            bf16x8 qf[2]; \
            _Pragma("unroll") for (int kk = 0; kk < 2; ++kk) qf[kk] = *(const LAS bf16x8*)qp_addr(lds, 16 * wr + fr, 8 * (dsv) + 4 * kk + fq); \
            _Pragma("unroll") for (int kb = 0; kb < 4; ++kb) { \
                _Pragma("unroll") for (int t = 0; t < 4; ++t) { \
                    _Pragma("unroll") for (int kk = 0; kk < 2; ++kk) Gt[kb][t] = MFMA16(frag_nat(lds, P144, 64 * (4 * we + kb) + 16 * t, 32 * kk, lane), qf[kk], Gt[kb][t]); \
                    asm volatile("" ::: "memory"); } } } while (0)
        LYA_LOAD(pa0, 0); LYA_LOAD(pa1, 1);
#pragma unroll 1
        for (int ds = 0; ds < 8; ds += 2) { LYA_STEP(pa0, ds); LYA_STEP(pa1, ds + 1); }
#undef LYA_LOAD
#undef LYA_STEP
        YT(2);
        qn_f += __shfl_xor(qn_f, 16); qn_f += __shfl_xor(qn_f, 32); qn_b += __shfl_xor(qn_b, 16); qn_b += __shfl_xor(qn_b, 32);
        float rsf = 0.f, rsb = 0.f;
#pragma unroll
        for (int kb = 0; kb < 4; ++kb)
#pragma unroll
            for (int t = 0; t < 4; ++t) { const int T = 4 * (4 * we + kb) + t, j0 = 16 * T + 4 * fq; const f32x4 g = Gt[kb][t];
                if (T < Rw) { rsf += g.x * __expf(AJL[j0] - mu_f) + g.y * __expf(AJL[j0 + 1] - mu_f) + g.z * __expf(AJL[j0 + 2] - mu_f) + g.w * __expf(AJL[j0 + 3] - mu_f); }
                else if (T > Rw) { rsb += g.x * __expf(AJL[512 + j0] - mu_b) + g.y * __expf(AJL[512 + j0 + 1] - mu_b) + g.z * __expf(AJL[512 + j0 + 2] - mu_b) + g.w * __expf(AJL[512 + j0 + 3] - mu_b); }
                else {
#pragma unroll
                    for (int r = 0; r < 4; ++r) { const int jj = 4 * fq + r; const float ef = __expf(AJL[j0 + r] - mu_f), eb = __expf(AJL[512 + j0 + r] - mu_b);
                        rsf += jj <= fr ? g[r] * ef : 0.f; rsb += jj >= fr ? g[r] * eb : 0.f; } }
                asm volatile("" ::: "memory"); }
        rsf += __shfl_xor(rsf, 16); rsf += __shfl_xor(rsf, 32); rsb += __shfl_xor(rsb, 16); rsb += __shfl_xor(rsb, 32);
        __syncthreads();
        { LAS float* RS = (LAS float*)lds; if (fq == 0) { RS[(wave * 16 + fr) * 4] = rsf; RS[(wave * 16 + fr) * 4 + 1] = rsb; RS[(wave * 16 + fr) * 4 + 2] = qn_f; RS[(wave * 16 + fr) * 4 + 3] = qn_b; }
          __syncthreads();
          rsf += RS[((wave ^ 1) * 16 + fr) * 4]; rsb += RS[((wave ^ 1) * 16 + fr) * 4 + 1]; qn_f += RS[((wave ^ 1) * 16 + fr) * 4 + 2]; qn_b += RS[((wave ^ 1) * 16 + fr) * 4 + 3]; }
        const float wp_f = __expf(m_in_f - mu_f), wp_b = __expf(m_in_b - mu_b);
        const float dn_f = fmaxf(fabsf(rsf + wp_f * qn_f), __expf(-bc_f - mu_f)), dn_b = fmaxf(fabsf(rsb + wp_b * qn_b), __expf(-bc_b - mu_b));
        const float inv_f = 1.0f / dn_f, inv_b = 1.0f / dn_b, s_f = wp_f * inv_f, s_b = wp_b * inv_b;
        __syncthreads();
#pragma unroll
        for (int kb = 0; kb < 4; ++kb)
#pragma unroll
            for (int t = 0; t < 4; ++t) { const int T = 4 * (4 * we + kb) + t, j0 = 16 * T + 4 * fq; const f32x4 g = Gt[kb][t]; f32x4 m;
                if (T < Rw) { m.x = g.x * __expf(AJL[j0] - mu_f) * inv_f; m.y = g.y * __expf(AJL[j0 + 1] - mu_f) * inv_f; m.z = g.z * __expf(AJL[j0 + 2] - mu_f) * inv_f; m.w = g.w * __expf(AJL[j0 + 3] - mu_f) * inv_f; }
                else if (T > Rw) { m.x = g.x * __expf(AJL[512 + j0] - mu_b) * inv_b; m.y = g.y * __expf(AJL[512 + j0 + 1] - mu_b) * inv_b; m.z = g.z * __expf(AJL[512 + j0 + 2] - mu_b) * inv_b; m.w = g.w * __expf(AJL[512 + j0 + 3] - mu_b) * inv_b; }
                else {
#pragma unroll
                    for (int r = 0; r < 4; ++r) { const int jj = 4 * fq + r; const float ef = __expf(AJL[j0 + r] - mu_f) * inv_f, eb = __expf(AJL[512 + j0 + r] - mu_b) * inv_b;
                        m[r] = g[r] * ((jj <= fr ? ef : 0.f) + (jj >= fr ? eb : 0.f)); } }
                *(LAS v2u*)(Mf + (16 * wr + fr) * P1040 + j0 * 2) = pack4(m); asm volatile("" ::: "memory"); }
        YT(3);
        f32x4 acc[16];
#pragma unroll
        for (int et = 0; et < 16; ++et) acc[et] = (f32x4){0.f, 0.f, 0.f, 0.f};
        v4u pre[8], pre1[8]; int tB = tid; asm volatile("" : "+v"(tB));
#define LYB_LOAD(P, kbv) do { asm volatile("" : "+v"(tB)); _Pragma("unroll") for (int c = 0; c < 8; ++c) { const int ch = tB + 512 * c, r = ch >> 6, cc = ch & 63; P[c] = *(const v4u*)(XM + (size_t)(base + 64 * (kbv) + r) * 2048 + 512 * h + 8 * cc); } } while (0)
#define LYB_STEP(P, kbv) do { __syncthreads(); \
            _Pragma("unroll") for (int c = 0; c < 8; ++c) { const int ch = tB + 512 * c, r = ch >> 6, cc = ch & 63; *(LAS v4u*)(Tt + r * P1040 + 16 * cc) = P[c]; } \
            __syncthreads(); \
            if ((kbv) + 2 < 8) LYB_LOAD(P, (kbv) + 2); \
            _Pragma("unroll") for (int kk2 = 0; kk2 < 2; ++kk2) { const bf16x8 mb = frag_nat(Mf, P1040, 16 * wr, 64 * (kbv) + 32 * kk2, lane); \
                _Pragma("unroll") for (int et = 0; et < 16; ++et) { acc[et] = MFMA16(frag_tr(Tt, P1040, 32 * kk2, 256 * we + 16 * et, lane), mb, acc[et]); if ((et & 3) == 3) asm volatile("" ::: "memory"); } } } while (0)
        LYB_LOAD(pre, 0); LYB_LOAD(pre1, 1);
#pragma unroll 1
        for (int kb = 0; kb < 8; kb += 2) { LYB_STEP(pre, kb); LYB_STEP(pre1, kb + 1); }
#undef LYB_LOAD
#undef LYB_STEP
        YT(4);
        int tC = tid; asm volatile("" : "+v"(tC));
#define LYC_LOAD(P, itv) do { asm volatile("" : "+v"(tC)); const bf16* S_ = ST + ((size_t)((((itv) >> 3) * 4 + h) * 16 + k) * 512) * 512 + 64 * ((itv) & 7); \
            _Pragma("unroll") for (int c = 0; c < 8; ++c) { const int ch = tC + 512 * c, r = ch >> 3, cc = ch & 7; P[c] = *(const v4u*)(S_ + (size_t)r * 512 + 8 * cc); } } while (0)
#define LYC_STEP(P, itv) do { __syncthreads(); \
            _Pragma("unroll") for (int c = 0; c < 8; ++c) { const int ch = tC + 512 * c, r = ch >> 3, cc = ch & 7; *(LAS v4u*)(lds + r * P144 + 16 * cc) = P[c]; } \
            __syncthreads(); \
            if ((itv) + 2 < 16) LYC_LOAD(P, (itv) + 2); \
            bf16x8 qs[2]; \
            _Pragma("unroll") for (int kk = 0; kk < 2; ++kk) qs[kk] = *(const LAS bf16x8*)qp_addr(lds, 16 * wr + fr, 8 * ((itv) & 7) + 4 * kk + fq); \
            _Pragma("unroll") for (int kk = 0; kk < 2; ++kk) \
                _Pragma("unroll") for (int et = 0; et < 16; ++et) { acc[et] = MFMA16(frag_nat(lds, P144, 256 * we + 16 * et, 32 * kk, lane), qs[kk], acc[et]); if ((et & 3) == 3) asm volatile("" ::: "memory"); } } while (0)
        LYC_LOAD(pre, 0); LYC_LOAD(pre1, 1);
#pragma unroll 1
        for (int dir = 0; dir < 2; ++dir) {
            __syncthreads();
            qp_fill_scaled(lds, xcrow, WQK, h, 16 * wr + fr, we, fq, dir ? s_b : s_f);
#pragma unroll 1
            for (int it = 8 * dir; it < 8 * dir + 8; it += 2) { LYC_STEP(pre, it); LYC_STEP(pre1, it + 1); }
        }
#undef LYC_LOAD
#undef LYC_STEP
        YT(5);
        float sm = 0.f;
#pragma unroll
        for (int et = 0; et < 16; ++et) { const float* w = args.in[I_MLWV] + (size_t)(128 * h + 64 * we + 4 * et + fq) * 16; const f32x4 a = acc[et]; f32x4 o;
            o.x = a.x * w[0] + a.y * w[4] + a.z * w[8] + a.w * w[12]; o.y = a.x * w[1] + a.y * w[5] + a.z * w[9] + a.w * w[13];
            o.z = a.x * w[2] + a.y * w[6] + a.z * w[10] + a.w * w[14]; o.w = a.x * w[3] + a.y * w[7] + a.z * w[11] + a.w * w[15];
            acc[et] = o; sm += (o.x + o.y) + (o.z + o.w); asm volatile("" ::: "memory"); }
        sm += __shfl_xor(sm, 16); sm += __shfl_xor(sm, 32);
        LAS float* XS = AJL;
        __syncthreads();
        if (fq == 0) XS[wave * 16 + fr] = sm;
        __syncthreads();
        const float mean = (sm + XS[(wave ^ 1) * 16 + fr]) * (1.f / 512.f); float sq = 0.f;
#pragma unroll
        for (int et = 0; et < 16; ++et) { acc[et] = acc[et] - mean; sq += (acc[et].x * acc[et].x + acc[et].y * acc[et].y) + (acc[et].z * acc[et].z + acc[et].w * acc[et].w); }
        sq += __shfl_xor(sq, 16); sq += __shfl_xor(sq, 32);
        if (fq == 0) XS[128 + wave * 16 + fr] = sq;
        __syncthreads();
        const float rstd = 1.0f / sqrtf((sq + XS[128 + (wave ^ 1) * 16 + fr]) * (1.f / 512.f) + LN_EPS);
#pragma unroll
        for (int et = 0; et < 16; ++et) { const int ch = 512 * h + 256 * we + 16 * et + 4 * fq;
            const f32x4 nw = *(const f32x4*)(args.in[I_MLNW] + ch), sk = *(const f32x4*)(args.in[I_MLSKIP] + ch), xcv = unpack4(*(const v2u*)(xcrow + ch)), zz = unpack4(*(const v2u*)(Z + (size_t)row * 2048 + ch));
            f32x4 y = acc[et] * rstd * nw + sk * xcv;
            y.x *= silu_f(zz.x); y.y *= silu_f(zz.y); y.z *= silu_f(zz.z); y.w *= silu_f(zz.w);
            if (!dry) *(v2u*)(Z + (size_t)row * 2048 + ch) = pack4(y); asm volatile("" ::: "memory"); }
        YT(6);
    }
    __syncthreads();
}


__device__ __forceinline__ void xcd_barrier2(const XcdBarrier& b) {
    asm volatile("s_waitcnt vmcnt(0)" ::: "memory");
    __syncthreads();
    if (threadIdx.x == 0) {
        unsigned* bar = b.bar;
        __builtin_amdgcn_s_waitcnt(0);
        unsigned nloc = b.st[0], nx = b.st[1];
        if (nloc == 0u) { xcd_barrier_complete(bar, b.x, nloc, nx); b.st[0] = nloc; b.st[1] = nx; }
        const unsigned old = xb_add(&bar[XB_XSUB(b.x)], 1u);
        const unsigned gen = old / nloc;
        if (old + 1u == (gen + 1u) * nloc) {
            __builtin_amdgcn_fence(__ATOMIC_RELEASE, "agent");
            asm volatile("s_waitcnt vmcnt(0)" ::: "memory");
            const unsigned og = xb_add(&bar[XB_TOP], 1u);
            if (og + 1u == (gen + 1u) * nx) xb_add(&bar[XB_TOPGEN], 1u);
        }
        XB_SPIN(xb_ld(&bar[XB_TOPGEN]) == gen, bar);
        __builtin_amdgcn_fence(__ATOMIC_ACQUIRE, "agent");
        asm volatile("s_waitcnt vmcnt(0)" ::: "memory");
    }
    __syncthreads();
}
#ifndef BARRIER_FLAT
#define BARRIER_FLAT 0
#endif
__device__ __forceinline__ void flat_barrier(unsigned* cnt, unsigned* flag, unsigned& gen, unsigned G) {
    asm volatile("s_waitcnt vmcnt(0)" ::: "memory");
    __syncthreads();
    if (threadIdx.x == 0) {
        __builtin_amdgcn_fence(__ATOMIC_RELEASE, "agent");
        asm volatile("s_waitcnt vmcnt(0)" ::: "memory");
        const unsigned target = gen + 1u;
        const unsigned old = __hip_atomic_fetch_add(cnt, 1u, __ATOMIC_RELAXED, __HIP_MEMORY_SCOPE_AGENT);
        if (old + 1u == target * G) __hip_atomic_store(flag, target, __ATOMIC_RELAXED, __HIP_MEMORY_SCOPE_AGENT);
        else { unsigned sp = 0; while (__hip_atomic_load(flag, __ATOMIC_RELAXED, __HIP_MEMORY_SCOPE_AGENT) < target) { __builtin_amdgcn_s_sleep(1); if (++sp > (1u << 22)) break; } }
        __builtin_amdgcn_fence(__ATOMIC_ACQUIRE, "agent");
        asm volatile("s_waitcnt vmcnt(0)" ::: "memory");
    }
    gen += 1u;
    __syncthreads();
}
#ifndef MK_PER_PHASE
#define MK_PER_PHASE 0
#endif
constexpr int N_PHASES = 25;
#ifndef PROBE_MASK
#define PROBE_MASK 0
#endif
#define DUP(k) (((PROBE_MASK) >> (k)) & 1)
#ifndef TPROBE_MASK
#define TPROBE_MASK 0
#endif
#define TPR(k) (((TPROBE_MASK) >> (k)) & 1)
__global__ void __launch_bounds__(NWAVES * 64, 2) mk_fwd(Args args) {
    extern __shared__ __attribute__((aligned(16))) unsigned char lds_raw[];
    LAS unsigned char* lds = (LAS unsigned char*)lds_raw;
    volatile LAS unsigned* MISC = (volatile LAS unsigned*)(lds + MISC_OFF);
    const int tid = threadIdx.x, lane = tid & 63, wave = __builtin_amdgcn_readfirstlane(tid >> 6);
    const int G = gridDim.x, bx = blockIdx.x;
    const int vcu = (G % 8 == 0) ? (bx % 8) * (G / 8) + bx / 8 : bx;
    const int gw = vcu * NWAVES + wave, NGW = G * NWAVES;
    unsigned char* ws = args.ws;
    gu32* ctl = (gu32*)(ws + WS_CTL);
    float* MOD = (float*)(ws + CTL_MOD);
    unsigned char* dob = (unsigned char*)args.out;
    for (int u = tid; u < (LDS_BYTES - LDSCTL_OFF) / 4; u += NWAVES * 64) ((LAS unsigned*)(lds + LDSCTL_OFF))[u] = 0u;
    __syncthreads();
    XcdBarrier bar; bar.bar = (unsigned*)(ctl + CW_BAR); bar.x = 0; bar.st = nullptr;
    if (!MK_PER_PHASE) bar = xcd_barrier_post((unsigned*)(ctl + CW_BAR), MISC + 8);
    const int lo = args.ph_lo, hi = args.ph_hi;
    unsigned long long tacc = 0ull, tmark = 0ull;
#define TBEG(k) do { if (TPR(k)) tmark = __builtin_amdgcn_s_memrealtime(); } while (0)
#define TEND(k) do { if (TPR(k)) tacc += __builtin_amdgcn_s_memrealtime() - tmark; } while (0)
#define IN(k) (lo <= (k) && (k) < hi)
    unsigned fgen = 0u;
#if BARRIER_FLAT
#define GBAR() flat_barrier((unsigned*)(ctl + 8192), (unsigned*)(ctl + 8192 + 64), fgen, (unsigned)G)
#elif defined(BARRIER2)
#define GBAR() xcd_barrier2(bar)
#else
#define GBAR() xcd_barrier(bar)
#endif
#define SEAM(k) do { if (IN(k) && IN((k) + 1)) GBAR(); TEND(k); TBEG((k) + 1); } while (0)

    TBEG(0);
    if (IN(0)) {
        LAS float* scr = (LAS float*)(lds + wave * 16384);
        conv_abin(args.in[I_ABIN], (bf16*)(ws + WS_W_IN), scr, gw, NGW, lane);
        conv_plain(args.in[I_ABOUT], 2048, 1024, (bf16*)(ws + WS_W_OUT), scr, gw, NGW, lane);
        conv_ffn1(args.in[I_W1], args.in[I_W3], (bf16*)(ws + WS_W_F1), scr, gw, NGW, lane);
        conv_plain(args.in[I_W2], FFH, 1024, (bf16*)(ws + WS_W_F2), scr, gw, NGW, lane);
        __syncthreads();
        LAS float* sc = (LAS float*)lds;
        LAS float* part = (LAS float*)(lds + 16384);
        for (int i = tid; i < 3 * 1024; i += 512) { const int v = i >> 10, k = i & 1023; const float cv = v == 0 ? args.in[I_CCTX][k] : args.in[I_C][(v - 1) * DM + k]; sc[i] = silu_f(cv); }
        __syncthreads();
        for (int u = bx; u < 192; u += G) {
            const int layer = u / 96, cb = u % 96, n = cb * 64 + lane;
            const float* W = args.in[I_ADAW] + (size_t)layer * DM * 6144 + (size_t)(wave * 128) * 6144 + n;
            float a0 = 0.f, a1 = 0.f, a2 = 0.f;
#pragma unroll 8
            for (int kk = 0; kk < 128; ++kk) { const float wv = W[(size_t)kk * 6144]; const int k = wave * 128 + kk; a0 += sc[k] * wv; a1 += sc[1024 + k] * wv; a2 += sc[2048 + k] * wv; }
            part[(wave * 3 + 0) * 64 + lane] = a0; part[(wave * 3 + 1) * 64 + lane] = a1; part[(wave * 3 + 2) * 64 + lane] = a2;
            __syncthreads();
            if (tid < 192) { const int v = tid >> 6, l = tid & 63; float s = args.in[I_ADAB][layer * 6144 + cb * 64 + l];
#pragma unroll
                for (int w = 0; w < 8; ++w) s += part[(w * 3 + v) * 64 + l];
                MOD[(size_t)(layer * 3 + v) * 6144 + cb * 64 + l] = s; }
            __syncthreads();
        }
        for (int i = bx * 512 + tid; i < 512 * 16; i += G * 512) { const int blk = i >> 4, d = (i >> 2) & 3, dp = i & 3; const float* q = args.in[I_MLWQ] + blk * 16 + d * 4; const float* k = args.in[I_MLWK] + blk * 16 + dp * 4;
            ((float*)(ws + WS_WQK))[i] = 0.04419417382415922f * (q[0] * k[0] + q[1] * k[1] + q[2] * k[2] + q[3] * k[3]); }
    }
    SEAM(0);
    if (IN(1)) {
        LAS float* wdt = (LAS float*)lds;
        for (int i = tid; i < 1024 * 4; i += 512) { const int k = i >> 2, q = i & 3; const f32x4 w4 = *(const f32x4*)(args.in[I_ABIN] + (size_t)k * ABIN + 3072 + 4 * q);
            wdt[(4 * q) * 1024 + k] = w4.x; wdt[(4 * q + 1) * 1024 + k] = w4.y; wdt[(4 * q + 2) * 1024 + k] = w4.z; wdt[(4 * q + 3) * 1024 + k] = w4.w; }
        __syncthreads();
        norm_rows<true>(args.in[I_CTX], args.in[I_X], args.in[I_NMIX], MOD, 0, (bf16*)(dob + DO_H), 0, 0, R, gw, NGW, lane, wdt, (float*)(ws + WS_DTRAW));
        __syncthreads();
    }
    SEAM(1);
    if (IN(2)) {
        pg8::Gemm g{(const bf16*)(dob + DO_H), (const bf16*)(ws + WS_W_IN), R, 6144, DM}; pg8::StaticOrder S; S.init(R, 6144, G, bx);
        pg8::EpiInProj E{(bf16*)(ws + WS_ZG), (bf16*)(ws + WS_XBC), (bf16*)(ws + WS_QK), (bf16*)(ws + WS_V), (bf16*)(ws + WS_HALO)};
        pg8::gemm_phase<pg8::EpiInProj, pg8::StaticOrder, true, true>(lds, g, S, E);
    }
    SEAM(2);
    if (DUP(20)) { for (int i = 0; i < 10; ++i) GBAR(); }
    if (IN(3)) { phase_l0_prep(args, ws, lds, tid, lane, wave, vcu, G, gw, NGW); }
    SEAM(3);
    if (DUP(4) && IN(4)) { phase_l0_scan(args, ws, dob, lds, tid, lane, wave, vcu, G); GBAR(); }
    if (IN(4)) { phase_l0_scan(args, ws, dob, lds, tid, lane, wave, vcu, G); }
    SEAM(4);
    if (DUP(5) && IN(5)) { phase_l0_y(args, ws, dob, lds, tid, lane, wave, vcu, G, tacc, lo == 0); GBAR(); }
    if (IN(5)) { phase_l0_y(args, ws, dob, lds, tid, lane, wave, vcu, G, tacc); }
    SEAM(5);
    if (IN(6)) {
        pg8::Gemm g{(const bf16*)(ws + WS_ZG), (const bf16*)(ws + WS_W_OUT), R, DM, 2048}; pg8::CtxSplitOrder S; S.init(G, bx, 8);
        pg8::EpiResidSplit E{args.in[I_X], args.out, MOD + 2 * 1024, (float*)(ws + WS_QK)};
        pg8::gemm_phase<pg8::EpiResidSplit, pg8::CtxSplitOrder, true, true>(lds, g, S, E);
    }
    SEAM(6);
    if (IN(7)) { norm_rows<false, 8>(args.in[I_CTX], args.out, args.in[I_NFFN], MOD, 3, (bf16*)(ws + WS_HF0), 0, 0, R, gw, NGW, lane, nullptr, nullptr, (const float*)(ws + WS_QK), MOD + 2 * 1024, (float*)(ws + WS_XCTX)); }
    SEAM(7);
    if (IN(8)) {
        pg8::Gemm g{(const bf16*)(ws + WS_HF0), (const bf16*)(ws + WS_W_F1), R, 5632, DM}; pg8::StaticOrder S; S.init(R, 5632, G, bx);
        pg8::EpiSwiglu E{(bf16*)(ws + WS_HH0), FFH};
        pg8::gemm_phase<pg8::EpiSwiglu, pg8::StaticOrder, true, true>(lds, g, S, E);
    }
    SEAM(8);
    if (IN(9)) {
        pg8::Gemm g{(const bf16*)(ws + WS_HH0), (const bf16*)(ws + WS_W_F2), R, DM, FFH}; pg8::CtxSplitOrder S; S.init(G, bx, 11);
        pg8::EpiResidSplit E{args.out, args.out, MOD + 5 * 1024, (float*)(ws + WS_V)};
        pg8::gemm_phase<pg8::EpiResidSplit, pg8::CtxSplitOrder, true, true>(lds, g, S, E);
    }
    SEAM(9);
    if (IN(10)) {
        norm_rows<false, 11>((const float*)(ws + WS_XCTX), args.out, args.in[I_NMIX] + DM, MOD + 3 * 6144, 0, (bf16*)(ws + WS_H1), 0, 0, R, gw, NGW, lane, nullptr, nullptr, (const float*)(ws + WS_V), MOD + 5 * 1024, (float*)(ws + WS_XCTX));
        conv_plain(args.in[I_MLUP], DM, 4096, (bf16*)(ws + WS_W_UP), (LAS float*)(lds + wave * 16384), gw, NGW, lane);
        for (int i = bx * 512 + tid; i < 2 * 16 * 2048; i += G * 512) { const int which = i >> 15, gt = (i >> 11) & 15, d = i & 2047, blk = d >> 2, dd = d & 3; const float* gw = args.in[I_MLGW];
            float s = 0.f;
            if (which == 0) { const float* q = args.in[I_MLWQ] + blk * 16 + dd * 4; const float* k = args.in[I_MLWK] + blk * 16 + dd * 4;
#pragma unroll
                for (int c = 0; c < 4; ++c) s += q[c] * gw[(size_t)(4 * blk + c) * 16 + gt] + k[c] * gw[(size_t)(2048 + 4 * blk + c) * 16 + gt]; }
            else { const float* v = args.in[I_MLWV] + blk * 16 + dd * 4;
#pragma unroll
                for (int c = 0; c < 4; ++c) s += v[c] * gw[(size_t)(4096 + 4 * blk + c) * 16 + gt]; }
            ((bf16*)(ws + WS_GWT))[i] = (bf16)f2bf(s); }
    }
    SEAM(10);
    if (IN(11)) {
        pg8::Gemm g{(const bf16*)(ws + WS_H1), (const bf16*)(ws + WS_W_UP), R, 4096, DM}; pg8::StaticOrder S; S.init(R, 4096, G, bx);
        pg8::EpiSplit2 E{(bf16*)(ws + WS_XM), (bf16*)(ws + WS_Z), 2048, 8};
        pg8::gemm_phase<pg8::EpiSplit2, pg8::StaticOrder, true, true>(lds, g, S, E);
    }
    SEAM(11);
    {
        if (IN(12)) {
            phase_l1_prep(args, ws, lds, tid, lane, wave, vcu, G, 0);
            if (0 == 1) {
                LAS float* scr = (LAS float*)(lds + wave * 16384);
                __syncthreads();
                conv_plain(args.in[I_MLDOWN], 2048, 1024, (bf16*)(ws + WS_W_DN), scr, gw, NGW, lane);
                conv_ffn1(args.in[I_W1] + (size_t)DM * FFH, args.in[I_W3] + (size_t)DM * FFH, (bf16*)(ws + WS_W_F1B), scr, gw, NGW, lane);
                conv_plain(args.in[I_W2] + (size_t)FFH * DM, FFH, 1024, (bf16*)(ws + WS_W_F2B), scr, gw, NGW, lane);
            }
        }
        SEAM(12);
        if (DUP(13) && IN(13)) { phase_l1_prep(args, ws, lds, tid, lane, wave, vcu, G, 0); GBAR(); phase_l1_gatescan(args, ws, lds, tid, lane, wave, bx, G, gw, NGW, 0); GBAR(); }
        if (DUP(21) && IN(13)) { phase_l1_gatescan(args, ws, lds, tid, lane, wave, bx, G, gw, NGW, 0); GBAR(); }
        if (DUP(22) && IN(13)) { phase_l1_prep(args, ws, lds, tid, lane, wave, vcu, G, 0); GBAR(); }
        if (IN(13)) { phase_l1_gatescan(args, ws, lds, tid, lane, wave, bx, G, gw, NGW, 0); }
        SEAM(13);
        if (DUP(14) && IN(14)) { phase_l1_scan(args, ws, lds, tid, lane, wave, vcu, G, 0); GBAR(); }
        if (IN(14)) { phase_l1_scan(args, ws, lds, tid, lane, wave, vcu, G, 0); }
        SEAM(14);
        if (DUP(15) && IN(15)) { phase_l1_y(args, ws, lds, tid, lane, wave, vcu, G, 0, tacc, lo == 0); GBAR(); }
        if (IN(15)) { phase_l1_y(args, ws, lds, tid, lane, wave, vcu, G, 0, tacc); }
        SEAM(15);
    }
    {
        if (IN(16)) {
            phase_l1_prep(args, ws, lds, tid, lane, wave, vcu, G, 1);
            if (1 == 1) {
                LAS float* scr = (LAS float*)(lds + wave * 16384);
                __syncthreads();
                conv_plain(args.in[I_MLDOWN], 2048, 1024, (bf16*)(ws + WS_W_DN), scr, gw, NGW, lane);
                conv_ffn1(args.in[I_W1] + (size_t)DM * FFH, args.in[I_W3] + (size_t)DM * FFH, (bf16*)(ws + WS_W_F1B), scr, gw, NGW, lane);
                conv_plain(args.in[I_W2] + (size_t)FFH * DM, FFH, 1024, (bf16*)(ws + WS_W_F2B), scr, gw, NGW, lane);
            }
        }
        SEAM(16);
        if (DUP(13) && IN(17)) { phase_l1_prep(args, ws, lds, tid, lane, wave, vcu, G, 1); GBAR(); phase_l1_gatescan(args, ws, lds, tid, lane, wave, bx, G, gw, NGW, 1); GBAR(); }
        if (DUP(21) && IN(17)) { phase_l1_gatescan(args, ws, lds, tid, lane, wave, bx, G, gw, NGW, 1); GBAR(); }
        if (DUP(22) && IN(17)) { phase_l1_prep(args, ws, lds, tid, lane, wave, vcu, G, 1); GBAR(); }
        if (IN(17)) { phase_l1_gatescan(args, ws, lds, tid, lane, wave, bx, G, gw, NGW, 1); }
        SEAM(17);
        if (DUP(14) && IN(18)) { phase_l1_scan(args, ws, lds, tid, lane, wave, vcu, G, 1); GBAR(); }
        if (IN(18)) { phase_l1_scan(args, ws, lds, tid, lane, wave, vcu, G, 1); }
        SEAM(18);
        if (DUP(15) && IN(19)) { phase_l1_y(args, ws, lds, tid, lane, wave, vcu, G, 1, tacc, lo == 0); GBAR(); }
        if (IN(19)) { phase_l1_y(args, ws, lds, tid, lane, wave, vcu, G, 1, tacc); }
        SEAM(19);
    }
    if (IN(20)) {
        pg8::Gemm g{(const bf16*)(ws + WS_Z) + (size_t)RL0 * 2048, (const bf16*)(ws + WS_W_DN), MLAT, DM, 2048}; pg8::StaticOrder S; S.init(MLAT, DM, G, bx);
        pg8::EpiResid E{(const float*)(ws + WS_XCTX), args.out, (float*)(ws + WS_XCTX), args.out, MOD + 3 * 6144 + 2 * 1024, RL0};
        pg8::gemm_phase<pg8::EpiResid, pg8::StaticOrder, true, true>(lds, g, S, E);
    }
    SEAM(20);
    if (IN(21)) { norm_rows<false>((const float*)(ws + WS_XCTX), args.out, args.in[I_NFFN] + DM, MOD + 3 * 6144, 3, (bf16*)(ws + WS_HF1), RL0, RL0, R, gw, NGW, lane, nullptr, nullptr); }
    SEAM(21);
    if (IN(22)) {
        pg8::Gemm g{(const bf16*)(ws + WS_HF1), (const bf16*)(ws + WS_W_F1B), MLAT, 5632, DM}; pg8::StaticOrder S; S.init(MLAT, 5632, G, bx);
        pg8::EpiSwiglu E{(bf16*)(ws + WS_HH1), FFH};
        pg8::gemm_phase<pg8::EpiSwiglu, pg8::StaticOrder, true, true>(lds, g, S, E);
    }
    SEAM(22);
    if (IN(23)) {
        pg8::Gemm g{(const bf16*)(ws + WS_HH1), (const bf16*)(ws + WS_W_F2B), MLAT, DM, FFH}; pg8::StaticOrder S; S.init(MLAT, DM, G, bx);
        pg8::EpiResid E{(const float*)(ws + WS_XCTX), args.out, (float*)(ws + WS_XCTX), args.out, MOD + 3 * 6144 + 5 * 1024, RL0};
        pg8::gemm_phase<pg8::EpiResid, pg8::StaticOrder, true, true>(lds, g, S, E);
    }
    SEAM(23);
    if (IN(24)) {
        const float* w = args.in[I_FNW];
        for (int m = gw; m < MLAT; m += NGW) {
            float* row = args.out + (size_t)m * DM; f32x4 v[4]; float ss = 0.f;
#pragma unroll
            for (int j = 0; j < 4; ++j) { v[j] = *(const f32x4*)(row + 4 * lane + 256 * j); ss += (v[j].x * v[j].x + v[j].y * v[j].y) + (v[j].z * v[j].z + v[j].w * v[j].w); }
            const float rstd = 1.0f / sqrtf(wave_sum(ss) * (1.f / DM) + RMS_EPS);
#pragma unroll
            for (int j = 0; j < 4; ++j) { const f32x4 wv = *(const f32x4*)(w + 4 * lane + 256 * j); *(f32x4*)(row + 4 * lane + 256 * j) = v[j] * rstd * wv; }
        }
    }
    TEND(24);
    if (TPROBE_MASK || YSEC >= 0) { if (bx == 0) { if (tid == 0) { const unsigned long long t0 = __builtin_amdgcn_s_memrealtime(); while (__builtin_amdgcn_s_memrealtime() - t0 < tacc) __builtin_amdgcn_s_sleep(8); } __syncthreads(); } }
#undef IN
#undef SEAM
}

extern "C" void kernel_launch(void* const* d_in, const int* in_sizes, int n_in, void* d_out, int out_size, void* d_ws, size_t ws_size, hipStream_t stream) {
    static int grid = 0;
    if (grid == 0) {
        if (n_in != 35 || out_size != MLAT * DM || ws_size < WS_END) { fprintf(stderr, "kernel_launch: unexpected problem: n_in %d out %d ws %zu\n", n_in, out_size, ws_size); grid = -1; return; }
        int dev = 0, cus = 0;
        if (hipGetDevice(&dev) != hipSuccess || hipDeviceGetAttribute(&cus, hipDeviceAttributeMultiprocessorCount, dev) != hipSuccess) { grid = -1; return; }
        if (hipFuncSetAttribute((const void*)mk_fwd, hipFuncAttributeMaxDynamicSharedMemorySize, LDS_BYTES) != hipSuccess) { fprintf(stderr, "kernel_launch: hipFuncSetAttribute failed\n"); grid = -1; return; }
        int per_cu = 0;
        if (hipOccupancyMaxActiveBlocksPerMultiprocessor(&per_cu, (const void*)mk_fwd, NWAVES * 64, LDS_BYTES) != hipSuccess || per_cu < 1) fprintf(stderr, "kernel_launch: occupancy query says %d\n", per_cu);
        (void)hipGetLastError();
        grid = cus;
    }
    if (grid < 0) return;
    if (hipMemsetAsync((char*)d_ws + WS_CTL, 0, CTL_ZERO_BYTES, stream) != hipSuccess) return;
    Args a{};
    for (int i = 0; i < 35; ++i) a.in[i] = (const float*)d_in[i];
    a.out = (float*)d_out; a.ws = (unsigned char*)d_ws;
#if MK_PER_PHASE
    for (int p = 0; p < N_PHASES; ++p) { a.ph_lo = p; a.ph_hi = p + 1; hipLaunchKernelGGL(mk_fwd, dim3(grid), dim3(NWAVES * 64), LDS_BYTES, stream, a); }
#else
    a.ph_lo = 0; a.ph_hi = N_PHASES;
    hipLaunchKernelGGL(mk_fwd, dim3(grid), dim3(NWAVES * 64), LDS_BYTES, stream, a);
#endif
}
```
